# Optimizing an MI355X kernel written in HIP

```python
import math
import jax
import jax.numpy as jnp
from jax import lax
import numpy as np

D_MODEL = 1024
BATCH = 16
SEQ = 2048
DEPTH = 2

ATT_WIDTH = D_MODEL // 2
HEAD_DIM = 128
ATT_HEADS = ATT_WIDTH // HEAD_DIM
ROT_DIM = HEAD_DIM // 4
ROPE_THETA = 500000.0
MOBA_BLOCK = 256
MOBA_TOPK = 3
Q_CHUNK = 128
POOL_WIDTH = D_MODEL // 2
POOL_WINDOWS = (2, 4, 8, 16)
POOL_GROUPS = len(POOL_WINDOWS)
POOL_GROUP_W = POOL_WIDTH // POOL_GROUPS
EVEN_IN = 4 * ATT_WIDTH + 2 * POOL_WIDTH

S5_WIDTH = D_MODEL // 2
S5_GROUP_IN = 16
S5_GROUPS = S5_WIDTH // S5_GROUP_IN
S5_STATE = 64
CONV_WIDTH = D_MODEL // 2
CONV_K = 31
ODD_IN = 2 * S5_WIDTH + 3 * CONV_WIDTH

N_EVEN = (DEPTH + 1) // 2
N_ODD = DEPTH // 2
EPS = 1e-6
NEG = -1e30

kernel_name = "hybrid_moba_pool_s5_conformer"


def rms_norm(x, g):
    xf = x.astype(jnp.float32)
    y = xf * lax.rsqrt(jnp.mean(xf * xf, axis=-1, keepdims=True) + EPS) * g.astype(jnp.float32)
    return y.astype(x.dtype)


def rope_partial(x):
    s = x.shape[1]
    pos = jnp.arange(s, dtype=jnp.float32)
    inv = jnp.power(ROPE_THETA, -jnp.arange(0, ROT_DIM, 2, dtype=jnp.float32) / ROT_DIM)
    ang = pos[:, None] * inv[None, :]
    cos = jnp.cos(ang)[None, :, None, :]
    sin = jnp.sin(ang)[None, :, None, :]
    xf = x.astype(jnp.float32)
    x1 = xf[..., : ROT_DIM // 2]
    x2 = xf[..., ROT_DIM // 2: ROT_DIM]
    out = jnp.concatenate([x1 * cos - x2 * sin, x2 * cos + x1 * sin, xf[..., ROT_DIM:]], axis=-1)
    return out.astype(x.dtype)


def moba_attention(q, k, v):
    b, s, h, hd = q.shape
    nb = -(-s // MOBA_BLOCK)
    pad = nb * MOBA_BLOCK - s
    kp = jnp.pad(k, ((0, 0), (0, pad), (0, 0), (0, 0)))
    vp = jnp.pad(v, ((0, 0), (0, pad), (0, 0), (0, 0)))
    kb = kp.reshape(b, nb, MOBA_BLOCK, h, hd)
    vb = vp.reshape(b, nb, MOBA_BLOCK, h, hd)
    kbar = jnp.mean(kb.astype(jnp.float32), axis=2)
    gate = jnp.einsum('bshd,bnhd->bshn', q.astype(jnp.float32), kbar)
    qblk = jnp.arange(s) // MOBA_BLOCK
    past = jnp.arange(nb)[None, :] < qblk[:, None]
    gate = jnp.where(past[None, :, None, :], gate, -jnp.inf)
    n_sel = min(MOBA_TOPK, nb)
    _, idx = lax.top_k(gate, n_sel)
    valid = idx < qblk[None, :, None, None]

    nc = s // Q_CHUNK
    q_c = q.reshape(b, nc, Q_CHUNK, h, hd)
    idx_c = idx.reshape(b, nc, Q_CHUNK, h, n_sel)
    valid_c = valid.reshape(b, nc, Q_CHUNK, h, n_sel)
    kh = kb.transpose(0, 3, 1, 2, 4)
    vh = vb.transpose(0, 3, 1, 2, 4)
    scale = 1.0 / math.sqrt(hd)
    h_ar = jnp.arange(h)[None, :, None]

    def per_batch(args):
        qb, ib, mb, khb, vhb = args

        def per_chunk(cargs):
            c, qc, ic, mc = cargs
            kg = khb[h_ar, ic]
            vg = vhb[h_ar, ic]
            blk = (c * Q_CHUNK) // MOBA_BLOCK
            ko = lax.dynamic_index_in_dim(khb, blk, axis=1, keepdims=False)
            vo = lax.dynamic_index_in_dim(vhb, blk, axis=1, keepdims=False)
            s_sel = jnp.einsum('qhd,qhjkd->qhjk', qc, kg).astype(jnp.float32) * scale
            s_sel = jnp.where(mc[..., None], s_sel, NEG)
            s_own = jnp.einsum('qhd,hkd->qhk', qc, ko).astype(jnp.float32) * scale
            qpos = c * Q_CHUNK + jnp.arange(Q_CHUNK)
            kpos = blk * MOBA_BLOCK + jnp.arange(MOBA_BLOCK)
            causal = (kpos[None, :] <= qpos[:, None])[:, None, :]
            s_own = jnp.where(causal, s_own, NEG)
            sc = jnp.concatenate([s_sel.reshape(Q_CHUNK, h, n_sel * MOBA_BLOCK), s_own], axis=-1)
            p = jax.nn.softmax(sc, axis=-1).astype(vhb.dtype)
            p_sel = p[..., : n_sel * MOBA_BLOCK].reshape(Q_CHUNK, h, n_sel, MOBA_BLOCK)
            p_own = p[..., n_sel * MOBA_BLOCK:]
            return (jnp.einsum('qhjk,qhjkd->qhd', p_sel, vg)
                    + jnp.einsum('qhk,hkd->qhd', p_own, vo))

        return lax.map(per_chunk, (jnp.arange(nc), qb, ib, mb))

    out = lax.map(per_batch, (q_c, idx_c, valid_c, kh, vh))
    return out.reshape(b, s, h, hd)


def multiscale_pool(u, pool_w, pool_scale):
    b, s, _ = u.shape
    ug = u.reshape(b, s, POOL_GROUPS, POOL_GROUP_W).astype(jnp.float32)
    cs = jnp.concatenate([jnp.zeros((b, 1, POOL_GROUPS, POOL_GROUP_W), jnp.float32),
                          jnp.cumsum(ug, axis=1)], axis=1)
    t = jnp.arange(s)
    outs = []
    for g, w in enumerate(POOL_WINDOWS):
        lo = jnp.maximum(t + 1 - w, 0)
        win = cs[:, 1:, g] - cs[:, lo, g]
        cnt = (t + 1 - lo).astype(jnp.float32)[None, :, None]
        outs.append(win / cnt - ug[:, :, g])
    m = jnp.stack(outs, axis=2)
    y = jnp.einsum('bsgc,gcd->bsgd', m, pool_w.astype(jnp.float32)).reshape(b, s, POOL_WIDTH)
    return (y * pool_scale.astype(jnp.float32)).astype(u.dtype)


def s5_ssm(u, lam_re, lam_im, log_dt, b_re, b_im, c_re, c_im, d):
    bsz, s, _ = u.shape
    f32 = jnp.float32
    uf = u.reshape(bsz, s, S5_GROUPS, S5_GROUP_IN).astype(f32)
    lr, li = lam_re.astype(f32), lam_im.astype(f32)
    dt = jnp.exp(log_dt.astype(f32))[:, None]
    mag = jnp.exp(lr * dt)
    ab_re = mag * jnp.cos(li * dt)
    ab_im = mag * jnp.sin(li * dt)
    den = lr * lr + li * li
    num_re = ab_re - 1.0
    f_re = (num_re * lr + ab_im * li) / den
    f_im = (ab_im * lr - num_re * li) / den
    br, bi = b_re.astype(f32), b_im.astype(f32)
    bb_re = f_re[..., None] * br - f_im[..., None] * bi
    bb_im = f_re[..., None] * bi + f_im[..., None] * br
    bu_re = jnp.einsum('bsgi,gpi->bsgp', uf, bb_re)
    bu_im = jnp.einsum('bsgi,gpi->bsgp', uf, bb_im)
    a_re = jnp.broadcast_to(ab_re, bu_re.shape)
    a_im = jnp.broadcast_to(ab_im, bu_im.shape)

    def combine(e1, e2):
        a1r, a1i, b1r, b1i = e1
        a2r, a2i, b2r, b2i = e2
        return (a2r * a1r - a2i * a1i,
                a2r * a1i + a2i * a1r,
                a2r * b1r - a2i * b1i + b2r,
                a2r * b1i + a2i * b1r + b2i)

    _, _, xr, xi = lax.associative_scan(combine, (a_re, a_im, bu_re, bu_im), axis=1)
    y = (jnp.einsum('bsgp,gip->bsgi', xr, c_re.astype(f32))
         - jnp.einsum('bsgp,gip->bsgi', xi, c_im.astype(f32)))
    y = y.reshape(bsz, s, S5_WIDTH) + d.astype(f32) * u.astype(f32)
    return y.astype(u.dtype)


def conformer_conv(a, gl, dw, ln_g, ln_b, pw):
    g = a * jax.nn.sigmoid(gl)
    kern = dw.reshape(CONV_K, 1, CONV_WIDTH).astype(g.dtype)
    c = lax.conv_general_dilated(g, kern, window_strides=(1,), padding=[(CONV_K - 1, 0)],
                                 dimension_numbers=('NWC', 'WIO', 'NWC'),
                                 feature_group_count=CONV_WIDTH)
    cf = c.astype(jnp.float32)
    mu = jnp.mean(cf, axis=-1, keepdims=True)
    var = jnp.mean(jnp.square(cf - mu), axis=-1, keepdims=True)
    n = (cf - mu) * lax.rsqrt(var + EPS) * ln_g.astype(jnp.float32) + ln_b.astype(jnp.float32)
    return (jax.nn.silu(n).astype(a.dtype)) @ pw


def even_mixer(h, w_in, pool_w, pool_scale, w_out):
    b, s, _ = h.shape
    z = h @ w_in
    A = ATT_WIDTH
    q, k, v, ga, pu, gb = jnp.split(z, [A, 2 * A, 3 * A, 4 * A, 4 * A + POOL_WIDTH], axis=-1)
    q = rope_partial(q.reshape(b, s, ATT_HEADS, HEAD_DIM))
    k = rope_partial(k.reshape(b, s, ATT_HEADS, HEAD_DIM))
    v = v.reshape(b, s, ATT_HEADS, HEAD_DIM)
    att = moba_attention(q, k, v).reshape(b, s, A) * jax.nn.silu(ga)
    pool = multiscale_pool(pu, pool_w, pool_scale) * jax.nn.silu(gb)
    return jnp.concatenate([att, pool], axis=-1) @ w_out


def odd_mixer(h, w_in, lam_re, lam_im, log_dt, b_re, b_im, c_re, c_im, d,
              glu_w, glu_b, dw, ln_g, ln_b, pw, w_out):
    z = h @ w_in
    Wc, Wd = S5_WIDTH, CONV_WIDTH
    su, gc, ca, cb, gd = jnp.split(z, [Wc, 2 * Wc, 2 * Wc + Wd, 2 * Wc + 2 * Wd], axis=-1)
    y = s5_ssm(su, lam_re, lam_im, log_dt, b_re, b_im, c_re, c_im, d)
    ya, yb = jnp.split(y @ glu_w + glu_b, 2, axis=-1)
    ssm_out = ya * jax.nn.sigmoid(yb) * jax.nn.silu(gc)
    conv_out = conformer_conv(ca, cb, dw, ln_g, ln_b, pw) * jax.nn.silu(gd)
    return jnp.concatenate([ssm_out, conv_out], axis=-1) @ w_out


def setup_inputs(seed: int = 0) -> dict:
    key = jax.random.key(seed)
    ks = jax.random.split(key, 24)
    nrm = jax.random.normal
    f32 = jnp.float32
    D = D_MODEL
    x = nrm(ks[0], (BATCH, SEQ, D), f32)
    pre_norm_g = 1.0 + 0.05 * nrm(ks[1], (DEPTH, D), f32)
    post_norm_g = 1.0 + 0.05 * nrm(ks[2], (DEPTH, D), f32)
    e_w_in = nrm(ks[3], (N_EVEN, D, EVEN_IN), f32) * D ** -0.5
    e_pool_w = nrm(ks[4], (N_EVEN, POOL_GROUPS, POOL_GROUP_W, POOL_GROUP_W), f32) * POOL_GROUP_W ** -0.5
    e_pool_scale = 1.0 + 0.05 * nrm(ks[5], (N_EVEN, POOL_WIDTH), f32)
    e_w_out = nrm(ks[6], (N_EVEN, ATT_WIDTH + POOL_WIDTH, D), f32) * (ATT_WIDTH + POOL_WIDTH) ** -0.5
    o_w_in = nrm(ks[7], (N_ODD, D, ODD_IN), f32) * D ** -0.5
    n_idx = jnp.arange(S5_STATE, dtype=f32)
    o_lam_re = -0.5 + 0.01 * nrm(ks[8], (N_ODD, S5_GROUPS, S5_STATE), f32)
    o_lam_im = math.pi * n_idx[None, None, :] + 0.01 * nrm(ks[9], (N_ODD, S5_GROUPS, S5_STATE), f32)
    o_log_dt = jax.random.uniform(ks[10], (N_ODD, S5_GROUPS), f32, math.log(1e-3), math.log(1e-1))
    o_b_re = nrm(ks[11], (N_ODD, S5_GROUPS, S5_STATE, S5_GROUP_IN), f32) * (2.0 * S5_GROUP_IN) ** -0.5
    o_b_im = nrm(ks[12], (N_ODD, S5_GROUPS, S5_STATE, S5_GROUP_IN), f32) * (2.0 * S5_GROUP_IN) ** -0.5
    o_c_re = nrm(ks[13], (N_ODD, S5_GROUPS, S5_GROUP_IN, S5_STATE), f32) * (2.0 * S5_STATE) ** -0.5
    o_c_im = nrm(ks[14], (N_ODD, S5_GROUPS, S5_GROUP_IN, S5_STATE), f32) * (2.0 * S5_STATE) ** -0.5
    o_d = nrm(ks[15], (N_ODD, S5_WIDTH), f32)
    o_glu_w = nrm(ks[16], (N_ODD, S5_WIDTH, 2 * S5_WIDTH), f32) * S5_WIDTH ** -0.5
    o_glu_b = 0.01 * nrm(ks[17], (N_ODD, 2 * S5_WIDTH), f32)
    o_dw = nrm(ks[18], (N_ODD, CONV_K, CONV_WIDTH), f32) * CONV_K ** -0.5
    o_ln_g = 1.0 + 0.05 * nrm(ks[19], (N_ODD, CONV_WIDTH), f32)
    o_ln_b = 0.01 * nrm(ks[20], (N_ODD, CONV_WIDTH), f32)
    o_pw = nrm(ks[21], (N_ODD, CONV_WIDTH, CONV_WIDTH), f32) * CONV_WIDTH ** -0.5
    o_w_out = nrm(ks[22], (N_ODD, S5_WIDTH + CONV_WIDTH, D), f32) * (S5_WIDTH + CONV_WIDTH) ** -0.5
    return {"x": x, "pre_norm_g": pre_norm_g, "post_norm_g": post_norm_g,
            "e_w_in": e_w_in, "e_pool_w": e_pool_w, "e_pool_scale": e_pool_scale, "e_w_out": e_w_out,
            "o_w_in": o_w_in, "o_lam_re": o_lam_re, "o_lam_im": o_lam_im, "o_log_dt": o_log_dt,
            "o_b_re": o_b_re, "o_b_im": o_b_im, "o_c_re": o_c_re, "o_c_im": o_c_im, "o_d": o_d,
            "o_glu_w": o_glu_w, "o_glu_b": o_glu_b, "o_dw": o_dw, "o_ln_g": o_ln_g, "o_ln_b": o_ln_b,
            "o_pw": o_pw, "o_w_out": o_w_out}


def reference(x, pre_norm_g, post_norm_g, e_w_in, e_pool_w, e_pool_scale, e_w_out,
              o_w_in, o_lam_re, o_lam_im, o_log_dt, o_b_re, o_b_im, o_c_re, o_c_im, o_d,
              o_glu_w, o_glu_b, o_dw, o_ln_g, o_ln_b, o_pw, o_w_out):
    for i in range(DEPTH):
        h = rms_norm(x, pre_norm_g[i])
        j = i // 2
        if i % 2 == 0:
            y = even_mixer(h, e_w_in[j], e_pool_w[j], e_pool_scale[j], e_w_out[j])
        else:
            y = odd_mixer(h, o_w_in[j], o_lam_re[j], o_lam_im[j], o_log_dt[j], o_b_re[j], o_b_im[j],
                          o_c_re[j], o_c_im[j], o_d[j], o_glu_w[j], o_glu_b[j], o_dw[j],
                          o_ln_g[j], o_ln_b[j], o_pw[j], o_w_out[j])
        x = x + rms_norm(y, post_norm_g[i])
    return x
```

```cpp
#include <hip/hip_runtime.h>
#include <cstdio>
#include <cstdint>
#include <cmath>
#define MK_N_LAUNCHES 0
namespace pg8 {
#define PG8_LAS __attribute__((address_space(3)))
typedef unsigned short bf16_t;
typedef short bf16x8 __attribute__((ext_vector_type(8)));
typedef float f32x4 __attribute__((ext_vector_type(4)));
typedef unsigned u32x4 __attribute__((ext_vector_type(4)));
constexpr int BM = 256, BK = 64, HALF = 128, HTB = HALF * BK * 2  , STAGE_BYTES = 8 * HTB, NXCD = 8, WGM = 8;

__host__ __device__ __forceinline__ int lds_byte(int r, int c) { const int st = (r >> 4) * 2 + (c >> 5), rr = r & 15, cc = c & 31, ob = rr * 64 + cc * 2; return st * 1024 + (ob ^ (((ob >> 9) & 1) << 5)); }
__host__ __device__ __forceinline__ void stage_rc(int b, int& R, int& C) { const int st = b / 1024, sb = b % 1024, swz = sb ^ (((sb >> 9) & 1) << 5); R = (st >> 1) * 16 + swz / 64; C = (st & 1) * 32 + (swz % 64) / 2; }
__host__ __device__ __forceinline__ int perm32(int rho) { const int n = rho >> 4, i = rho & 15; return 8 * (i >> 2) + 4 * n + (i & 3); }

struct Unit { int pm, pn; };
struct Gemm { const bf16_t* A; const bf16_t* Bt; int M, N, K; };

struct StaticOrder {
    int nM, nN, nwg, G, c;
    __host__ __device__ void init(int M, int N, int G_, int c_) { nM = M / BM; nN = N / BM; nwg = nM * nN; G = G_; c = c_; }
    __host__ __device__ bool next(int i, Unit& u) const {
        const long L = (long)i * G + c; if (L >= nwg) return false;
        int wgid = (int)L; { const int q = nwg / NXCD, r = nwg % NXCD, xcd = wgid % NXCD, off = wgid / NXCD; wgid = (xcd < r ? xcd * (q + 1) : r * (q + 1) + (xcd - r) * q) + off; }
        const int nig = WGM * nN, gid = wgid / nig, fm = gid * WGM, gsz = (nM - fm) < WGM ? (nM - fm) : WGM;
        u.pm = fm + ((wgid % nig) % gsz); u.pn = (wgid % nig) / gsz; return true;
    }
    __device__ __forceinline__ void a_ready(const Unit&) const {}
    __device__ __forceinline__ void done(const Unit&) const {}
};

__device__ __forceinline__ unsigned cvt_pk_bf16(float lo, float hi) { unsigned r; asm volatile("v_cvt_pk_bf16_f32 %0, %1, %2" : "=v"(r) : "v"(lo), "v"(hi)); return r; }
typedef float f32x2 __attribute__((ext_vector_type(2)));
__device__ __forceinline__ f32x2 gelu_pk(f32x2 v) {
    const f32x2 av = __builtin_elementwise_abs(v), d = av * 0.2316418882f + 1.0f;
    f32x2 t; t.x = __builtin_amdgcn_rcpf(d.x); t.y = __builtin_amdgcn_rcpf(d.y);
    f32x2 q = t * 0.5307027145f + (-0.7265760135f); q = q * t + 0.7107068705f; q = q * t + (-0.142248368f); q = q * t + 0.127414796f; q = q * t;
    const f32x2 s = (v * v) * (-0.72134752044f);
    f32x2 e; e.x = __builtin_amdgcn_exp2f(s.x); e.y = __builtin_amdgcn_exp2f(s.y);
    const f32x2 m = v * (q * e), r = v - m;
    f32x2 o; o.x = v.x < 0.f ? m.x : r.x; o.y = v.y < 0.f ? m.y : r.y; return o;
}

template <int ACT  > struct EpiBf16 {
    static constexpr bool PERM = true, AFTER_DRAIN = false; static_assert(ACT == 0 || ACT == 1, "EpiBf16: ACT is 0 (none) or 1 (gelu_pk)");
    bf16_t* O; int ldc; const float* bias; int split_cols; size_t split_stride; float scale0;
    __device__ __forceinline__ void operator()(const f32x4 (&acc)[2][2][4][2], const Unit& u, int wr, int wc, int fr, int fq) const {
        const int row0 = u.pm * BM + wr * 64 + fr; int colt = u.pn * BM; bf16_t* base = O;
        float sc = 1.f; if (split_cols) { const int t = colt / split_cols; base += (size_t)t * split_stride; colt -= t * split_cols; if (t == 0) sc = scale0; }
        const int col0 = colt + wc * 32 + 8 * fq, bcol0 = u.pn * BM + wc * 32 + 8 * fq;
        f32x4 bv[2][2];
#pragma unroll
        for (int bj = 0; bj < 2; ++bj)
#pragma unroll
            for (int n = 0; n < 2; ++n) bv[bj][n] = bias ? *(const f32x4*)(bias + bcol0 + bj * HALF + 4 * n) : (f32x4){0.f, 0.f, 0.f, 0.f};
#pragma unroll
        for (int ai = 0; ai < 2; ++ai)
#pragma unroll
            for (int m = 0; m < 4; ++m) { bf16_t* rowp = base + (size_t)(row0 + ai * HALF + m * 16) * ldc + col0;
#pragma unroll
                for (int bj = 0; bj < 2; ++bj) { f32x4 v0 = acc[ai][bj][m][0] + bv[bj][0], v1 = acc[ai][bj][m][1] + bv[bj][1];
                    if (ACT == 1) { f32x2 a = gelu_pk((f32x2){v0[0], v0[1]}), b = gelu_pk((f32x2){v0[2], v0[3]}), c = gelu_pk((f32x2){v1[0], v1[1]}), d = gelu_pk((f32x2){v1[2], v1[3]});
                        v0 = (f32x4){a.x, a.y, b.x, b.y}; v1 = (f32x4){c.x, c.y, d.x, d.y}; }
                    v0 = v0 * sc; v1 = v1 * sc; u32x4 w; w.x = cvt_pk_bf16(v0[0], v0[1]); w.y = cvt_pk_bf16(v0[2], v0[3]); w.z = cvt_pk_bf16(v1[0], v1[1]); w.w = cvt_pk_bf16(v1[2], v1[3]);
                    *(u32x4*)(rowp + bj * HALF) = w; } }
    }
};

struct PanelStats {
    unsigned* xbuf;
    unsigned* cnt;
    unsigned* tmo;
    int ntn; float eps;
    unsigned code;
    __device__ __forceinline__ bool run(const f32x4 (&v)[2][2][4][2], const Unit& u, int wr, int wc, int fr, int fq, PG8_LAS unsigned char* lds, int wid, int lane) const {
        typedef float f32x2v __attribute__((ext_vector_type(2)));
        PG8_LAS f32x2v* P = (PG8_LAS f32x2v*)lds;
        PG8_LAS f32x2v* S = (PG8_LAS f32x2v*)(lds + 8192);
        PG8_LAS unsigned* flag = (PG8_LAS unsigned*)(lds + 8192 + 2048);
#pragma unroll
        for (int ai = 0; ai < 2; ++ai)
#pragma unroll
            for (int m = 0; m < 4; ++m) {
                float s = 0.f;
#pragma unroll
                for (int bj = 0; bj < 2; ++bj)
#pragma unroll
                    for (int n = 0; n < 2; ++n) { const f32x4 x = v[ai][bj][m][n]; s += (x[0] + x[1]) + (x[2] + x[3]); }
                s += __shfl_xor(s, 16); s += __shfl_xor(s, 32);
                const float mw = s * (1.0f / 64.0f); float q = 0.f;
#pragma unroll
                for (int bj = 0; bj < 2; ++bj)
#pragma unroll
                    for (int n = 0; n < 2; ++n) { const f32x4 d = v[ai][bj][m][n] - mw; q += (d[0] * d[0] + d[1] * d[1]) + (d[2] * d[2] + d[3] * d[3]); }
                q += __shfl_xor(q, 16); q += __shfl_xor(q, 32);
                if (fq == 0) P[(ai * HALF + wr * 64 + m * 16 + fr) * 4 + wc] = (f32x2v){mw, q};
            }
        asm volatile("s_waitcnt lgkmcnt(0)" ::: "memory"); __builtin_amdgcn_s_barrier(); asm volatile("" ::: "memory");
#if defined(BROKEN_EXCHANGE_NO_WAIT)
#warning BROKEN CONTROL BUILD: the row-statistics exchange does not wait; results are wrong by design
        if (blockIdx.x >= 64) { const long long t0_ = clock64(); while (clock64() - t0_ < 60000) __builtin_amdgcn_s_sleep(8); }
#endif
        const int row = wid * 32 + (lane & 31);
        if (lane < 32) {
            const f32x2v a = P[row * 4 + 0], b = P[row * 4 + 1], c = P[row * 4 + 2], d = P[row * 4 + 3];
            const float mt = (a.x + b.x + c.x + d.x) * 0.25f;
            const float da = a.x - mt, db = b.x - mt, dc = c.x - mt, dd = d.x - mt;
            const float m2 = (a.y + b.y) + (c.y + d.y) + 64.0f * ((da * da + db * db) + (dc * dc + dd * dd));
            unsigned long long* slot = (unsigned long long*)xbuf + ((size_t)(u.pm * BM + row) * 4 + u.pn);
            __hip_atomic_store(slot, ((unsigned long long)__float_as_uint(m2) << 32) | __float_as_uint(mt), __ATOMIC_RELAXED, __HIP_MEMORY_SCOPE_AGENT);
        }
        asm volatile("s_waitcnt vmcnt(0)" ::: "memory");
        if (lane == 0) __hip_atomic_fetch_add(cnt + 64 * u.pm, 1u, __ATOMIC_RELAXED, __HIP_MEMORY_SCOPE_AGENT);
        if (wid == 0) {
            bool dead = false; const unsigned long long t0 = __builtin_amdgcn_s_memrealtime(); const unsigned want = 8u * (unsigned)ntn;
            for (;;) {
#if defined(BROKEN_EXCHANGE_NO_WAIT)
                break;
#endif
                if ((unsigned)__builtin_amdgcn_readfirstlane(__hip_atomic_load(cnt + 64 * u.pm, __ATOMIC_RELAXED, __HIP_MEMORY_SCOPE_AGENT)) >= want) break;
                if (__builtin_amdgcn_s_memrealtime() - t0 > 2000000ull) {
                    if (lane == 0) { unsigned expect = 0u; __hip_atomic_compare_exchange_strong(tmo + 1, &expect, code | (unsigned)(u.pm & 0xff), __ATOMIC_RELAXED, __ATOMIC_RELAXED, __HIP_MEMORY_SCOPE_AGENT);
                                     __hip_atomic_store(tmo, 1u, __ATOMIC_RELAXED, __HIP_MEMORY_SCOPE_AGENT); }
                    dead = true; break; }
                __builtin_amdgcn_s_sleep(2);
            }
            __builtin_amdgcn_fence(__ATOMIC_ACQUIRE, "agent");
            if (lane == 0) flag[0] = dead ? 1u : 0u;
        }
        asm volatile("s_waitcnt vmcnt(0) lgkmcnt(0)" ::: "memory"); __builtin_amdgcn_s_barrier(); asm volatile("" ::: "memory");
        const bool bad = flag[0] != 0u;
        if (lane < 32) {
            const unsigned long long* slot = (const unsigned long long*)xbuf + (size_t)(u.pm * BM + row) * 4; float mt[4], m2[4]; float ms = 0.f;
#pragma unroll
            for (int t = 0; t < 4; ++t) { if (t < ntn) { const unsigned long long w = __hip_atomic_load(slot + t, __ATOMIC_RELAXED, __HIP_MEMORY_SCOPE_AGENT); mt[t] = __uint_as_float((unsigned)w); m2[t] = __uint_as_float((unsigned)(w >> 32)); } else { mt[t] = 0.f; m2[t] = 0.f; } ms += mt[t]; }
            const float mean = ms / (float)ntn; float q = 0.f;
#pragma unroll
            for (int t = 0; t < 4; ++t) if (t < ntn) { const float dm = mt[t] - mean; q += m2[t] + 256.0f * dm * dm; }
            S[row] = (f32x2v){mean, 1.0f / sqrtf(q / (256.0f * (float)ntn) + eps)};
        }
        asm volatile("s_waitcnt lgkmcnt(0)" ::: "memory"); __builtin_amdgcn_s_barrier(); asm volatile("" ::: "memory");
        return bad;
    }
};
struct EpiLnRes {
    static constexpr bool PERM = false, AFTER_DRAIN = true;
    const float* base; float* out; int ldc; const float* bias; PanelStats st; unsigned poison;
    __device__ __forceinline__ void fused(f32x4 (&acc)[2][2][4][2], const Unit& u, int wr, int wc, int fr, int fq, PG8_LAS unsigned char* lds, int wid, int lane) const {
        typedef float f32x2v __attribute__((ext_vector_type(2)));
        const PG8_LAS f32x2v* S = (const PG8_LAS f32x2v*)(lds + 8192);
        const int col0 = u.pn * BM + wc * 32 + 4 * fq;
#pragma unroll
        for (int bj = 0; bj < 2; ++bj)
#pragma unroll
            for (int n = 0; n < 2; ++n) { const f32x4 bv = bias ? *(const f32x4*)(bias + col0 + bj * HALF + n * 16) : (f32x4){0.f, 0.f, 0.f, 0.f};
#pragma unroll
                for (int ai = 0; ai < 2; ++ai)
#pragma unroll
                    for (int m = 0; m < 4; ++m) acc[ai][bj][m][n] += bv; }
        f32x4 pre[4][2][2];
#pragma unroll
        for (int m = 0; m < 4; ++m) { const size_t off = (size_t)(u.pm * BM + wr * 64 + m * 16 + fr) * ldc + col0;
#pragma unroll
            for (int bj = 0; bj < 2; ++bj)
#pragma unroll
                for (int n = 0; n < 2; ++n) pre[m][bj][n] = *(const f32x4*)(base + off + bj * HALF + n * 16); }
        const bool bad = st.run(acc, u, wr, wc, fr, fq, lds, wid, lane) || poison != 0u;
        const float qnan = __builtin_nanf("");
#pragma unroll
        for (int ai = 0; ai < 2; ++ai)
#pragma unroll
            for (int m = 0; m < 4; ++m) { const int r = ai * HALF + wr * 64 + m * 16 + fr; const f32x2v sr = S[r]; const size_t off = (size_t)(u.pm * BM + r) * ldc + col0;
#pragma unroll
                for (int bj = 0; bj < 2; ++bj)
#pragma unroll
                    for (int n = 0; n < 2; ++n) { const f32x4 bs = ai == 0 ? pre[m][bj][n] : *(const f32x4*)(base + off + bj * HALF + n * 16); f32x4 o = bs + (acc[ai][bj][m][n] - sr.x) * sr.y;
                        if (bad) o = (f32x4){qnan, qnan, qnan, qnan}; *(f32x4*)(out + off + bj * HALF + n * 16) = o; }
                if (m & 1) asm volatile("" ::: "memory"); }
    }
};
struct EpiLnResLn {
    static constexpr bool PERM = false, AFTER_DRAIN = true;
    const float* base; float* out; bf16_t* xn; int ldc; const float* bias; PanelStats st1, st2; unsigned poison;
    __device__ __forceinline__ void fused(f32x4 (&acc)[2][2][4][2], const Unit& u, int wr, int wc, int fr, int fq, PG8_LAS unsigned char* lds, int wid, int lane) const {
        typedef float f32x2v __attribute__((ext_vector_type(2))); typedef unsigned u32x2v __attribute__((ext_vector_type(2)));
        const PG8_LAS f32x2v* S = (const PG8_LAS f32x2v*)(lds + 8192);
        const int col0 = u.pn * BM + wc * 32 + 4 * fq;
#pragma unroll
        for (int bj = 0; bj < 2; ++bj)
#pragma unroll
            for (int n = 0; n < 2; ++n) { const f32x4 bv = bias ? *(const f32x4*)(bias + col0 + bj * HALF + n * 16) : (f32x4){0.f, 0.f, 0.f, 0.f};
#pragma unroll
                for (int ai = 0; ai < 2; ++ai)
#pragma unroll
                    for (int m = 0; m < 4; ++m) acc[ai][bj][m][n] += bv; }
        bool bad = st1.run(acc, u, wr, wc, fr, fq, lds, wid, lane) || poison != 0u;
        const float qnan = __builtin_nanf("");
#pragma unroll
        for (int ai = 0; ai < 2; ++ai)
#pragma unroll
            for (int m = 0; m < 4; ++m) { const int r = ai * HALF + wr * 64 + m * 16 + fr; const f32x2v sr = S[r]; const size_t off = (size_t)(u.pm * BM + r) * ldc + col0;
#pragma unroll
                for (int bj = 0; bj < 2; ++bj)
#pragma unroll
                    for (int n = 0; n < 2; ++n) { const f32x4 bs = *(const f32x4*)(base + off + bj * HALF + n * 16); acc[ai][bj][m][n] = bs + (acc[ai][bj][m][n] - sr.x) * sr.y; }
                asm volatile("" : "+v"(acc[ai][0][m][0]), "+v"(acc[ai][0][m][1]), "+v"(acc[ai][1][m][0]), "+v"(acc[ai][1][m][1]));
                if (m & 1) asm volatile("" ::: "memory"); }
        const bool bad1 = bad;
        bad = st2.run(acc, u, wr, wc, fr, fq, lds, wid, lane) || bad;
#pragma unroll
        for (int ai = 0; ai < 2; ++ai)
#pragma unroll
            for (int m = 0; m < 4; ++m) { const int r = ai * HALF + wr * 64 + m * 16 + fr; const f32x2v sr = S[r]; const size_t off = (size_t)(u.pm * BM + r) * ldc + col0;
#pragma unroll
                for (int bj = 0; bj < 2; ++bj)
#pragma unroll
                    for (int n = 0; n < 2; ++n) { const f32x4 x1 = acc[ai][bj][m][n]; *(f32x4*)(out + off + bj * HALF + n * 16) = bad1 ? (f32x4){qnan, qnan, qnan, qnan} : x1;
                        const f32x4 o = (x1 - sr.x) * sr.y; u32x2v w; w.x = cvt_pk_bf16(o[0], o[1]); w.y = cvt_pk_bf16(o[2], o[3]);
                        if (bad) { w.x = 0x7fc07fc0u; w.y = 0x7fc07fc0u; } *(u32x2v*)(xn + off + bj * HALF + n * 16) = w; }
                asm volatile("" ::: "memory"); }
    }
};

template <class Epi, class Sched, bool ALIGN_EPI = false, bool SP2 = false>
__device__ __forceinline__ void gemm_phase(PG8_LAS unsigned char* lds, const Gemm g, const Sched& S, const Epi& E) {
    const int tid = threadIdx.x, wid = __builtin_amdgcn_readfirstlane(tid >> 6), lane = tid & 63, wr = wid >> 2, wc = wid & 3, fr = lane & 15, fq = lane >> 4;
    const int K = g.K, nt = K / BK;
    unsigned voffA[2], voffB[2];
#pragma unroll
    for (int i = 0; i < 2; ++i) { int R, C; stage_rc(tid * 16 + i * 8192, R, C); const int Rb = Epi::PERM ? ((R & ~31) + perm32(R & 31)) : R;
        voffA[i] = (unsigned)(R * K + C) * 2u; voffB[i] = (unsigned)(Rb * K + C) * 2u; }
    const size_t kstep = (size_t)(BK * 2);
    const size_t hstep = (size_t)HALF * K * 2;
    const size_t tstep = 2 * hstep;
    const unsigned ldsw = (unsigned)wid * 1024u;
    const int aoff = lds_byte(wr * 64 + fr, fq * 8), boff = lds_byte(wc * 32 + fr, fq * 8);
#define PG8_SA(b, h) (((b) * 2 + (h)) * HTB)
#define PG8_SB(b, h) ((4 + (b) * 2 + (h)) * HTB)
#define PG8_STAGE(bufoff, gbase, voff) do { _Pragma("unroll") for (int _i = 0; _i < 2; ++_i) \
        __builtin_amdgcn_global_load_lds((const unsigned*)((const char*)(gbase) + (voff)[_i]), (PG8_LAS unsigned*)(lds + (bufoff) + ldsw + _i * 8192), 16, 0, 0); } while (0)
#define PG8_LDA(dst, b, h) do { _Pragma("unroll") for (int m = 0; m < 4; ++m) _Pragma("unroll") for (int k = 0; k < 2; ++k) dst[m][k] = *(const PG8_LAS bf16x8*)(lds + PG8_SA(b, h) + aoff + m * 2048 + k * 1024); } while (0)
#define PG8_LDB(dst, b, h) do { _Pragma("unroll") for (int n = 0; n < 2; ++n) _Pragma("unroll") for (int k = 0; k < 2; ++k) dst[n][k] = *(const PG8_LAS bf16x8*)(lds + PG8_SB(b, h) + boff + n * 2048 + k * 1024); } while (0)
#define PG8_MMA(ai, bj, At, Bt) do { __builtin_amdgcn_s_setprio(1); _Pragma("unroll") for (int m = 0; m < 4; ++m) _Pragma("unroll") for (int n = 0; n < 2; ++n) _Pragma("unroll") for (int k = 0; k < 2; ++k) \
        acc[ai][bj][m][n] = __builtin_amdgcn_mfma_f32_16x16x32_bf16(Bt[n][k], At[m][k], acc[ai][bj][m][n], 0, 0, 0); __builtin_amdgcn_s_setprio(0); } while (0)
#define PG8_WAIT_V(n) asm volatile("s_waitcnt vmcnt(" #n ")" ::: "memory")
#define PG8_WAIT_L(n) asm volatile("s_waitcnt lgkmcnt(" #n ")" ::: "memory")
#define PG8_BAR __builtin_amdgcn_s_barrier()
#define PG8_SCHED __builtin_amdgcn_sched_barrier(0)
    Unit cur, nxt; int ui = 0;
    if (!S.next(0, cur)) return;
    f32x4 acc[2][2][4][2];
#pragma unroll
    for (int a = 0; a < 2; ++a)
#pragma unroll
        for (int b = 0; b < 2; ++b)
#pragma unroll
            for (int m = 0; m < 4; ++m)
#pragma unroll
                for (int n = 0; n < 2; ++n) acc[a][b][m][n] = (f32x4){0.f, 0.f, 0.f, 0.f};
    bf16x8 At[4][2], B0[2][2], B1[2][2];
    const char* cA = (const char*)g.A + (size_t)cur.pm * tstep; const char* cB = (const char*)g.Bt + (size_t)cur.pn * tstep;
    S.a_ready(cur);
    if constexpr (SP2) {
        PG8_STAGE(PG8_SB(0, 0), cB, voffB); PG8_STAGE(PG8_SB(0, 1), cB + hstep, voffB); PG8_STAGE(PG8_SA(0, 0), cA, voffA); PG8_STAGE(PG8_SA(0, 1), cA + hstep, voffA);
        if (wr == 1) PG8_BAR;
        PG8_WAIT_V(2); PG8_BAR;
        PG8_STAGE(PG8_SB(1, 0), cB + kstep, voffB); PG8_STAGE(PG8_SA(1, 0), cA + kstep, voffA); PG8_STAGE(PG8_SB(1, 1), cB + hstep + kstep, voffB);
        PG8_WAIT_V(6); PG8_BAR;
    } else {
        PG8_STAGE(PG8_SB(0, 0), cB, voffB); PG8_STAGE(PG8_SA(0, 0), cA, voffA); PG8_STAGE(PG8_SB(0, 1), cB + hstep, voffB); PG8_STAGE(PG8_SA(0, 1), cA + hstep, voffA);
        if (wr == 1) PG8_BAR;
        PG8_WAIT_V(4); PG8_BAR;
        PG8_STAGE(PG8_SB(1, 0), cB + kstep, voffB); PG8_STAGE(PG8_SA(1, 0), cA + kstep, voffA); PG8_STAGE(PG8_SB(1, 1), cB + hstep + kstep, voffB);
        PG8_WAIT_V(6); PG8_BAR;
    }
    for (;;) {
        const bool has_next = S.next(ui + 1, nxt);
        const char* nA = has_next ? (const char*)g.A + (size_t)nxt.pm * tstep : cA; const char* nB = has_next ? (const char*)g.Bt + (size_t)nxt.pn * tstep : cB;
        for (int t = 0; t < nt; t += 2) {
            const bool last = (t == nt - 2);
            const char* a1 = cA + (size_t)(t + 1) * kstep;
            const char* a2 = last ? nA : cA + (size_t)(t + 2) * kstep; const char* b2 = last ? nB : cB + (size_t)(t + 2) * kstep;
            const char* a3 = a2 + kstep; const char* b3 = b2 + kstep;
            if (last && has_next) S.a_ready(nxt);
            if constexpr (SP2) {
            PG8_LDB(B0, 0, 0); PG8_LDB(B1, 0, 1); PG8_SCHED; PG8_LDA(At, 0, 0); PG8_STAGE(PG8_SA(1, 1), a1 + hstep, voffA);
            PG8_WAIT_V(8); PG8_WAIT_L(0); PG8_BAR; PG8_MMA(0, 0, At, B0); PG8_MMA(0, 1, At, B1); PG8_BAR; PG8_SCHED;
            PG8_LDA(At, 0, 1); PG8_STAGE(PG8_SB(0, 0), b2, voffB); PG8_STAGE(PG8_SB(0, 1), b2 + hstep, voffB); PG8_STAGE(PG8_SA(0, 0), a2, voffA);
            PG8_WAIT_V(8); PG8_WAIT_L(0); PG8_BAR; PG8_MMA(1, 0, At, B0); PG8_MMA(1, 1, At, B1); PG8_BAR; PG8_SCHED;
            PG8_LDB(B0, 1, 0); PG8_LDB(B1, 1, 1); PG8_SCHED; PG8_LDA(At, 1, 0); PG8_STAGE(PG8_SA(0, 1), a2 + hstep, voffA);
            PG8_WAIT_V(8); PG8_WAIT_L(0); PG8_BAR; PG8_MMA(0, 0, At, B0); PG8_MMA(0, 1, At, B1); PG8_BAR; PG8_SCHED;
            PG8_LDA(At, 1, 1); PG8_STAGE(PG8_SB(1, 0), b3, voffB); PG8_STAGE(PG8_SB(1, 1), b3 + hstep, voffB); PG8_STAGE(PG8_SA(1, 0), a3, voffA);
            PG8_WAIT_V(8); PG8_WAIT_L(0); PG8_BAR; PG8_MMA(1, 0, At, B0); PG8_MMA(1, 1, At, B1); PG8_BAR; PG8_SCHED;
            } else {
            PG8_LDB(B0, 0, 0); PG8_SCHED; PG8_LDA(At, 0, 0); PG8_STAGE(PG8_SA(1, 1), a1 + hstep, voffA);
            PG8_WAIT_L(8); PG8_BAR; PG8_WAIT_L(0); PG8_MMA(0, 0, At, B0); PG8_BAR; PG8_SCHED;
            PG8_LDB(B1, 0, 1); PG8_STAGE(PG8_SB(0, 0), b2, voffB);
            PG8_BAR; PG8_WAIT_L(0); PG8_MMA(0, 1, At, B1); PG8_BAR;
            PG8_LDA(At, 0, 1); PG8_STAGE(PG8_SA(0, 0), a2, voffA);
            PG8_BAR; PG8_WAIT_L(0); PG8_MMA(1, 0, At, B0); PG8_BAR; PG8_SCHED;
            PG8_STAGE(PG8_SB(0, 1), b2 + hstep, voffB);
            PG8_WAIT_V(6); PG8_BAR; PG8_MMA(1, 1, At, B1); PG8_BAR;
            PG8_LDB(B0, 1, 0); PG8_SCHED; PG8_LDA(At, 1, 0); PG8_STAGE(PG8_SA(0, 1), a2 + hstep, voffA);
            PG8_WAIT_L(8); PG8_BAR; PG8_WAIT_L(0); PG8_MMA(0, 0, At, B0); PG8_BAR; PG8_SCHED;
            PG8_LDB(B1, 1, 1); PG8_STAGE(PG8_SB(1, 0), b3, voffB);
            PG8_BAR; PG8_WAIT_L(0); PG8_MMA(0, 1, At, B1); PG8_BAR;
            PG8_LDA(At, 1, 1); PG8_STAGE(PG8_SA(1, 0), a3, voffA);
            PG8_BAR; PG8_WAIT_L(0); PG8_MMA(1, 0, At, B0); PG8_BAR; PG8_SCHED;
            PG8_STAGE(PG8_SB(1, 1), b3 + hstep, voffB);
            PG8_WAIT_V(6); PG8_BAR; PG8_MMA(1, 1, At, B1); PG8_BAR;
            }
        }
        if constexpr (ALIGN_EPI) { if (wr == 0) PG8_BAR; }
        if constexpr (!Epi::AFTER_DRAIN) { E(acc, cur, wr, wc, fr, fq); S.done(cur); }
        if (!has_next) break;
#pragma unroll
        for (int a = 0; a < 2; ++a)
#pragma unroll
            for (int b = 0; b < 2; ++b)
#pragma unroll
                for (int m = 0; m < 4; ++m)
#pragma unroll
                    for (int n = 0; n < 2; ++n) acc[a][b][m][n] = (f32x4){0.f, 0.f, 0.f, 0.f};
        cur = nxt; cA = nA; cB = nB; ++ui;
        if constexpr (ALIGN_EPI) { if (wr == 1) PG8_BAR; }
    }
    PG8_WAIT_V(0);
    if constexpr (!ALIGN_EPI) { if (wr == 0) PG8_BAR; }
    PG8_BAR;
    if constexpr (Epi::AFTER_DRAIN) { E.fused(acc, cur, wr, wc, fr, fq, lds, wid, lane); S.done(cur); }
#undef PG8_SA
#undef PG8_SB
#undef PG8_STAGE
#undef PG8_LDA
#undef PG8_LDB
#undef PG8_MMA
#undef PG8_WAIT_V
#undef PG8_WAIT_L
#undef PG8_BAR
#undef PG8_SCHED
}
}

constexpr int NWAVES = 8;
#ifndef MK_N_LAUNCHES
#define MK_N_LAUNCHES 1
#endif
constexpr int N_LAUNCHES = MK_N_LAUNCHES;
constexpr int N_PHASES = 17;

constexpr int BATCH = 16, SEQ = 2048, DM = 1024, M = BATCH * SEQ;
constexpr int EVEN_IN = 3072, ODD_IN = 2560;
constexpr float EPS = 1e-6f;

constexpr size_t MiB = 1u << 20;
constexpr size_t WS_CTL = 0, CTL_ZERO_BYTES = 1 * MiB;
constexpr size_t WS_WIN0 = 2 * MiB;
constexpr size_t WS_WOUT0 = 8 * MiB;
constexpr size_t WS_WIN1 = 10 * MiB;
constexpr size_t WS_WGLU = 15 * MiB;
constexpr size_t WS_WPW = 16 * MiB;
constexpr size_t WS_WPOOL = 17 * MiB;
constexpr size_t WS_WOUT1 = 18 * MiB;
constexpr size_t WS_ROPE = 20 * MiB;
constexpr size_t WS_S5C = 21 * MiB;
constexpr size_t WS_KBAR = 22 * MiB;
constexpr size_t WS_XN = 32 * MiB;
constexpr size_t WS_Z = 96 * MiB;
constexpr size_t WS_MB = 288 * MiB;
constexpr size_t WS_Y = 352 * MiB;
constexpr size_t WS_T1 = 416 * MiB;
constexpr size_t WS_T2 = 448 * MiB;
constexpr size_t WS_END = 480 * MiB;
constexpr int CW_BAR = 4096;

constexpr int RING_OFF = 0, RING_BYTES = 131072;
constexpr int LDSCTL_OFF = RING_BYTES, MISC_OFF = LDSCTL_OFF + 320;
constexpr int LDS_BYTES = 147456;

#define GAS __attribute__((address_space(1)))
#define LAS __attribute__((address_space(3)))
typedef unsigned short bf16;
typedef unsigned v4u __attribute__((ext_vector_type(4)));
typedef unsigned v2u __attribute__((ext_vector_type(2)));
typedef float f32x4 __attribute__((ext_vector_type(4)));
#define LDS_WAIT() asm volatile("s_waitcnt lgkmcnt(0)" ::: "memory")
#define VM_WAIT() asm volatile("s_waitcnt vmcnt(0)" ::: "memory")
__device__ __forceinline__ unsigned f2bf(float f) { unsigned u = __builtin_bit_cast(unsigned, f); return (u + 0x7fffu + ((u >> 16) & 1u)) >> 16; }
__device__ __forceinline__ unsigned pk2(float lo, float hi) { return f2bf(lo) | (f2bf(hi) << 16); }
__device__ __forceinline__ float bf2f(unsigned short v) { return __builtin_bit_cast(float, (unsigned)v << 16); }
__device__ __forceinline__ float bflo(unsigned w) { return __builtin_bit_cast(float, w << 16); }
__device__ __forceinline__ float bfhi(unsigned w) { return __builtin_bit_cast(float, w & 0xffff0000u); }
__device__ __forceinline__ float sigmoidf_(float x) { return 1.0f / (1.0f + __expf(-x)); }
__device__ __forceinline__ float siluf_(float x) { return x / (1.0f + __expf(-x)); }

#define XB_TMO      128
#define XB_XCNT(j)  (256  + 64 * (j))
#define XB_XSUB(j)  (1280 + 64 * (j))
#define XB_XGEN(j)  (2304 + 64 * (j))
#define XB_TOP      3328
#define XB_TOPGEN   3392
#define XCD_BAR_WORDS 3456
#define XB_SPIN_CAP (1u << 18)
__device__ __forceinline__ unsigned xb_ld(unsigned* p)              { return __hip_atomic_load(p, __ATOMIC_RELAXED, __HIP_MEMORY_SCOPE_AGENT); }
__device__ __forceinline__ unsigned xb_add(unsigned* p, unsigned v) { return __hip_atomic_fetch_add(p, v, __ATOMIC_RELAXED, __HIP_MEMORY_SCOPE_AGENT); }
__device__ __forceinline__ unsigned xb_xcc_id() { return (unsigned)__builtin_amdgcn_s_getreg((3 << 11) | 20) & 0xFu; }
#define XB_SPIN(cond, bar) do { unsigned _sp = 0; while (cond) { __builtin_amdgcn_s_sleep(1); \
    if ((++_sp & 255u) == 0u) { if (xb_ld(&(bar)[XB_TMO])) break; if (_sp > XB_SPIN_CAP) { atomicAdd(&(bar)[XB_TMO], 1u); break; } } } } while (0)
struct XcdBarrier { unsigned* bar; unsigned x; volatile LAS unsigned* st; };
__device__ __forceinline__ XcdBarrier xcd_barrier_post(unsigned* bar, volatile LAS unsigned* st) {
    XcdBarrier b; b.bar = bar; b.x = xb_xcc_id(); b.st = st;
    if (threadIdx.x == 0) (void)xb_add(&bar[XB_XCNT(b.x)], 1u);
    return b;
}
__device__ __forceinline__ void xcd_barrier_complete(unsigned* bar, unsigned x, unsigned& nloc, unsigned& nx) {
    const unsigned G = gridDim.x * gridDim.y * gridDim.z;
    unsigned sum, cnt, mine, sp = 0u;
    for (;;) {
        sum = 0u; cnt = 0u; mine = 0u;
#pragma unroll
        for (unsigned j = 0; j < 16; ++j) { const unsigned c = xb_ld(&bar[XB_XCNT(j)]); sum += c; cnt += (c > 0u) ? 1u : 0u; mine = (j == x) ? c : mine; }
        if (sum == G) break;
        __builtin_amdgcn_s_sleep(1);
        if ((++sp & 255u) == 0u) { if (xb_ld(&bar[XB_TMO])) break; if (sp > XB_SPIN_CAP) { atomicAdd(&bar[XB_TMO], 1u); break; } }
    }
    nloc = mine > 0u ? mine : 1u; nx = cnt > 0u ? cnt : 1u;
}
__device__ __forceinline__ void xcd_barrier(const XcdBarrier& b) {
    asm volatile("s_waitcnt vmcnt(0)" ::: "memory");
    __syncthreads();
    if (threadIdx.x == 0) {
        unsigned* bar = b.bar;
        __builtin_amdgcn_s_waitcnt(0);
        unsigned nloc = b.st[0], nx = b.st[1];
        if (nloc == 0u) { xcd_barrier_complete(bar, b.x, nloc, nx); b.st[0] = nloc; b.st[1] = nx; }
        const unsigned old = xb_add(&bar[XB_XSUB(b.x)], 1u);
        const unsigned gen = old / nloc;
        if (old + 1u == (gen + 1u) * nloc) {
            __builtin_amdgcn_fence(__ATOMIC_RELEASE, "agent");
            asm volatile("s_waitcnt vmcnt(0)" ::: "memory");
            const unsigned og = xb_add(&bar[XB_TOP], 1u);
            const unsigned tg = og / nx;
            if (og + 1u == (tg + 1u) * nx) xb_add(&bar[XB_TOPGEN], 1u);
            else XB_SPIN(xb_ld(&bar[XB_TOPGEN]) == tg, bar);
            __builtin_amdgcn_fence(__ATOMIC_ACQUIRE, "agent");
            xb_add(&bar[XB_XGEN(b.x)], 1u);
            asm volatile("s_waitcnt vmcnt(0)" ::: "memory");
        } else {
            XB_SPIN(xb_ld(&bar[XB_XGEN(b.x)]) == gen, bar);
            __builtin_amdgcn_fence(__ATOMIC_ACQUIRE, "agent");
            asm volatile("s_waitcnt vmcnt(0)" ::: "memory");
        }
    }
    __syncthreads();
}

struct Frame {
    LAS unsigned char* lds;
    int tid, lane, wave;
    int vcu, G, gw, NGW;
    const float* in[23]; float* out; unsigned char* ws;
};
__device__ __forceinline__ float wave_sum(float v) {
#pragma unroll
    for (int o = 1; o < 64; o <<= 1) v += __shfl_xor(v, o);
    return v;
}
__device__ __forceinline__ float wave_max(float v) {
#pragma unroll
    for (int o = 1; o < 64; o <<= 1) v = fmaxf(v, __shfl_xor(v, o));
    return v;
}

__device__ __forceinline__ void p0_transpose_item(const float* W, int K, int N, bf16* WT, const float* gk, LAS float* scr, int item, int lane) {
    const int nblk = N / 32, kb = item / nblk, nb = item % nblk, k0 = 64 * kb, n0 = 32 * nb;
#pragma unroll 8
    for (int i = 0; i < 32; ++i) { const int kk = 2 * i + (lane >> 5); float v = W[(size_t)(k0 + kk) * N + n0 + (lane & 31)]; if (gk) v *= gk[k0 + kk]; scr[kk * 33 + (lane & 31)] = v; }
    LDS_WAIT(); asm volatile("" ::: "memory");
    const int c = lane & 7;
#pragma unroll
    for (int j = 0; j < 4; ++j) { const int n = (lane >> 3) + 8 * j; const LAS float* s = scr + (8 * c) * 33 + n;
        v4u o; o.x = pk2(s[0 * 33], s[1 * 33]); o.y = pk2(s[2 * 33], s[3 * 33]); o.z = pk2(s[4 * 33], s[5 * 33]); o.w = pk2(s[6 * 33], s[7 * 33]);
        *(GAS v4u*)(WT + (size_t)(n0 + n) * K + k0 + 8 * c) = o; }
    LDS_WAIT(); asm volatile("" ::: "memory");
}

__device__ __forceinline__ void ph_prologue(Frame& F) {
    LAS float* scr = (LAS float*)(F.lds + RING_OFF + F.wave * 16384);
    unsigned char* ws = F.ws;
    const int I_IN0 = (1024 / 64) * (EVEN_IN / 32), I_SQ = (1024 / 64) * (1024 / 32), I_IN1 = (1024 / 64) * (ODD_IN / 32), I_GLU = (512 / 64) * (1024 / 32), I_PW = (512 / 64) * (512 / 32);
    const int NITEMS = I_IN0 + I_SQ + I_IN1 + I_GLU + I_PW + I_SQ;
    for (int it = F.gw; it < NITEMS; it += F.NGW) {
        int r = it;
        if (r < I_IN0) { p0_transpose_item(F.in[3], 1024, EVEN_IN, (bf16*)(ws + WS_WIN0), F.in[1], scr, r, F.lane); continue; } r -= I_IN0;
        if (r < I_SQ) { p0_transpose_item(F.in[6], 1024, 1024, (bf16*)(ws + WS_WOUT0), nullptr, scr, r, F.lane); continue; } r -= I_SQ;
        if (r < I_IN1) { p0_transpose_item(F.in[7], 1024, ODD_IN, (bf16*)(ws + WS_WIN1), F.in[1] + 1024, scr, r, F.lane); continue; } r -= I_IN1;
        if (r < I_GLU) { p0_transpose_item(F.in[16], 512, 1024, (bf16*)(ws + WS_WGLU), nullptr, scr, r, F.lane); continue; } r -= I_GLU;
        if (r < I_PW) { p0_transpose_item(F.in[21], 512, 512, (bf16*)(ws + WS_WPW), nullptr, scr, r, F.lane); continue; } r -= I_PW;
        p0_transpose_item(F.in[22], 1024, 1024, (bf16*)(ws + WS_WOUT1), nullptr, scr, r, F.lane);
    }
    const int gt = F.gw * 64 + F.lane, NGT = F.NGW * 64;
    { bf16* wp = (bf16*)(ws + WS_WPOOL); const float* pw = F.in[4]; const float* ps = F.in[5];
      for (int i = gt; i < 512 * 512; i += NGT) { const int n = i >> 9, k = i & 511; float v = 0.f;
          if ((n >> 7) == (k >> 7)) v = pw[(size_t)(n >> 7) * 16384 + (k & 127) * 128 + (n & 127)] * ps[n];
          wp[i] = (bf16)f2bf(v); } }
    { float* rt = (float*)(ws + WS_ROPE);
      for (int i = gt; i < SEQ * 16; i += NGT) { const int t = i >> 4, j = i & 15;
          const float inv = (float)pow(500000.0, -(double)(2 * j) / 32.0); const float ang = (float)t * inv;
          rt[2 * i] = (float)cos((double)ang); rt[2 * i + 1] = (float)sin((double)ang); } }
    { float* sc = (float*)(ws + WS_S5C); float* Lre = sc, *Lim = sc + 2048, *BBre = sc + 4096, *BBim = sc + 4096 + 32768;
      const float* lam_re = F.in[8]; const float* lam_im = F.in[9]; const float* log_dt = F.in[10]; const float* b_re = F.in[11]; const float* b_im = F.in[12];
      for (int i = gt; i < 2048; i += NGT) { const int g = i >> 6;
          const double lr = lam_re[i], li = lam_im[i], dt = exp((double)log_dt[g]);
          const double mag = exp(lr * dt), are = mag * cos(li * dt), aim = mag * sin(li * dt);
          const double den = lr * lr + li * li, nre = are - 1.0;
          const double fre = (nre * lr + aim * li) / den, fim = (aim * lr - nre * li) / den;
          Lre[i] = (float)are; Lim[i] = (float)aim;
          for (int k = 0; k < 16; ++k) { const double br = b_re[(size_t)i * 16 + k], bi = b_im[(size_t)i * 16 + k];
              BBre[(size_t)i * 16 + k] = (float)(fre * br - fim * bi); BBim[(size_t)i * 16 + k] = (float)(fre * bi + fim * br); } } }
    { const float* x = F.in[0]; bf16* xn = (bf16*)(ws + WS_XN);
      for (int m = F.gw; m < M; m += F.NGW) {
          const GAS f32x4* xr = (const GAS f32x4*)(x + (size_t)m * DM) + F.lane;
          f32x4 v[4]; float s = 0.f;
#pragma unroll
          for (int j = 0; j < 4; ++j) { v[j] = xr[64 * j]; s += (v[j].x * v[j].x + v[j].y * v[j].y) + (v[j].z * v[j].z + v[j].w * v[j].w); }
          const float rstd = 1.0f / sqrtf(wave_sum(s) * (1.f / DM) + EPS);
          GAS v2u* o8 = (GAS v2u*)(xn + (size_t)m * DM) + F.lane;
#pragma unroll
          for (int j = 0; j < 4; ++j) { v2u w; w.x = pk2(v[j].x * rstd, v[j].y * rstd); w.y = pk2(v[j].z * rstd, v[j].w * rstd); o8[64 * j] = w; } } }
}

__device__ __forceinline__ void ph_rope(Frame& F) {
    bf16* Z = (bf16*)(F.ws + WS_Z); const float* rt = (const float*)(F.ws + WS_ROPE);
    const int gt = F.gw * 64 + F.lane, NGT = F.NGW * 64;
    for (int i = gt; i < M * 128; i += NGT) {
        const int row = i >> 7, r = i & 127, which = r >> 6, h = (r >> 4) & 3, j = r & 15, t = row & (SEQ - 1);
        bf16* p = Z + (size_t)row * EVEN_IN + which * 512 + h * 128 + j;
        const float x1 = bf2f(p[0]), x2 = bf2f(p[16]), c = rt[(t * 16 + j) * 2], s = rt[(t * 16 + j) * 2 + 1];
        p[0] = (bf16)f2bf(x1 * c - x2 * s); p[16] = (bf16)f2bf(x2 * c + x1 * s);
    }
}
__device__ __forceinline__ void ph_kbar(Frame& F) {
    const bf16* Z = (const bf16*)(F.ws + WS_Z); float* kb = (float*)(F.ws + WS_KBAR);
    const int gt = F.gw * 64 + F.lane, NGT = F.NGW * 64;
    for (int i = gt; i < BATCH * 8 * 512; i += NGT) { const int bn = i >> 9, c = i & 511; float s = 0.f;
        const bf16* p = Z + (size_t)bn * 256 * EVEN_IN + 512 + c;
        for (int k = 0; k < 256; ++k) s += bf2f(p[(size_t)k * EVEN_IN]);
        kb[i] = s * (1.f / 256.f); }
}
__device__ __forceinline__ void ph_attn_naive(Frame& F) {
    const bf16* Z = (const bf16*)(F.ws + WS_Z); const float* kbar = (const float*)(F.ws + WS_KBAR); bf16* MB = (bf16*)(F.ws + WS_MB);
    LAS float* qs = (LAS float*)(F.lds + RING_OFF + F.wave * 8192); LAS float* ps = qs + 128;
    const int lane = F.lane; const float scale = 0.08838834764831845f;
    for (int item = F.gw; item < M * 4; item += F.NGW) {
        const int row = item >> 2, h = item & 3, b = row >> 11, t = row & (SEQ - 1), qblk = t >> 8;
        const bf16* zrow = Z + (size_t)row * EVEN_IN;
        qs[lane] = bf2f(zrow[h * 128 + lane]); qs[lane + 64] = bf2f(zrow[h * 128 + 64 + lane]);
        LDS_WAIT(); asm volatile("" ::: "memory");
        float gate = -INFINITY;
        if (lane < 8 && lane < qblk) { const float* kb = kbar + (size_t)(b * 8 + lane) * 512 + h * 128; float a = 0.f; for (int d = 0; d < 128; ++d) a += qs[d] * kb[d]; gate = a; }
        float gv[8];
#pragma unroll
        for (int n = 0; n < 8; ++n) gv[n] = __shfl(gate, n);
        int blk[4];
#pragma unroll
        for (int r = 0; r < 3; ++r) { int best = -1; float bv = -INFINITY;
#pragma unroll
            for (int n = 0; n < 8; ++n) if (gv[n] > bv) { bv = gv[n]; best = n; }
#pragma unroll
            for (int n = 0; n < 8; ++n) if (n == best) gv[n] = -INFINITY;
            blk[r] = best; }
        blk[3] = qblk;
        float s[4][4];
#pragma unroll
        for (int j = 0; j < 4; ++j) {
#pragma unroll
            for (int i = 0; i < 4; ++i) s[j][i] = -INFINITY;
            if (blk[j] >= 0) {
#pragma unroll
                for (int i = 0; i < 4; ++i) { const int key = blk[j] * 256 + lane + 64 * i;
                    const GAS v4u* kr = (const GAS v4u*)(Z + (size_t)(b * SEQ + key) * EVEN_IN + 512 + h * 128); float a = 0.f;
                    for (int c = 0; c < 16; ++c) { const v4u w = kr[c]; const LAS float* q8 = qs + c * 8;
                        a += q8[0] * bflo(w.x) + q8[1] * bfhi(w.x) + q8[2] * bflo(w.y) + q8[3] * bfhi(w.y) + q8[4] * bflo(w.z) + q8[5] * bfhi(w.z) + q8[6] * bflo(w.w) + q8[7] * bfhi(w.w); }
                    a *= scale; if (j == 3 && key > t) a = -INFINITY; s[j][i] = a; } } }
        float mx = -INFINITY;
#pragma unroll
        for (int j = 0; j < 4; ++j)
#pragma unroll
            for (int i = 0; i < 4; ++i) mx = fmaxf(mx, s[j][i]);
        mx = wave_max(mx);
        float sum = 0.f;
#pragma unroll
        for (int j = 0; j < 4; ++j)
#pragma unroll
            for (int i = 0; i < 4; ++i) { const float p = __expf(s[j][i] - mx); sum += p; ps[j * 256 + lane + 64 * i] = p; }
        sum = wave_sum(sum);
        LDS_WAIT(); asm volatile("" ::: "memory");
        float a0 = 0.f, a1 = 0.f;
#pragma unroll
        for (int j = 0; j < 4; ++j) if (blk[j] >= 0) { const int nk = (j == 3) ? (t & 255) + 1 : 256;
            const bf16* vb = Z + (size_t)(b * SEQ + blk[j] * 256) * EVEN_IN + 1024 + h * 128 + 2 * lane;
            for (int k = 0; k < nk; ++k) { const unsigned w = *(const GAS unsigned*)(vb + (size_t)k * EVEN_IN); const float p = ps[j * 256 + k]; a0 += p * bflo(w); a1 += p * bfhi(w); } }
        const float inv = 1.0f / sum;
        const unsigned gw2 = *(const GAS unsigned*)(zrow + 1536 + h * 128 + 2 * lane);
        const float o0 = a0 * inv * siluf_(bflo(gw2)), o1 = a1 * inv * siluf_(bfhi(gw2));
        *(GAS unsigned*)(MB + (size_t)row * DM + h * 128 + 2 * lane) = pk2(o0, o1);
        LDS_WAIT(); asm volatile("" ::: "memory");
    }
}
__device__ __forceinline__ void ph_pool_naive(Frame& F) {
    const bf16* Z = (const bf16*)(F.ws + WS_Z); bf16* T1 = (bf16*)(F.ws + WS_T1);
    const int gt = F.gw * 64 + F.lane, NGT = F.NGW * 64;
    for (int i = gt; i < M * 512; i += NGT) { const int row = i >> 9, c = i & 511, g = c >> 7, w = 2 << g, t = row & (SEQ - 1);
        const int n = (t + 1 < w) ? t + 1 : w; const bf16* p = Z + (size_t)row * EVEN_IN + 2048 + c; float s = 0.f;
        for (int k = 0; k < n; ++k) s += bf2f(*(p - (size_t)k * EVEN_IN));
        T1[i] = (bf16)f2bf(s / (float)n - bf2f(p[0])); }
}
__device__ __forceinline__ void ph_pool_gate(Frame& F) {
    const bf16* Z = (const bf16*)(F.ws + WS_Z); const bf16* T2 = (const bf16*)(F.ws + WS_T2); bf16* MB = (bf16*)(F.ws + WS_MB);
    const int gt = F.gw * 64 + F.lane, NGT = F.NGW * 64;
    for (int i = gt; i < M * 512; i += NGT) { const int row = i >> 9, c = i & 511;
        MB[(size_t)row * DM + 512 + c] = (bf16)f2bf(bf2f(T2[i]) * siluf_(bf2f(Z[(size_t)row * EVEN_IN + 2560 + c]))); }
}
__device__ __forceinline__ void ph_norm_res(Frame& F, const float* base, const bf16* Y, const float* g, float* outp, bf16* xn) {
    for (int m = F.gw; m < M; m += F.NGW) {
        const GAS v2u* yr = (const GAS v2u*)(Y + (size_t)m * DM) + F.lane;
        float y[4][4]; float s = 0.f;
#pragma unroll
        for (int j = 0; j < 4; ++j) { const v2u w = yr[64 * j]; y[j][0] = bflo(w.x); y[j][1] = bfhi(w.x); y[j][2] = bflo(w.y); y[j][3] = bfhi(w.y);
            s += (y[j][0] * y[j][0] + y[j][1] * y[j][1]) + (y[j][2] * y[j][2] + y[j][3] * y[j][3]); }
        const float rstd = 1.0f / sqrtf(wave_sum(s) * (1.f / DM) + EPS);
        const GAS f32x4* br = (const GAS f32x4*)(base + (size_t)m * DM) + F.lane; const GAS f32x4* gr = (const GAS f32x4*)g + F.lane;
        GAS f32x4* orow = (GAS f32x4*)(outp + (size_t)m * DM) + F.lane;
        f32x4 x1[4]; float s1 = 0.f;
#pragma unroll
        for (int j = 0; j < 4; ++j) { const f32x4 bv = br[64 * j], gv = gr[64 * j];
            x1[j].x = bv.x + y[j][0] * rstd * gv.x; x1[j].y = bv.y + y[j][1] * rstd * gv.y; x1[j].z = bv.z + y[j][2] * rstd * gv.z; x1[j].w = bv.w + y[j][3] * rstd * gv.w;
            orow[64 * j] = x1[j]; s1 += (x1[j].x * x1[j].x + x1[j].y * x1[j].y) + (x1[j].z * x1[j].z + x1[j].w * x1[j].w); }
        if (xn) { const float r1 = 1.0f / sqrtf(wave_sum(s1) * (1.f / DM) + EPS);
            GAS v2u* o8 = (GAS v2u*)(xn + (size_t)m * DM) + F.lane;
#pragma unroll
            for (int j = 0; j < 4; ++j) { v2u w; w.x = pk2(x1[j].x * r1, x1[j].y * r1); w.y = pk2(x1[j].z * r1, x1[j].w * r1); o8[64 * j] = w; } }
    }
}
__device__ __forceinline__ void ph_s5_naive(Frame& F) {
    const bf16* Z = (const bf16*)(F.ws + WS_Z); bf16* T1 = (bf16*)(F.ws + WS_T1);
    const float* sc = (const float*)(F.ws + WS_S5C); const float* Lre = sc, *Lim = sc + 2048, *BBre = sc + 4096, *BBim = sc + 4096 + 32768;
    const float* c_re = F.in[13]; const float* c_im = F.in[14]; const float* dvec = F.in[15];
    const int lane = F.lane;
    for (int item = F.gw; item < BATCH * 32; item += F.NGW) {
        const int b = item >> 5, g = item & 31, gp = g * 64 + lane;
        const float are = Lre[gp], aim = Lim[gp];
        float bbr[16], bbi[16], cr[16], ci[16];
#pragma unroll
        for (int i = 0; i < 16; ++i) { bbr[i] = BBre[(size_t)gp * 16 + i]; bbi[i] = BBim[(size_t)gp * 16 + i]; cr[i] = c_re[(size_t)(g * 16 + i) * 64 + lane]; ci[i] = c_im[(size_t)(g * 16 + i) * 64 + lane]; }
        const float dmine = dvec[g * 16 + (lane & 15)];
        float xr = 0.f, xi = 0.f;
        for (int t = 0; t < SEQ; ++t) {
            const size_t row = (size_t)b * SEQ + t;
            const GAS v4u* up = (const GAS v4u*)(Z + row * ODD_IN + g * 16);
            const v4u w0 = up[0], w1 = up[1];
            float u[16];
            u[0] = bflo(w0.x); u[1] = bfhi(w0.x); u[2] = bflo(w0.y); u[3] = bfhi(w0.y); u[4] = bflo(w0.z); u[5] = bfhi(w0.z); u[6] = bflo(w0.w); u[7] = bfhi(w0.w);
            u[8] = bflo(w1.x); u[9] = bfhi(w1.x); u[10] = bflo(w1.y); u[11] = bfhi(w1.y); u[12] = bflo(w1.z); u[13] = bfhi(w1.z); u[14] = bflo(w1.w); u[15] = bfhi(w1.w);
            float bur = 0.f, bui = 0.f;
#pragma unroll
            for (int i = 0; i < 16; ++i) { bur += bbr[i] * u[i]; bui += bbi[i] * u[i]; }
            const float nr = are * xr - aim * xi + bur, ni = are * xi + aim * xr + bui; xr = nr; xi = ni;
            float mine = 0.f;
#pragma unroll
            for (int i = 0; i < 16; ++i) { const float v = wave_sum(xr * cr[i] - xi * ci[i]); if ((lane & 15) == i) mine = v; }
            if (lane < 16) { const float ui = bf2f(Z[row * ODD_IN + g * 16 + lane]); T1[row * 512 + g * 16 + lane] = (bf16)f2bf(mine + dmine * ui); }
        }
    }
}
__device__ __forceinline__ void ph_conv_naive(Frame& F) {
    const bf16* Z = (const bf16*)(F.ws + WS_Z); bf16* T2 = (bf16*)(F.ws + WS_T2);
    const float* dw = F.in[18]; const float* ln_g = F.in[19]; const float* ln_b = F.in[20];
    LAS float* red = (LAS float*)(F.lds + RING_OFF);
    const int c = F.tid;
    float wt[31];
#pragma unroll
    for (int j = 0; j < 31; ++j) wt[j] = dw[j * 512 + c];
    const float lg = ln_g[c], lb = ln_b[c];
    for (int row = blockIdx.x; row < M; row += F.G) {
        const int t = row & (SEQ - 1); float acc = 0.f;
#pragma unroll
        for (int j = 0; j < 31; ++j) { const int tt = t - 30 + j;
            if (tt >= 0) { const bf16* zr = Z + (size_t)(row - 30 + j) * ODD_IN; acc += bf2f(zr[1024 + c]) * sigmoidf_(bf2f(zr[1536 + c])) * wt[j]; } }
        float s = wave_sum(acc);
        __syncthreads();
        if (F.lane == 0) red[F.wave] = s;
        __syncthreads();
        float tot = 0.f;
#pragma unroll
        for (int w = 0; w < 8; ++w) tot += red[w];
        const float mu = tot * (1.f / 512.f), dlt = acc - mu;
        float q = wave_sum(dlt * dlt);
        __syncthreads();
        if (F.lane == 0) red[F.wave] = q;
        __syncthreads();
        float qt = 0.f;
#pragma unroll
        for (int w = 0; w < 8; ++w) qt += red[w];
        const float nrm = dlt * (1.0f / sqrtf(qt * (1.f / 512.f) + EPS)) * lg + lb;
        T2[(size_t)row * 512 + c] = (bf16)f2bf(siluf_(nrm));
    }
    __syncthreads();
}
__device__ __forceinline__ void ph_glu_gate(Frame& F) {
    const bf16* Z = (const bf16*)(F.ws + WS_Z); const bf16* Y = (const bf16*)(F.ws + WS_Y); bf16* MB = (bf16*)(F.ws + WS_MB); const float* gb = F.in[17];
    const int gt = F.gw * 64 + F.lane, NGT = F.NGW * 64;
    for (int i = gt; i < M * 512; i += NGT) { const int row = i >> 9, c = i & 511;
        const float ya = bf2f(Y[(size_t)row * 1024 + c]) + gb[c], yb = bf2f(Y[(size_t)row * 1024 + 512 + c]) + gb[512 + c];
        MB[(size_t)row * DM + c] = (bf16)f2bf(ya * sigmoidf_(yb) * siluf_(bf2f(Z[(size_t)row * ODD_IN + 512 + c]))); }
}
__device__ __forceinline__ void ph_conv_gate(Frame& F) {
    const bf16* Z = (const bf16*)(F.ws + WS_Z); const bf16* Y = (const bf16*)(F.ws + WS_Y); bf16* MB = (bf16*)(F.ws + WS_MB);
    const int gt = F.gw * 64 + F.lane, NGT = F.NGW * 64;
    for (int i = gt; i < M * 512; i += NGT) { const int row = i >> 9, c = i & 511;
        MB[(size_t)row * DM + 512 + c] = (bf16)f2bf(bf2f(Y[i]) * siluf_(bf2f(Z[(size_t)row * ODD_IN + 2048 + c]))); }
}

struct Args { const float* in[23]; float* out; unsigned char* ws; int ph_lo, ph_hi; };
__global__ void __launch_bounds__(NWAVES * 64, 2) fwd_kernel(Args args) {
    extern __shared__ __attribute__((aligned(16))) unsigned char lds[];
    Frame F;
    F.lds = (LAS unsigned char*)lds;
    volatile LAS unsigned* MISC = (volatile LAS unsigned*)(F.lds + MISC_OFF);
    F.tid = threadIdx.x; F.lane = F.tid & 63; F.wave = __builtin_amdgcn_readfirstlane(F.tid >> 6);
    F.G = gridDim.x; { const int bx = blockIdx.x; F.vcu = (F.G % 8 == 0) ? (bx % 8) * (F.G / 8) + bx / 8 : bx; }
    F.gw = blockIdx.x * NWAVES + F.wave; F.NGW = F.G * NWAVES;
#pragma unroll
    for (int i = 0; i < 23; ++i) F.in[i] = args.in[i];
    F.out = args.out; F.ws = args.ws;
    unsigned* ctl = (unsigned*)(args.ws + WS_CTL);
    for (int u = F.tid; u < (LDS_BYTES - LDSCTL_OFF) / 4; u += NWAVES * 64) ((LAS unsigned*)(F.lds + LDSCTL_OFF))[u] = 0u;
    __syncthreads();
    XcdBarrier bar; bar.bar = ctl + CW_BAR; bar.x = 0; bar.st = nullptr;
    if (N_LAUNCHES == 1) bar = xcd_barrier_post(ctl + CW_BAR, MISC + 8);
#define GRID_BAR() do { if (N_LAUNCHES == 1) xcd_barrier(bar); } while (0)
    const int lo = args.ph_lo, hi = args.ph_hi;
#define IN(k) (lo <= (k) && (k) < hi)
#define BOTH(k) (IN(k) && IN((k) + 1))
    unsigned char* ws = args.ws;
    bf16* XN = (bf16*)(ws + WS_XN); bf16* Z = (bf16*)(ws + WS_Z); bf16* MB = (bf16*)(ws + WS_MB); bf16* Y = (bf16*)(ws + WS_Y); bf16* T1 = (bf16*)(ws + WS_T1); bf16* T2 = (bf16*)(ws + WS_T2);
    typedef pg8::EpiBf16<0> EpiP;
#define GEMM_PLAIN(Aptr, Wptr, Nn, Kk, Optr, ldc_) do { pg8::Gemm g{(const pg8::bf16_t*)(Aptr), (const pg8::bf16_t*)(Wptr), M, (Nn), (Kk)}; pg8::StaticOrder S; S.init(M, (Nn), F.G, (int)blockIdx.x); \
        EpiP E{(pg8::bf16_t*)(Optr), (ldc_), nullptr, 0, 0, 1.f}; pg8::gemm_phase<EpiP, pg8::StaticOrder, true, true>(F.lds + RING_OFF, g, S, E); } while (0)

    if (IN(0)) { ph_prologue(F); if (BOTH(0)) GRID_BAR(); }
    if (IN(1)) { GEMM_PLAIN(XN, ws + WS_WIN0, EVEN_IN, 1024, Z, EVEN_IN); if (BOTH(1)) GRID_BAR(); }
    if (IN(2)) { ph_rope(F); if (BOTH(2)) GRID_BAR(); }
    if (IN(3)) { ph_kbar(F); if (BOTH(3)) GRID_BAR(); }
    if (IN(4)) { ph_attn_naive(F); ph_pool_naive(F); if (BOTH(4)) GRID_BAR(); }
    if (IN(5)) { GEMM_PLAIN(T1, ws + WS_WPOOL, 512, 512, T2, 512); if (BOTH(5)) GRID_BAR(); }
    if (IN(6)) { ph_pool_gate(F); if (BOTH(6)) GRID_BAR(); }
    if (IN(7)) { GEMM_PLAIN(MB, ws + WS_WOUT0, 1024, 1024, Y, 1024); if (BOTH(7)) GRID_BAR(); }
    if (IN(8)) { ph_norm_res(F, F.in[0], Y, F.in[2], F.out, XN); if (BOTH(8)) GRID_BAR(); }
    if (IN(9)) { GEMM_PLAIN(XN, ws + WS_WIN1, ODD_IN, 1024, Z, ODD_IN); if (BOTH(9)) GRID_BAR(); }
    if (IN(10)) { ph_s5_naive(F); ph_conv_naive(F); if (BOTH(10)) GRID_BAR(); }
    if (IN(11)) { GEMM_PLAIN(T1, ws + WS_WGLU, 1024, 512, Y, 1024); if (BOTH(11)) GRID_BAR(); }
    if (IN(12)) { ph_glu_gate(F); if (BOTH(12)) GRID_BAR(); }
    if (IN(13)) { GEMM_PLAIN(T2, ws + WS_WPW, 512, 512, Y, 512); if (BOTH(13)) GRID_BAR(); }
    if (IN(14)) { ph_conv_gate(F); if (BOTH(14)) GRID_BAR(); }
    if (IN(15)) { GEMM_PLAIN(MB, ws + WS_WOUT1, 1024, 1024, Y, 1024); if (BOTH(15)) GRID_BAR(); }
    if (IN(16)) { ph_norm_res(F, F.out, Y, F.in[2] + 1024, F.out, nullptr); }
#undef IN
#undef BOTH
}

extern "C" void kernel_launch(void* const* d_in, const int* in_sizes, int n_in, void* d_out, int out_size, void* d_ws, size_t ws_size, hipStream_t stream) {
    static int grid = 0;
    if (grid == 0) {
        if (n_in != 23 || in_sizes[0] != M * DM || out_size != M * DM || ws_size < WS_END) { fprintf(stderr, "kernel_launch: unexpected shapes n_in %d in0 %d out %d ws %zu\n", n_in, n_in > 0 ? in_sizes[0] : -1, out_size, ws_size); grid = -1; return; }
        int dev = 0, cus = 0, per_cu = 0;
        if (hipGetDevice(&dev) != hipSuccess || hipDeviceGetAttribute(&cus, hipDeviceAttributeMultiprocessorCount, dev) != hipSuccess) { grid = -1; return; }
        if (hipFuncSetAttribute((const void*)fwd_kernel, hipFuncAttributeMaxDynamicSharedMemorySize, LDS_BYTES) != hipSuccess) { fprintf(stderr, "kernel_launch: hipFuncSetAttribute failed\n"); grid = -1; return; }
        if (hipOccupancyMaxActiveBlocksPerMultiprocessor(&per_cu, (const void*)fwd_kernel, NWAVES * 64, LDS_BYTES) != hipSuccess || per_cu < 1) fprintf(stderr, "kernel_launch: occupancy query reports %d\n", per_cu);
        (void)hipGetLastError();
        grid = cus;
    }
    if (grid < 0) return;
    (void)hipMemsetAsync((char*)d_ws + WS_CTL, 0, CTL_ZERO_BYTES, stream);
    Args a{};
    for (int i = 0; i < 23; ++i) a.in[i] = (const float*)d_in[i];
    a.out = (float*)d_out; a.ws = (unsigned char*)d_ws;
    if (N_LAUNCHES == 1) { a.ph_lo = 0; a.ph_hi = N_PHASES; hipLaunchKernelGGL(fwd_kernel, dim3(grid), dim3(NWAVES * 64), LDS_BYTES, stream, a); }
    else for (int p = 0; p < N_PHASES; ++p) { a.ph_lo = p; a.ph_hi = p + 1; hipLaunchKernelGGL(fwd_kernel, dim3(grid), dim3(NWAVES * 64), LDS_BYTES, stream, a); }
}
```

```cpp
#include <hip/hip_runtime.h>
#include <cstdio>
#include <cstdint>
#include <cmath>
#define MK_N_LAUNCHES 1
namespace pg8 {
#define PG8_LAS __attribute__((address_space(3)))
typedef unsigned short bf16_t;
typedef short bf16x8 __attribute__((ext_vector_type(8)));
typedef float f32x4 __attribute__((ext_vector_type(4)));
typedef unsigned u32x4 __attribute__((ext_vector_type(4)));
constexpr int BM = 256, BK = 64, HALF = 128, HTB = HALF * BK * 2  , STAGE_BYTES = 8 * HTB, NXCD = 8, WGM = 8;

__host__ __device__ __forceinline__ int lds_byte(int r, int c) { const int st = (r >> 4) * 2 + (c >> 5), rr = r & 15, cc = c & 31, ob = rr * 64 + cc * 2; return st * 1024 + (ob ^ (((ob >> 9) & 1) << 5)); }
__host__ __device__ __forceinline__ void stage_rc(int b, int& R, int& C) { const int st = b / 1024, sb = b % 1024, swz = sb ^ (((sb >> 9) & 1) << 5); R = (st >> 1) * 16 + swz / 64; C = (st & 1) * 32 + (swz % 64) / 2; }
__host__ __device__ __forceinline__ int perm32(int rho) { const int n = rho >> 4, i = rho & 15; return 8 * (i >> 2) + 4 * n + (i & 3); }

struct Unit { int pm, pn; };
struct Gemm { const bf16_t* A; const bf16_t* Bt; int M, N, K; };

struct StaticOrder {
    int nM, nN, nwg, G, c;
    __host__ __device__ void init(int M, int N, int G_, int c_) { nM = M / BM; nN = N / BM; nwg = nM * nN; G = G_; c = c_; }
    __host__ __device__ bool next(int i, Unit& u) const {
        const long L = (long)i * G + c; if (L >= nwg) return false;
        int wgid = (int)L; { const int q = nwg / NXCD, r = nwg % NXCD, xcd = wgid % NXCD, off = wgid / NXCD; wgid = (xcd < r ? xcd * (q + 1) : r * (q + 1) + (xcd - r) * q) + off; }
        const int nig = WGM * nN, gid = wgid / nig, fm = gid * WGM, gsz = (nM - fm) < WGM ? (nM - fm) : WGM;
        u.pm = fm + ((wgid % nig) % gsz); u.pn = (wgid % nig) / gsz; return true;
    }
    __device__ __forceinline__ void a_ready(const Unit&) const {}
    __device__ __forceinline__ void done(const Unit&) const {}
};

__device__ __forceinline__ unsigned cvt_pk_bf16(float lo, float hi) { unsigned r; asm volatile("v_cvt_pk_bf16_f32 %0, %1, %2" : "=v"(r) : "v"(lo), "v"(hi)); return r; }
typedef float f32x2 __attribute__((ext_vector_type(2)));
__device__ __forceinline__ f32x2 gelu_pk(f32x2 v) {
    const f32x2 av = __builtin_elementwise_abs(v), d = av * 0.2316418882f + 1.0f;
    f32x2 t; t.x = __builtin_amdgcn_rcpf(d.x); t.y = __builtin_amdgcn_rcpf(d.y);
    f32x2 q = t * 0.5307027145f + (-0.7265760135f); q = q * t + 0.7107068705f; q = q * t + (-0.142248368f); q = q * t + 0.127414796f; q = q * t;
    const f32x2 s = (v * v) * (-0.72134752044f);
    f32x2 e; e.x = __builtin_amdgcn_exp2f(s.x); e.y = __builtin_amdgcn_exp2f(s.y);
    const f32x2 m = v * (q * e), r = v - m;
    f32x2 o; o.x = v.x < 0.f ? m.x : r.x; o.y = v.y < 0.f ? m.y : r.y; return o;
}

template <int ACT  > struct EpiBf16 {
    static constexpr bool PERM = true, AFTER_DRAIN = false; static_assert(ACT == 0 || ACT == 1, "EpiBf16: ACT is 0 (none) or 1 (gelu_pk)");
    bf16_t* O; int ldc; const float* bias; int split_cols; size_t split_stride; float scale0;
    __device__ __forceinline__ void operator()(const f32x4 (&acc)[2][2][4][2], const Unit& u, int wr, int wc, int fr, int fq) const {
        const int row0 = u.pm * BM + wr * 64 + fr; int colt = u.pn * BM; bf16_t* base = O;
        float sc = 1.f; if (split_cols) { const int t = colt / split_cols; base += (size_t)t * split_stride; colt -= t * split_cols; if (t == 0) sc = scale0; }
        const int col0 = colt + wc * 32 + 8 * fq, bcol0 = u.pn * BM + wc * 32 + 8 * fq;
        f32x4 bv[2][2];
#pragma unroll
        for (int bj = 0; bj < 2; ++bj)
#pragma unroll
            for (int n = 0; n < 2; ++n) bv[bj][n] = bias ? *(const f32x4*)(bias + bcol0 + bj * HALF + 4 * n) : (f32x4){0.f, 0.f, 0.f, 0.f};
#pragma unroll
        for (int ai = 0; ai < 2; ++ai)
#pragma unroll
            for (int m = 0; m < 4; ++m) { bf16_t* rowp = base + (size_t)(row0 + ai * HALF + m * 16) * ldc + col0;
#pragma unroll
                for (int bj = 0; bj < 2; ++bj) { f32x4 v0 = acc[ai][bj][m][0] + bv[bj][0], v1 = acc[ai][bj][m][1] + bv[bj][1];
                    if (ACT == 1) { f32x2 a = gelu_pk((f32x2){v0[0], v0[1]}), b = gelu_pk((f32x2){v0[2], v0[3]}), c = gelu_pk((f32x2){v1[0], v1[1]}), d = gelu_pk((f32x2){v1[2], v1[3]});
                        v0 = (f32x4){a.x, a.y, b.x, b.y}; v1 = (f32x4){c.x, c.y, d.x, d.y}; }
                    v0 = v0 * sc; v1 = v1 * sc; u32x4 w; w.x = cvt_pk_bf16(v0[0], v0[1]); w.y = cvt_pk_bf16(v0[2], v0[3]); w.z = cvt_pk_bf16(v1[0], v1[1]); w.w = cvt_pk_bf16(v1[2], v1[3]);
                    *(u32x4*)(rowp + bj * HALF) = w; } }
    }
};

struct PanelStats {
    unsigned* xbuf;
    unsigned* cnt;
    unsigned* tmo;
    int ntn; float eps;
    unsigned code;
    __device__ __forceinline__ bool run(const f32x4 (&v)[2][2][4][2], const Unit& u, int wr, int wc, int fr, int fq, PG8_LAS unsigned char* lds, int wid, int lane) const {
        typedef float f32x2v __attribute__((ext_vector_type(2)));
        PG8_LAS f32x2v* P = (PG8_LAS f32x2v*)lds;
        PG8_LAS f32x2v* S = (PG8_LAS f32x2v*)(lds + 8192);
        PG8_LAS unsigned* flag = (PG8_LAS unsigned*)(lds + 8192 + 2048);
#pragma unroll
        for (int ai = 0; ai < 2; ++ai)
#pragma unroll
            for (int m = 0; m < 4; ++m) {
                float s = 0.f;
#pragma unroll
                for (int bj = 0; bj < 2; ++bj)
#pragma unroll
                    for (int n = 0; n < 2; ++n) { const f32x4 x = v[ai][bj][m][n]; s += (x[0] + x[1]) + (x[2] + x[3]); }
                s += __shfl_xor(s, 16); s += __shfl_xor(s, 32);
                const float mw = s * (1.0f / 64.0f); float q = 0.f;
#pragma unroll
                for (int bj = 0; bj < 2; ++bj)
#pragma unroll
                    for (int n = 0; n < 2; ++n) { const f32x4 d = v[ai][bj][m][n] - mw; q += (d[0] * d[0] + d[1] * d[1]) + (d[2] * d[2] + d[3] * d[3]); }
                q += __shfl_xor(q, 16); q += __shfl_xor(q, 32);
                if (fq == 0) P[(ai * HALF + wr * 64 + m * 16 + fr) * 4 + wc] = (f32x2v){mw, q};
            }
        asm volatile("s_waitcnt lgkmcnt(0)" ::: "memory"); __builtin_amdgcn_s_barrier(); asm volatile("" ::: "memory");
#if defined(BROKEN_EXCHANGE_NO_WAIT)
#warning BROKEN CONTROL BUILD: the row-statistics exchange does not wait; results are wrong by design
        if (blockIdx.x >= 64) { const long long t0_ = clock64(); while (clock64() - t0_ < 60000) __builtin_amdgcn_s_sleep(8); }
#endif
        const int row = wid * 32 + (lane & 31);
        if (lane < 32) {
            const f32x2v a = P[row * 4 + 0], b = P[row * 4 + 1], c = P[row * 4 + 2], d = P[row * 4 + 3];
            const float mt = (a.x + b.x + c.x + d.x) * 0.25f;
            const float da = a.x - mt, db = b.x - mt, dc = c.x - mt, dd = d.x - mt;
            const float m2 = (a.y + b.y) + (c.y + d.y) + 64.0f * ((da * da + db * db) + (dc * dc + dd * dd));
            unsigned long long* slot = (unsigned long long*)xbuf + ((size_t)(u.pm * BM + row) * 4 + u.pn);
            __hip_atomic_store(slot, ((unsigned long long)__float_as_uint(m2) << 32) | __float_as_uint(mt), __ATOMIC_RELAXED, __HIP_MEMORY_SCOPE_AGENT);
        }
        asm volatile("s_waitcnt vmcnt(0)" ::: "memory");
        if (lane == 0) __hip_atomic_fetch_add(cnt + 64 * u.pm, 1u, __ATOMIC_RELAXED, __HIP_MEMORY_SCOPE_AGENT);
        if (wid == 0) {
            bool dead = false; const unsigned long long t0 = __builtin_amdgcn_s_memrealtime(); const unsigned want = 8u * (unsigned)ntn;
            for (;;) {
#if defined(BROKEN_EXCHANGE_NO_WAIT)
                break;
#endif
                if ((unsigned)__builtin_amdgcn_readfirstlane(__hip_atomic_load(cnt + 64 * u.pm, __ATOMIC_RELAXED, __HIP_MEMORY_SCOPE_AGENT)) >= want) break;
                if (__builtin_amdgcn_s_memrealtime() - t0 > 2000000ull) {
                    if (lane == 0) { unsigned expect = 0u; __hip_atomic_compare_exchange_strong(tmo + 1, &expect, code | (unsigned)(u.pm & 0xff), __ATOMIC_RELAXED, __ATOMIC_RELAXED, __HIP_MEMORY_SCOPE_AGENT);
                                     __hip_atomic_store(tmo, 1u, __ATOMIC_RELAXED, __HIP_MEMORY_SCOPE_AGENT); }
                    dead = true; break; }
                __builtin_amdgcn_s_sleep(2);
            }
            __builtin_amdgcn_fence(__ATOMIC_ACQUIRE, "agent");
            if (lane == 0) flag[0] = dead ? 1u : 0u;
        }
        asm volatile("s_waitcnt vmcnt(0) lgkmcnt(0)" ::: "memory"); __builtin_amdgcn_s_barrier(); asm volatile("" ::: "memory");
        const bool bad = flag[0] != 0u;
        if (lane < 32) {
            const unsigned long long* slot = (const unsigned long long*)xbuf + (size_t)(u.pm * BM + row) * 4; float mt[4], m2[4]; float ms = 0.f;
#pragma unroll
            for (int t = 0; t < 4; ++t) { if (t < ntn) { const unsigned long long w = __hip_atomic_load(slot + t, __ATOMIC_RELAXED, __HIP_MEMORY_SCOPE_AGENT); mt[t] = __uint_as_float((unsigned)w); m2[t] = __uint_as_float((unsigned)(w >> 32)); } else { mt[t] = 0.f; m2[t] = 0.f; } ms += mt[t]; }
            const float mean = ms / (float)ntn; float q = 0.f;
#pragma unroll
            for (int t = 0; t < 4; ++t) if (t < ntn) { const float dm = mt[t] - mean; q += m2[t] + 256.0f * dm * dm; }
            S[row] = (f32x2v){mean, 1.0f / sqrtf(q / (256.0f * (float)ntn) + eps)};
        }
        asm volatile("s_waitcnt lgkmcnt(0)" ::: "memory"); __builtin_amdgcn_s_barrier(); asm volatile("" ::: "memory");
        return bad;
    }
};
struct EpiLnRes {
    static constexpr bool PERM = false, AFTER_DRAIN = true;
    const float* base; float* out; int ldc; const float* bias; PanelStats st; unsigned poison;
    __device__ __forceinline__ void fused(f32x4 (&acc)[2][2][4][2], const Unit& u, int wr, int wc, int fr, int fq, PG8_LAS unsigned char* lds, int wid, int lane) const {
        typedef float f32x2v __attribute__((ext_vector_type(2)));
        const PG8_LAS f32x2v* S = (const PG8_LAS f32x2v*)(lds + 8192);
        const int col0 = u.pn * BM + wc * 32 + 4 * fq;
#pragma unroll
        for (int bj = 0; bj < 2; ++bj)
#pragma unroll
            for (int n = 0; n < 2; ++n) { const f32x4 bv = bias ? *(const f32x4*)(bias + col0 + bj * HALF + n * 16) : (f32x4){0.f, 0.f, 0.f, 0.f};
#pragma unroll
                for (int ai = 0; ai < 2; ++ai)
#pragma unroll
                    for (int m = 0; m < 4; ++m) acc[ai][bj][m][n] += bv; }
        f32x4 pre[4][2][2];
#pragma unroll
        for (int m = 0; m < 4; ++m) { const size_t off = (size_t)(u.pm * BM + wr * 64 + m * 16 + fr) * ldc + col0;
#pragma unroll
            for (int bj = 0; bj < 2; ++bj)
#pragma unroll
                for (int n = 0; n < 2; ++n) pre[m][bj][n] = *(const f32x4*)(base + off + bj * HALF + n * 16); }
        const bool bad = st.run(acc, u, wr, wc, fr, fq, lds, wid, lane) || poison != 0u;
        const float qnan = __builtin_nanf("");
#pragma unroll
        for (int ai = 0; ai < 2; ++ai)
#pragma unroll
            for (int m = 0; m < 4; ++m) { const int r = ai * HALF + wr * 64 + m * 16 + fr; const f32x2v sr = S[r]; const size_t off = (size_t)(u.pm * BM + r) * ldc + col0;
#pragma unroll
                for (int bj = 0; bj < 2; ++bj)
#pragma unroll
                    for (int n = 0; n < 2; ++n) { const f32x4 bs = ai == 0 ? pre[m][bj][n] : *(const f32x4*)(base + off + bj * HALF + n * 16); f32x4 o = bs + (acc[ai][bj][m][n] - sr.x) * sr.y;
                        if (bad) o = (f32x4){qnan, qnan, qnan, qnan}; *(f32x4*)(out + off + bj * HALF + n * 16) = o; }
                if (m & 1) asm volatile("" ::: "memory"); }
    }
};
struct EpiLnResLn {
    static constexpr bool PERM = false, AFTER_DRAIN = true;
    const float* base; float* out; bf16_t* xn; int ldc; const float* bias; PanelStats st1, st2; unsigned poison;
    __device__ __forceinline__ void fused(f32x4 (&acc)[2][2][4][2], const Unit& u, int wr, int wc, int fr, int fq, PG8_LAS unsigned char* lds, int wid, int lane) const {
        typedef float f32x2v __attribute__((ext_vector_type(2))); typedef unsigned u32x2v __attribute__((ext_vector_type(2)));
        const PG8_LAS f32x2v* S = (const PG8_LAS f32x2v*)(lds + 8192);
        const int col0 = u.pn * BM + wc * 32 + 4 * fq;
#pragma unroll
        for (int bj = 0; bj < 2; ++bj)
#pragma unroll
            for (int n = 0; n < 2; ++n) { const f32x4 bv = bias ? *(const f32x4*)(bias + col0 + bj * HALF + n * 16) : (f32x4){0.f, 0.f, 0.f, 0.f};
#pragma unroll
                for (int ai = 0; ai < 2; ++ai)
#pragma unroll
                    for (int m = 0; m < 4; ++m) acc[ai][bj][m][n] += bv; }
        bool bad = st1.run(acc, u, wr, wc, fr, fq, lds, wid, lane) || poison != 0u;
        const float qnan = __builtin_nanf("");
#pragma unroll
        for (int ai = 0; ai < 2; ++ai)
#pragma unroll
            for (int m = 0; m < 4; ++m) { const int r = ai * HALF + wr * 64 + m * 16 + fr; const f32x2v sr = S[r]; const size_t off = (size_t)(u.pm * BM + r) * ldc + col0;
#pragma unroll
                for (int bj = 0; bj < 2; ++bj)
#pragma unroll
                    for (int n = 0; n < 2; ++n) { const f32x4 bs = *(const f32x4*)(base + off + bj * HALF + n * 16); acc[ai][bj][m][n] = bs + (acc[ai][bj][m][n] - sr.x) * sr.y; }
                asm volatile("" : "+v"(acc[ai][0][m][0]), "+v"(acc[ai][0][m][1]), "+v"(acc[ai][1][m][0]), "+v"(acc[ai][1][m][1]));
                if (m & 1) asm volatile("" ::: "memory"); }
        const bool bad1 = bad;
        bad = st2.run(acc, u, wr, wc, fr, fq, lds, wid, lane) || bad;
#pragma unroll
        for (int ai = 0; ai < 2; ++ai)
#pragma unroll
            for (int m = 0; m < 4; ++m) { const int r = ai * HALF + wr * 64 + m * 16 + fr; const f32x2v sr = S[r]; const size_t off = (size_t)(u.pm * BM + r) * ldc + col0;
#pragma unroll
                for (int bj = 0; bj < 2; ++bj)
#pragma unroll
                    for (int n = 0; n < 2; ++n) { const f32x4 x1 = acc[ai][bj][m][n]; *(f32x4*)(out + off + bj * HALF + n * 16) = bad1 ? (f32x4){qnan, qnan, qnan, qnan} : x1;
                        const f32x4 o = (x1 - sr.x) * sr.y; u32x2v w; w.x = cvt_pk_bf16(o[0], o[1]); w.y = cvt_pk_bf16(o[2], o[3]);
                        if (bad) { w.x = 0x7fc07fc0u; w.y = 0x7fc07fc0u; } *(u32x2v*)(xn + off + bj * HALF + n * 16) = w; }
                asm volatile("" ::: "memory"); }
    }
};

template <class Epi, class Sched, bool ALIGN_EPI = false, bool SP2 = false>
__device__ __forceinline__ void gemm_phase(PG8_LAS unsigned char* lds, const Gemm g, const Sched& S, const Epi& E) {
    const int tid = threadIdx.x, wid = __builtin_amdgcn_readfirstlane(tid >> 6), lane = tid & 63, wr = wid >> 2, wc = wid & 3, fr = lane & 15, fq = lane >> 4;
    const int K = g.K, nt = K / BK;
    unsigned voffA[2], voffB[2];
#pragma unroll
    for (int i = 0; i < 2; ++i) { int R, C; stage_rc(tid * 16 + i * 8192, R, C); const int Rb = Epi::PERM ? ((R & ~31) + perm32(R & 31)) : R;
        voffA[i] = (unsigned)(R * K + C) * 2u; voffB[i] = (unsigned)(Rb * K + C) * 2u; }
    const size_t kstep = (size_t)(BK * 2);
    const size_t hstep = (size_t)HALF * K * 2;
    const size_t tstep = 2 * hstep;
    const unsigned ldsw = (unsigned)wid * 1024u;
    const int aoff = lds_byte(wr * 64 + fr, fq * 8), boff = lds_byte(wc * 32 + fr, fq * 8);
#define PG8_SA(b, h) (((b) * 2 + (h)) * HTB)
#define PG8_SB(b, h) ((4 + (b) * 2 + (h)) * HTB)
#define PG8_STAGE(bufoff, gbase, voff) do { _Pragma("unroll") for (int _i = 0; _i < 2; ++_i) \
        __builtin_amdgcn_global_load_lds((const unsigned*)((const char*)(gbase) + (voff)[_i]), (PG8_LAS unsigned*)(lds + (bufoff) + ldsw + _i * 8192), 16, 0, 0); } while (0)
#define PG8_LDA(dst, b, h) do { _Pragma("unroll") for (int m = 0; m < 4; ++m) _Pragma("unroll") for (int k = 0; k < 2; ++k) dst[m][k] = *(const PG8_LAS bf16x8*)(lds + PG8_SA(b, h) + aoff + m * 2048 + k * 1024); } while (0)
#define PG8_LDB(dst, b, h) do { _Pragma("unroll") for (int n = 0; n < 2; ++n) _Pragma("unroll") for (int k = 0; k < 2; ++k) dst[n][k] = *(const PG8_LAS bf16x8*)(lds + PG8_SB(b, h) + boff + n * 2048 + k * 1024); } while (0)
#define PG8_MMA(ai, bj, At, Bt) do { __builtin_amdgcn_s_setprio(1); _Pragma("unroll") for (int m = 0; m < 4; ++m) _Pragma("unroll") for (int n = 0; n < 2; ++n) _Pragma("unroll") for (int k = 0; k < 2; ++k) \
        acc[ai][bj][m][n] = __builtin_amdgcn_mfma_f32_16x16x32_bf16(Bt[n][k], At[m][k], acc[ai][bj][m][n], 0, 0, 0); __builtin_amdgcn_s_setprio(0); } while (0)
#define PG8_WAIT_V(n) asm volatile("s_waitcnt vmcnt(" #n ")" ::: "memory")
#define PG8_WAIT_L(n) asm volatile("s_waitcnt lgkmcnt(" #n ")" ::: "memory")
#define PG8_BAR __builtin_amdgcn_s_barrier()
#define PG8_SCHED __builtin_amdgcn_sched_barrier(0)
    Unit cur, nxt; int ui = 0;
    if (!S.next(0, cur)) return;
    f32x4 acc[2][2][4][2];
#pragma unroll
    for (int a = 0; a < 2; ++a)
#pragma unroll
        for (int b = 0; b < 2; ++b)
#pragma unroll
            for (int m = 0; m < 4; ++m)
#pragma unroll
                for (int n = 0; n < 2; ++n) acc[a][b][m][n] = (f32x4){0.f, 0.f, 0.f, 0.f};
    bf16x8 At[4][2], B0[2][2], B1[2][2];
    const char* cA = (const char*)g.A + (size_t)cur.pm * tstep; const char* cB = (const char*)g.Bt + (size_t)cur.pn * tstep;
    S.a_ready(cur);
    if constexpr (SP2) {
        PG8_STAGE(PG8_SB(0, 0), cB, voffB); PG8_STAGE(PG8_SB(0, 1), cB + hstep, voffB); PG8_STAGE(PG8_SA(0, 0), cA, voffA); PG8_STAGE(PG8_SA(0, 1), cA + hstep, voffA);
        if (wr == 1) PG8_BAR;
        PG8_WAIT_V(2); PG8_BAR;
        PG8_STAGE(PG8_SB(1, 0), cB + kstep, voffB); PG8_STAGE(PG8_SA(1, 0), cA + kstep, voffA); PG8_STAGE(PG8_SB(1, 1), cB + hstep + kstep, voffB);
        PG8_WAIT_V(6); PG8_BAR;
    } else {
        PG8_STAGE(PG8_SB(0, 0), cB, voffB); PG8_STAGE(PG8_SA(0, 0), cA, voffA); PG8_STAGE(PG8_SB(0, 1), cB + hstep, voffB); PG8_STAGE(PG8_SA(0, 1), cA + hstep, voffA);
        if (wr == 1) PG8_BAR;
        PG8_WAIT_V(4); PG8_BAR;
        PG8_STAGE(PG8_SB(1, 0), cB + kstep, voffB); PG8_STAGE(PG8_SA(1, 0), cA + kstep, voffA); PG8_STAGE(PG8_SB(1, 1), cB + hstep + kstep, voffB);
        PG8_WAIT_V(6); PG8_BAR;
    }
    for (;;) {
        const bool has_next = S.next(ui + 1, nxt);
        const char* nA = has_next ? (const char*)g.A + (size_t)nxt.pm * tstep : cA; const char* nB = has_next ? (const char*)g.Bt + (size_t)nxt.pn * tstep : cB;
        for (int t = 0; t < nt; t += 2) {
            const bool last = (t == nt - 2);
            const char* a1 = cA + (size_t)(t + 1) * kstep;
            const char* a2 = last ? nA : cA + (size_t)(t + 2) * kstep; const char* b2 = last ? nB : cB + (size_t)(t + 2) * kstep;
            const char* a3 = a2 + kstep; const char* b3 = b2 + kstep;
            if (last && has_next) S.a_ready(nxt);
            if constexpr (SP2) {
            PG8_LDB(B0, 0, 0); PG8_LDB(B1, 0, 1); PG8_SCHED; PG8_LDA(At, 0, 0); PG8_STAGE(PG8_SA(1, 1), a1 + hstep, voffA);
            PG8_WAIT_V(8); PG8_WAIT_L(0); PG8_BAR; PG8_MMA(0, 0, At, B0); PG8_MMA(0, 1, At, B1); PG8_BAR; PG8_SCHED;
            PG8_LDA(At, 0, 1); PG8_STAGE(PG8_SB(0, 0), b2, voffB); PG8_STAGE(PG8_SB(0, 1), b2 + hstep, voffB); PG8_STAGE(PG8_SA(0, 0), a2, voffA);
            PG8_WAIT_V(8); PG8_WAIT_L(0); PG8_BAR; PG8_MMA(1, 0, At, B0); PG8_MMA(1, 1, At, B1); PG8_BAR; PG8_SCHED;
            PG8_LDB(B0, 1, 0); PG8_LDB(B1, 1, 1); PG8_SCHED; PG8_LDA(At, 1, 0); PG8_STAGE(PG8_SA(0, 1), a2 + hstep, voffA);
            PG8_WAIT_V(8); PG8_WAIT_L(0); PG8_BAR; PG8_MMA(0, 0, At, B0); PG8_MMA(0, 1, At, B1); PG8_BAR; PG8_SCHED;
            PG8_LDA(At, 1, 1); PG8_STAGE(PG8_SB(1, 0), b3, voffB); PG8_STAGE(PG8_SB(1, 1), b3 + hstep, voffB); PG8_STAGE(PG8_SA(1, 0), a3, voffA);
            PG8_WAIT_V(8); PG8_WAIT_L(0); PG8_BAR; PG8_MMA(1, 0, At, B0); PG8_MMA(1, 1, At, B1); PG8_BAR; PG8_SCHED;
            } else {
            PG8_LDB(B0, 0, 0); PG8_SCHED; PG8_LDA(At, 0, 0); PG8_STAGE(PG8_SA(1, 1), a1 + hstep, voffA);
            PG8_WAIT_L(8); PG8_BAR; PG8_WAIT_L(0); PG8_MMA(0, 0, At, B0); PG8_BAR; PG8_SCHED;
            PG8_LDB(B1, 0, 1); PG8_STAGE(PG8_SB(0, 0), b2, voffB);
            PG8_BAR; PG8_WAIT_L(0); PG8_MMA(0, 1, At, B1); PG8_BAR;
            PG8_LDA(At, 0, 1); PG8_STAGE(PG8_SA(0, 0), a2, voffA);
            PG8_BAR; PG8_WAIT_L(0); PG8_MMA(1, 0, At, B0); PG8_BAR; PG8_SCHED;
            PG8_STAGE(PG8_SB(0, 1), b2 + hstep, voffB);
            PG8_WAIT_V(6); PG8_BAR; PG8_MMA(1, 1, At, B1); PG8_BAR;
            PG8_LDB(B0, 1, 0); PG8_SCHED; PG8_LDA(At, 1, 0); PG8_STAGE(PG8_SA(0, 1), a2 + hstep, voffA);
            PG8_WAIT_L(8); PG8_BAR; PG8_WAIT_L(0); PG8_MMA(0, 0, At, B0); PG8_BAR; PG8_SCHED;
            PG8_LDB(B1, 1, 1); PG8_STAGE(PG8_SB(1, 0), b3, voffB);
            PG8_BAR; PG8_WAIT_L(0); PG8_MMA(0, 1, At, B1); PG8_BAR;
            PG8_LDA(At, 1, 1); PG8_STAGE(PG8_SA(1, 0), a3, voffA);
            PG8_BAR; PG8_WAIT_L(0); PG8_MMA(1, 0, At, B0); PG8_BAR; PG8_SCHED;
            PG8_STAGE(PG8_SB(1, 1), b3 + hstep, voffB);
            PG8_WAIT_V(6); PG8_BAR; PG8_MMA(1, 1, At, B1); PG8_BAR;
            }
        }
        if constexpr (ALIGN_EPI) { if (wr == 0) PG8_BAR; }
        if constexpr (!Epi::AFTER_DRAIN) { E(acc, cur, wr, wc, fr, fq); S.done(cur); }
        if (!has_next) break;
#pragma unroll
        for (int a = 0; a < 2; ++a)
#pragma unroll
            for (int b = 0; b < 2; ++b)
#pragma unroll
                for (int m = 0; m < 4; ++m)
#pragma unroll
                    for (int n = 0; n < 2; ++n) acc[a][b][m][n] = (f32x4){0.f, 0.f, 0.f, 0.f};
        cur = nxt; cA = nA; cB = nB; ++ui;
        if constexpr (ALIGN_EPI) { if (wr == 1) PG8_BAR; }
    }
    PG8_WAIT_V(0);
    if constexpr (!ALIGN_EPI) { if (wr == 0) PG8_BAR; }
    PG8_BAR;
    if constexpr (Epi::AFTER_DRAIN) { E.fused(acc, cur, wr, wc, fr, fq, lds, wid, lane); S.done(cur); }
#undef PG8_SA
#undef PG8_SB
#undef PG8_STAGE
#undef PG8_LDA
#undef PG8_LDB
#undef PG8_MMA
#undef PG8_WAIT_V
#undef PG8_WAIT_L
#undef PG8_BAR
#undef PG8_SCHED
}
}

constexpr int NWAVES = 8;
#ifndef MK_N_LAUNCHES
#define MK_N_LAUNCHES 1
#endif
constexpr int N_LAUNCHES = MK_N_LAUNCHES;
constexpr int N_PHASES = 17;

constexpr int BATCH = 16, SEQ = 2048, DM = 1024, M = BATCH * SEQ;
constexpr int EVEN_IN = 3072, ODD_IN = 2560;
constexpr float EPS = 1e-6f;

constexpr size_t MiB = 1u << 20;
constexpr size_t WS_CTL = 0, CTL_ZERO_BYTES = 1 * MiB;
constexpr size_t WS_WIN0 = 2 * MiB;
constexpr size_t WS_WOUT0 = 8 * MiB;
constexpr size_t WS_WIN1 = 10 * MiB;
constexpr size_t WS_WGLU = 15 * MiB;
constexpr size_t WS_WPW = 16 * MiB;
constexpr size_t WS_WPOOL = 17 * MiB;
constexpr size_t WS_WOUT1 = 18 * MiB;
constexpr size_t WS_ROPE = 20 * MiB;
constexpr size_t WS_S5C = 21 * MiB;
constexpr size_t WS_KBAR = 22 * MiB;
constexpr size_t WS_XN = 32 * MiB;
constexpr size_t WS_Z = 96 * MiB;
constexpr size_t WS_MB = 288 * MiB;
constexpr size_t WS_Y = 352 * MiB;
constexpr size_t WS_T1 = 416 * MiB;
constexpr size_t WS_T2 = 448 * MiB;
constexpr size_t WS_END = 480 * MiB;
constexpr int CW_BAR = 4096;

constexpr int RING_OFF = 0, RING_BYTES = 131072;
constexpr int LDSCTL_OFF = RING_BYTES, MISC_OFF = LDSCTL_OFF + 320;
constexpr int LDS_BYTES = 147456;

#define GAS __attribute__((address_space(1)))
#define LAS __attribute__((address_space(3)))
typedef unsigned short bf16;
typedef unsigned v4u __attribute__((ext_vector_type(4)));
typedef unsigned v2u __attribute__((ext_vector_type(2)));
typedef float f32x4 __attribute__((ext_vector_type(4)));
#define LDS_WAIT() asm volatile("s_waitcnt lgkmcnt(0)" ::: "memory")
#define VM_WAIT() asm volatile("s_waitcnt vmcnt(0)" ::: "memory")
__device__ __forceinline__ unsigned f2bf(float f) { unsigned u = __builtin_bit_cast(unsigned, f); return (u + 0x7fffu + ((u >> 16) & 1u)) >> 16; }
__device__ __forceinline__ unsigned pk2(float lo, float hi) { return f2bf(lo) | (f2bf(hi) << 16); }
__device__ __forceinline__ float bf2f(unsigned short v) { return __builtin_bit_cast(float, (unsigned)v << 16); }
__device__ __forceinline__ float bflo(unsigned w) { return __builtin_bit_cast(float, w << 16); }
__device__ __forceinline__ float bfhi(unsigned w) { return __builtin_bit_cast(float, w & 0xffff0000u); }
__device__ __forceinline__ float sigmoidf_(float x) { return 1.0f / (1.0f + __expf(-x)); }
__device__ __forceinline__ float siluf_(float x) { return x / (1.0f + __expf(-x)); }

#define XB_TMO      128
#define XB_XCNT(j)  (256  + 64 * (j))
#define XB_XSUB(j)  (1280 + 64 * (j))
#define XB_XGEN(j)  (2304 + 64 * (j))
#define XB_TOP      3328
#define XB_TOPGEN   3392
#define XCD_BAR_WORDS 3456
#define XB_SPIN_CAP (1u << 18)
__device__ __forceinline__ unsigned xb_ld(unsigned* p)              { return __hip_atomic_load(p, __ATOMIC_RELAXED, __HIP_MEMORY_SCOPE_AGENT); }
__device__ __forceinline__ unsigned xb_add(unsigned* p, unsigned v) { return __hip_atomic_fetch_add(p, v, __ATOMIC_RELAXED, __HIP_MEMORY_SCOPE_AGENT); }
__device__ __forceinline__ unsigned xb_xcc_id() { return (unsigned)__builtin_amdgcn_s_getreg((3 << 11) | 20) & 0xFu; }
#define XB_SPIN(cond, bar) do { unsigned _sp = 0; while (cond) { __builtin_amdgcn_s_sleep(1); \
    if ((++_sp & 255u) == 0u) { if (xb_ld(&(bar)[XB_TMO])) break; if (_sp > XB_SPIN_CAP) { atomicAdd(&(bar)[XB_TMO], 1u); break; } } } } while (0)
struct XcdBarrier { unsigned* bar; unsigned x; volatile LAS unsigned* st; };
__device__ __forceinline__ XcdBarrier xcd_barrier_post(unsigned* bar, volatile LAS unsigned* st) {
    XcdBarrier b; b.bar = bar; b.x = xb_xcc_id(); b.st = st;
    if (threadIdx.x == 0) (void)xb_add(&bar[XB_XCNT(b.x)], 1u);
    return b;
}
__device__ __forceinline__ void xcd_barrier_complete(unsigned* bar, unsigned x, unsigned& nloc, unsigned& nx) {
    const unsigned G = gridDim.x * gridDim.y * gridDim.z;
    unsigned sum, cnt, mine, sp = 0u;
    for (;;) {
        sum = 0u; cnt = 0u; mine = 0u;
#pragma unroll
        for (unsigned j = 0; j < 16; ++j) { const unsigned c = xb_ld(&bar[XB_XCNT(j)]); sum += c; cnt += (c > 0u) ? 1u : 0u; mine = (j == x) ? c : mine; }
        if (sum == G) break;
        __builtin_amdgcn_s_sleep(1);
        if ((++sp & 255u) == 0u) { if (xb_ld(&bar[XB_TMO])) break; if (sp > XB_SPIN_CAP) { atomicAdd(&bar[XB_TMO], 1u); break; } }
    }
    nloc = mine > 0u ? mine : 1u; nx = cnt > 0u ? cnt : 1u;
}
__device__ __forceinline__ void xcd_barrier(const XcdBarrier& b) {
    asm volatile("s_waitcnt vmcnt(0)" ::: "memory");
    __syncthreads();
    if (threadIdx.x == 0) {
        unsigned* bar = b.bar;
        __builtin_amdgcn_s_waitcnt(0);
        unsigned nloc = b.st[0], nx = b.st[1];
        if (nloc == 0u) { xcd_barrier_complete(bar, b.x, nloc, nx); b.st[0] = nloc; b.st[1] = nx; }
        const unsigned old = xb_add(&bar[XB_XSUB(b.x)], 1u);
        const unsigned gen = old / nloc;
        if (old + 1u == (gen + 1u) * nloc) {
            __builtin_amdgcn_fence(__ATOMIC_RELEASE, "agent");
            asm volatile("s_waitcnt vmcnt(0)" ::: "memory");
            const unsigned og = xb_add(&bar[XB_TOP], 1u);
            const unsigned tg = og / nx;
            if (og + 1u == (tg + 1u) * nx) xb_add(&bar[XB_TOPGEN], 1u);
            else XB_SPIN(xb_ld(&bar[XB_TOPGEN]) == tg, bar);
            __builtin_amdgcn_fence(__ATOMIC_ACQUIRE, "agent");
            xb_add(&bar[XB_XGEN(b.x)], 1u);
            asm volatile("s_waitcnt vmcnt(0)" ::: "memory");
        } else {
            XB_SPIN(xb_ld(&bar[XB_XGEN(b.x)]) == gen, bar);
            __builtin_amdgcn_fence(__ATOMIC_ACQUIRE, "agent");
            asm volatile("s_waitcnt vmcnt(0)" ::: "memory");
        }
    }
    __syncthreads();
}

struct Frame {
    LAS unsigned char* lds;
    int tid, lane, wave;
    int vcu, G, gw, NGW;
    const float* in[23]; float* out; unsigned char* ws;
};
__device__ __forceinline__ float wave_sum(float v) {
#pragma unroll
    for (int o = 1; o < 64; o <<= 1) v += __shfl_xor(v, o);
    return v;
}
__device__ __forceinline__ float wave_max(float v) {
#pragma unroll
    for (int o = 1; o < 64; o <<= 1) v = fmaxf(v, __shfl_xor(v, o));
    return v;
}

__device__ __forceinline__ void p0_transpose_item(const float* W, int K, int N, bf16* WT, const float* gk, LAS float* scr, int item, int lane) {
    const int nblk = N / 32, kb = item / nblk, nb = item % nblk, k0 = 64 * kb, n0 = 32 * nb;
#pragma unroll 8
    for (int i = 0; i < 32; ++i) { const int kk = 2 * i + (lane >> 5); float v = W[(size_t)(k0 + kk) * N + n0 + (lane & 31)]; if (gk) v *= gk[k0 + kk]; scr[kk * 33 + (lane & 31)] = v; }
    LDS_WAIT(); asm volatile("" ::: "memory");
    const int c = lane & 7;
#pragma unroll
    for (int j = 0; j < 4; ++j) { const int n = (lane >> 3) + 8 * j; const LAS float* s = scr + (8 * c) * 33 + n;
        v4u o; o.x = pk2(s[0 * 33], s[1 * 33]); o.y = pk2(s[2 * 33], s[3 * 33]); o.z = pk2(s[4 * 33], s[5 * 33]); o.w = pk2(s[6 * 33], s[7 * 33]);
        *(GAS v4u*)(WT + (size_t)(n0 + n) * K + k0 + 8 * c) = o; }
    LDS_WAIT(); asm volatile("" ::: "memory");
}

__device__ __forceinline__ void ph_prologue(Frame& F) {
    LAS float* scr = (LAS float*)(F.lds + RING_OFF + F.wave * 16384);
    unsigned char* ws = F.ws;
    const int I_IN0 = (1024 / 64) * (EVEN_IN / 32), I_SQ = (1024 / 64) * (1024 / 32), I_IN1 = (1024 / 64) * (ODD_IN / 32), I_GLU = (512 / 64) * (1024 / 32), I_PW = (512 / 64) * (512 / 32);
    const int NITEMS = I_IN0 + I_SQ + I_IN1 + I_GLU + I_PW + I_SQ;
    for (int it = F.gw; it < NITEMS; it += F.NGW) {
        int r = it;
        if (r < I_IN0) { p0_transpose_item(F.in[3], 1024, EVEN_IN, (bf16*)(ws + WS_WIN0), F.in[1], scr, r, F.lane); continue; } r -= I_IN0;
        if (r < I_SQ) { p0_transpose_item(F.in[6], 1024, 1024, (bf16*)(ws + WS_WOUT0), nullptr, scr, r, F.lane); continue; } r -= I_SQ;
        if (r < I_IN1) { p0_transpose_item(F.in[7], 1024, ODD_IN, (bf16*)(ws + WS_WIN1), F.in[1] + 1024, scr, r, F.lane); continue; } r -= I_IN1;
        if (r < I_GLU) { p0_transpose_item(F.in[16], 512, 1024, (bf16*)(ws + WS_WGLU), nullptr, scr, r, F.lane); continue; } r -= I_GLU;
        if (r < I_PW) { p0_transpose_item(F.in[21], 512, 512, (bf16*)(ws + WS_WPW), nullptr, scr, r, F.lane); continue; } r -= I_PW;
        p0_transpose_item(F.in[22], 1024, 1024, (bf16*)(ws + WS_WOUT1), nullptr, scr, r, F.lane);
    }
    const int gt = F.gw * 64 + F.lane, NGT = F.NGW * 64;
    { bf16* wp = (bf16*)(ws + WS_WPOOL); const float* pw = F.in[4]; const float* ps = F.in[5];
      for (int i = gt; i < 512 * 512; i += NGT) { const int n = i >> 9, k = i & 511; float v = 0.f;
          if ((n >> 7) == (k >> 7)) v = pw[(size_t)(n >> 7) * 16384 + (k & 127) * 128 + (n & 127)] * ps[n];
          wp[i] = (bf16)f2bf(v); } }
    { float* rt = (float*)(ws + WS_ROPE);
      for (int i = gt; i < SEQ * 16; i += NGT) { const int t = i >> 4, j = i & 15;
          const float inv = (float)pow(500000.0, -(double)(2 * j) / 32.0); const float ang = (float)t * inv;
          rt[2 * i] = (float)cos((double)ang); rt[2 * i + 1] = (float)sin((double)ang); } }
    { float* sc = (float*)(ws + WS_S5C); float* Lre = sc, *Lim = sc + 2048, *BBre = sc + 4096, *BBim = sc + 4096 + 32768;
      const float* lam_re = F.in[8]; const float* lam_im = F.in[9]; const float* log_dt = F.in[10]; const float* b_re = F.in[11]; const float* b_im = F.in[12];
      for (int i = gt; i < 2048; i += NGT) { const int g = i >> 6;
          const double lr = lam_re[i], li = lam_im[i], dt = exp((double)log_dt[g]);
          const double mag = exp(lr * dt), are = mag * cos(li * dt), aim = mag * sin(li * dt);
          const double den = lr * lr + li * li, nre = are - 1.0;
          const double fre = (nre * lr + aim * li) / den, fim = (aim * lr - nre * li) / den;
          Lre[i] = (float)are; Lim[i] = (float)aim;
          for (int k = 0; k < 16; ++k) { const double br = b_re[(size_t)i * 16 + k], bi = b_im[(size_t)i * 16 + k];
              BBre[(size_t)i * 16 + k] = (float)(fre * br - fim * bi); BBim[(size_t)i * 16 + k] = (float)(fre * bi + fim * br); } } }
    { const float* x = F.in[0]; bf16* xn = (bf16*)(ws + WS_XN);
      for (int m = F.gw; m < M; m += F.NGW) {
          const GAS f32x4* xr = (const GAS f32x4*)(x + (size_t)m * DM) + F.lane;
          f32x4 v[4]; float s = 0.f;
#pragma unroll
          for (int j = 0; j < 4; ++j) { v[j] = xr[64 * j]; s += (v[j].x * v[j].x + v[j].y * v[j].y) + (v[j].z * v[j].z + v[j].w * v[j].w); }
          const float rstd = 1.0f / sqrtf(wave_sum(s) * (1.f / DM) + EPS);
          GAS v2u* o8 = (GAS v2u*)(xn + (size_t)m * DM) + F.lane;
#pragma unroll
          for (int j = 0; j < 4; ++j) { v2u w; w.x = pk2(v[j].x * rstd, v[j].y * rstd); w.y = pk2(v[j].z * rstd, v[j].w * rstd); o8[64 * j] = w; } } }
}

__device__ __forceinline__ void ph_rope(Frame& F) {
    bf16* Z = (bf16*)(F.ws + WS_Z); const float* rt = (const float*)(F.ws + WS_ROPE);
    const int gt = F.gw * 64 + F.lane, NGT = F.NGW * 64;
    for (int i = gt; i < M * 128; i += NGT) {
        const int row = i >> 7, r = i & 127, which = r >> 6, h = (r >> 4) & 3, j = r & 15, t = row & (SEQ - 1);
        bf16* p = Z + (size_t)row * EVEN_IN + which * 512 + h * 128 + j;
        const float x1 = bf2f(p[0]), x2 = bf2f(p[16]), c = rt[(t * 16 + j) * 2], s = rt[(t * 16 + j) * 2 + 1];
        p[0] = (bf16)f2bf(x1 * c - x2 * s); p[16] = (bf16)f2bf(x2 * c + x1 * s);
    }
}
__device__ __forceinline__ void ph_kbar(Frame& F) {
    const bf16* Z = (const bf16*)(F.ws + WS_Z); float* kb = (float*)(F.ws + WS_KBAR);
    const int gt = F.gw * 64 + F.lane, NGT = F.NGW * 64;
    for (int i = gt; i < BATCH * 8 * 512; i += NGT) { const int bn = i >> 9, c = i & 511; float s = 0.f;
        const bf16* p = Z + (size_t)bn * 256 * EVEN_IN + 512 + c;
        for (int k = 0; k < 256; ++k) s += bf2f(p[(size_t)k * EVEN_IN]);
        kb[i] = s * (1.f / 256.f); }
}
__device__ __forceinline__ void ph_attn_naive(Frame& F) {
    const bf16* Z = (const bf16*)(F.ws + WS_Z); const float* kbar = (const float*)(F.ws + WS_KBAR); bf16* MB = (bf16*)(F.ws + WS_MB);
    LAS float* qs = (LAS float*)(F.lds + RING_OFF + F.wave * 8192); LAS float* ps = qs + 128;
    const int lane = F.lane; const float scale = 0.08838834764831845f;
    for (int item = F.gw; item < M * 4; item += F.NGW) {
        const int row = item >> 2, h = item & 3, b = row >> 11, t = row & (SEQ - 1), qblk = t >> 8;
        const bf16* zrow = Z + (size_t)row * EVEN_IN;
        qs[lane] = bf2f(zrow[h * 128 + lane]); qs[lane + 64] = bf2f(zrow[h * 128 + 64 + lane]);
        LDS_WAIT(); asm volatile("" ::: "memory");
        float gate = -INFINITY;
        if (lane < 8 && lane < qblk) { const float* kb = kbar + (size_t)(b * 8 + lane) * 512 + h * 128; float a = 0.f; for (int d = 0; d < 128; ++d) a += qs[d] * kb[d]; gate = a; }
        float gv[8];
#pragma unroll
        for (int n = 0; n < 8; ++n) gv[n] = __shfl(gate, n);
        int blk[4];
#pragma unroll
        for (int r = 0; r < 3; ++r) { int best = -1; float bv = -INFINITY;
#pragma unroll
            for (int n = 0; n < 8; ++n) if (gv[n] > bv) { bv = gv[n]; best = n; }
#pragma unroll
            for (int n = 0; n < 8; ++n) if (n == best) gv[n] = -INFINITY;
            blk[r] = best; }
        blk[3] = qblk;
        float s[4][4];
#pragma unroll
        for (int j = 0; j < 4; ++j) {
#pragma unroll
            for (int i = 0; i < 4; ++i) s[j][i] = -INFINITY;
            if (blk[j] >= 0) {
#pragma unroll
                for (int i = 0; i < 4; ++i) { const int key = blk[j] * 256 + lane + 64 * i;
                    const GAS v4u* kr = (const GAS v4u*)(Z + (size_t)(b * SEQ + key) * EVEN_IN + 512 + h * 128); float a = 0.f;
                    for (int c = 0; c < 16; ++c) { const v4u w = kr[c]; const LAS float* q8 = qs + c * 8;
                        a += q8[0] * bflo(w.x) + q8[1] * bfhi(w.x) + q8[2] * bflo(w.y) + q8[3] * bfhi(w.y) + q8[4] * bflo(w.z) + q8[5] * bfhi(w.z) + q8[6] * bflo(w.w) + q8[7] * bfhi(w.w); }
                    a *= scale; if (j == 3 && key > t) a = -INFINITY; s[j][i] = a; } } }
        float mx = -INFINITY;
#pragma unroll
        for (int j = 0; j < 4; ++j)
#pragma unroll
            for (int i = 0; i < 4; ++i) mx = fmaxf(mx, s[j][i]);
        mx = wave_max(mx);
        float sum = 0.f;
#pragma unroll
        for (int j = 0; j < 4; ++j)
#pragma unroll
            for (int i = 0; i < 4; ++i) { const float p = __expf(s[j][i] - mx); sum += p; ps[j * 256 + lane + 64 * i] = p; }
        sum = wave_sum(sum);
        LDS_WAIT(); asm volatile("" ::: "memory");
        float a0 = 0.f, a1 = 0.f;
#pragma unroll
        for (int j = 0; j < 4; ++j) if (blk[j] >= 0) { const int nk = (j == 3) ? (t & 255) + 1 : 256;
            const bf16* vb = Z + (size_t)(b * SEQ + blk[j] * 256) * EVEN_IN + 1024 + h * 128 + 2 * lane;
            for (int k = 0; k < nk; ++k) { const unsigned w = *(const GAS unsigned*)(vb + (size_t)k * EVEN_IN); const float p = ps[j * 256 + k]; a0 += p * bflo(w); a1 += p * bfhi(w); } }
        const float inv = 1.0f / sum;
        const unsigned gw2 = *(const GAS unsigned*)(zrow + 1536 + h * 128 + 2 * lane);
        const float o0 = a0 * inv * siluf_(bflo(gw2)), o1 = a1 * inv * siluf_(bfhi(gw2));
        *(GAS unsigned*)(MB + (size_t)row * DM + h * 128 + 2 * lane) = pk2(o0, o1);
        LDS_WAIT(); asm volatile("" ::: "memory");
    }
}
__device__ __forceinline__ void ph_pool_naive(Frame& F) {
    const bf16* Z = (const bf16*)(F.ws + WS_Z); bf16* T1 = (bf16*)(F.ws + WS_T1);
    const int gt = F.gw * 64 + F.lane, NGT = F.NGW * 64;
    for (int i = gt; i < M * 512; i += NGT) { const int row = i >> 9, c = i & 511, g = c >> 7, w = 2 << g, t = row & (SEQ - 1);
        const int n = (t + 1 < w) ? t + 1 : w; const bf16* p = Z + (size_t)row * EVEN_IN + 2048 + c; float s = 0.f;
        for (int k = 0; k < n; ++k) s += bf2f(*(p - (size_t)k * EVEN_IN));
        T1[i] = (bf16)f2bf(s / (float)n - bf2f(p[0])); }
}
__device__ __forceinline__ void ph_pool_gate(Frame& F) {
    const bf16* Z = (const bf16*)(F.ws + WS_Z); const bf16* T2 = (const bf16*)(F.ws + WS_T2); bf16* MB = (bf16*)(F.ws + WS_MB);
    const int gt = F.gw * 64 + F.lane, NGT = F.NGW * 64;
    for (int i = gt; i < M * 512; i += NGT) { const int row = i >> 9, c = i & 511;
        MB[(size_t)row * DM + 512 + c] = (bf16)f2bf(bf2f(T2[i]) * siluf_(bf2f(Z[(size_t)row * EVEN_IN + 2560 + c]))); }
}
__device__ __forceinline__ void ph_norm_res(Frame& F, const float* base, const bf16* Y, const float* g, float* outp, bf16* xn) {
    for (int m = F.gw; m < M; m += F.NGW) {
        const GAS v2u* yr = (const GAS v2u*)(Y + (size_t)m * DM) + F.lane;
        float y[4][4]; float s = 0.f;
#pragma unroll
        for (int j = 0; j < 4; ++j) { const v2u w = yr[64 * j]; y[j][0] = bflo(w.x); y[j][1] = bfhi(w.x); y[j][2] = bflo(w.y); y[j][3] = bfhi(w.y);
            s += (y[j][0] * y[j][0] + y[j][1] * y[j][1]) + (y[j][2] * y[j][2] + y[j][3] * y[j][3]); }
        const float rstd = 1.0f / sqrtf(wave_sum(s) * (1.f / DM) + EPS);
        const GAS f32x4* br = (const GAS f32x4*)(base + (size_t)m * DM) + F.lane; const GAS f32x4* gr = (const GAS f32x4*)g + F.lane;
        GAS f32x4* orow = (GAS f32x4*)(outp + (size_t)m * DM) + F.lane;
        f32x4 x1[4]; float s1 = 0.f;
#pragma unroll
        for (int j = 0; j < 4; ++j) { const f32x4 bv = br[64 * j], gv = gr[64 * j];
            x1[j].x = bv.x + y[j][0] * rstd * gv.x; x1[j].y = bv.y + y[j][1] * rstd * gv.y; x1[j].z = bv.z + y[j][2] * rstd * gv.z; x1[j].w = bv.w + y[j][3] * rstd * gv.w;
            orow[64 * j] = x1[j]; s1 += (x1[j].x * x1[j].x + x1[j].y * x1[j].y) + (x1[j].z * x1[j].z + x1[j].w * x1[j].w); }
        if (xn) { const float r1 = 1.0f / sqrtf(wave_sum(s1) * (1.f / DM) + EPS);
            GAS v2u* o8 = (GAS v2u*)(xn + (size_t)m * DM) + F.lane;
#pragma unroll
            for (int j = 0; j < 4; ++j) { v2u w; w.x = pk2(x1[j].x * r1, x1[j].y * r1); w.y = pk2(x1[j].z * r1, x1[j].w * r1); o8[64 * j] = w; } }
    }
}
__device__ __forceinline__ void ph_s5_naive(Frame& F) {
    const bf16* Z = (const bf16*)(F.ws + WS_Z); bf16* T1 = (bf16*)(F.ws + WS_T1);
    const float* sc = (const float*)(F.ws + WS_S5C); const float* Lre = sc, *Lim = sc + 2048, *BBre = sc + 4096, *BBim = sc + 4096 + 32768;
    const float* c_re = F.in[13]; const float* c_im = F.in[14]; const float* dvec = F.in[15];
    const int lane = F.lane;
    for (int item = F.gw; item < BATCH * 32; item += F.NGW) {
        const int b = item >> 5, g = item & 31, gp = g * 64 + lane;
        const float are = Lre[gp], aim = Lim[gp];
        float bbr[16], bbi[16], cr[16], ci[16];
#pragma unroll
        for (int i = 0; i < 16; ++i) { bbr[i] = BBre[(size_t)gp * 16 + i]; bbi[i] = BBim[(size_t)gp * 16 + i]; cr[i] = c_re[(size_t)(g * 16 + i) * 64 + lane]; ci[i] = c_im[(size_t)(g * 16 + i) * 64 + lane]; }
        const float dmine = dvec[g * 16 + (lane & 15)];
        float xr = 0.f, xi = 0.f;
        for (int t = 0; t < SEQ; ++t) {
            const size_t row = (size_t)b * SEQ + t;
            const GAS v4u* up = (const GAS v4u*)(Z + row * ODD_IN + g * 16);
            const v4u w0 = up[0], w1 = up[1];
            float u[16];
            u[0] = bflo(w0.x); u[1] = bfhi(w0.x); u[2] = bflo(w0.y); u[3] = bfhi(w0.y); u[4] = bflo(w0.z); u[5] = bfhi(w0.z); u[6] = bflo(w0.w); u[7] = bfhi(w0.w);
            u[8] = bflo(w1.x); u[9] = bfhi(w1.x); u[10] = bflo(w1.y); u[11] = bfhi(w1.y); u[12] = bflo(w1.z); u[13] = bfhi(w1.z); u[14] = bflo(w1.w); u[15] = bfhi(w1.w);
            float bur = 0.f, bui = 0.f;
#pragma unroll
            for (int i = 0; i < 16; ++i) { bur += bbr[i] * u[i]; bui += bbi[i] * u[i]; }
            const float nr = are * xr - aim * xi + bur, ni = are * xi + aim * xr + bui; xr = nr; xi = ni;
            float mine = 0.f;
#pragma unroll
            for (int i = 0; i < 16; ++i) { const float v = wave_sum(xr * cr[i] - xi * ci[i]); if ((lane & 15) == i) mine = v; }
            if (lane < 16) { const float ui = bf2f(Z[row * ODD_IN + g * 16 + lane]); T1[row * 512 + g * 16 + lane] = (bf16)f2bf(mine + dmine * ui); }
        }
    }
}
__device__ __forceinline__ void ph_conv_naive(Frame& F) {
    const bf16* Z = (const bf16*)(F.ws + WS_Z); bf16* T2 = (bf16*)(F.ws + WS_T2);
    const float* dw = F.in[18]; const float* ln_g = F.in[19]; const float* ln_b = F.in[20];
    LAS float* red = (LAS float*)(F.lds + RING_OFF);
    const int c = F.tid;
    float wt[31];
#pragma unroll
    for (int j = 0; j < 31; ++j) wt[j] = dw[j * 512 + c];
    const float lg = ln_g[c], lb = ln_b[c];
    for (int row = blockIdx.x; row < M; row += F.G) {
        const int t = row & (SEQ - 1); float acc = 0.f;
#pragma unroll
        for (int j = 0; j < 31; ++j) { const int tt = t - 30 + j;
            if (tt >= 0) { const bf16* zr = Z + (size_t)(row - 30 + j) * ODD_IN; acc += bf2f(zr[1024 + c]) * sigmoidf_(bf2f(zr[1536 + c])) * wt[j]; } }
        float s = wave_sum(acc);
        __syncthreads();
        if (F.lane == 0) red[F.wave] = s;
        __syncthreads();
        float tot = 0.f;
#pragma unroll
        for (int w = 0; w < 8; ++w) tot += red[w];
        const float mu = tot * (1.f / 512.f), dlt = acc - mu;
        float q = wave_sum(dlt * dlt);
        __syncthreads();
        if (F.lane == 0) red[F.wave] = q;
        __syncthreads();
        float qt = 0.f;
#pragma unroll
        for (int w = 0; w < 8; ++w) qt += red[w];
        const float nrm = dlt * (1.0f / sqrtf(qt * (1.f / 512.f) + EPS)) * lg + lb;
        T2[(size_t)row * 512 + c] = (bf16)f2bf(siluf_(nrm));
    }
    __syncthreads();
}
__device__ __forceinline__ void ph_glu_gate(Frame& F) {
    const bf16* Z = (const bf16*)(F.ws + WS_Z); const bf16* Y = (const bf16*)(F.ws + WS_Y); bf16* MB = (bf16*)(F.ws + WS_MB); const float* gb = F.in[17];
    const int gt = F.gw * 64 + F.lane, NGT = F.NGW * 64;
    for (int i = gt; i < M * 512; i += NGT) { const int row = i >> 9, c = i & 511;
        const float ya = bf2f(Y[(size_t)row * 1024 + c]) + gb[c], yb = bf2f(Y[(size_t)row * 1024 + 512 + c]) + gb[512 + c];
        MB[(size_t)row * DM + c] = (bf16)f2bf(ya * sigmoidf_(yb) * siluf_(bf2f(Z[(size_t)row * ODD_IN + 512 + c]))); }
}
__device__ __forceinline__ void ph_conv_gate(Frame& F) {
    const bf16* Z = (const bf16*)(F.ws + WS_Z); const bf16* Y = (const bf16*)(F.ws + WS_Y); bf16* MB = (bf16*)(F.ws + WS_MB);
    const int gt = F.gw * 64 + F.lane, NGT = F.NGW * 64;
    for (int i = gt; i < M * 512; i += NGT) { const int row = i >> 9, c = i & 511;
        MB[(size_t)row * DM + 512 + c] = (bf16)f2bf(bf2f(Y[i]) * siluf_(bf2f(Z[(size_t)row * ODD_IN + 2048 + c]))); }
}

struct Args { const float* in[23]; float* out; unsigned char* ws; int ph_lo, ph_hi; };
__global__ void __launch_bounds__(NWAVES * 64, 2) fwd_kernel(Args args) {
    extern __shared__ __attribute__((aligned(16))) unsigned char lds[];
    Frame F;
    F.lds = (LAS unsigned char*)lds;
    volatile LAS unsigned* MISC = (volatile LAS unsigned*)(F.lds + MISC_OFF);
    F.tid = threadIdx.x; F.lane = F.tid & 63; F.wave = __builtin_amdgcn_readfirstlane(F.tid >> 6);
    F.G = gridDim.x; { const int bx = blockIdx.x; F.vcu = (F.G % 8 == 0) ? (bx % 8) * (F.G / 8) + bx / 8 : bx; }
    F.gw = blockIdx.x * NWAVES + F.wave; F.NGW = F.G * NWAVES;
#pragma unroll
    for (int i = 0; i < 23; ++i) F.in[i] = args.in[i];
    F.out = args.out; F.ws = args.ws;
    unsigned* ctl = (unsigned*)(args.ws + WS_CTL);
    for (int u = F.tid; u < (LDS_BYTES - LDSCTL_OFF) / 4; u += NWAVES * 64) ((LAS unsigned*)(F.lds + LDSCTL_OFF))[u] = 0u;
    __syncthreads();
    XcdBarrier bar; bar.bar = ctl + CW_BAR; bar.x = 0; bar.st = nullptr;
    if (N_LAUNCHES == 1) bar = xcd_barrier_post(ctl + CW_BAR, MISC + 8);
#define GRID_BAR() do { if (N_LAUNCHES == 1) xcd_barrier(bar); } while (0)
    const int lo = args.ph_lo, hi = args.ph_hi;
#define IN(k) (lo <= (k) && (k) < hi)
#define BOTH(k) (IN(k) && IN((k) + 1))
    unsigned char* ws = args.ws;
    bf16* XN = (bf16*)(ws + WS_XN); bf16* Z = (bf16*)(ws + WS_Z); bf16* MB = (bf16*)(ws + WS_MB); bf16* Y = (bf16*)(ws + WS_Y); bf16* T1 = (bf16*)(ws + WS_T1); bf16* T2 = (bf16*)(ws + WS_T2);
    typedef pg8::EpiBf16<0> EpiP;
#define GEMM_PLAIN(Aptr, Wptr, Nn, Kk, Optr, ldc_) do { pg8::Gemm g{(const pg8::bf16_t*)(Aptr), (const pg8::bf16_t*)(Wptr), M, (Nn), (Kk)}; pg8::StaticOrder S; S.init(M, (Nn), F.G, (int)blockIdx.x); \
        EpiP E{(pg8::bf16_t*)(Optr), (ldc_), nullptr, 0, 0, 1.f}; pg8::gemm_phase<EpiP, pg8::StaticOrder, true, true>(F.lds + RING_OFF, g, S, E); } while (0)

    if (IN(0)) { ph_prologue(F); if (BOTH(0)) GRID_BAR(); }
    if (IN(1)) { GEMM_PLAIN(XN, ws + WS_WIN0, EVEN_IN, 1024, Z, EVEN_IN); if (BOTH(1)) GRID_BAR(); }
    if (IN(2)) { ph_rope(F); if (BOTH(2)) GRID_BAR(); }
    if (IN(3)) { ph_kbar(F); if (BOTH(3)) GRID_BAR(); }
    if (IN(4)) { ph_attn_naive(F); ph_pool_naive(F); if (BOTH(4)) GRID_BAR(); }
    if (IN(5)) { GEMM_PLAIN(T1, ws + WS_WPOOL, 512, 512, T2, 512); if (BOTH(5)) GRID_BAR(); }
    if (IN(6)) { ph_pool_gate(F); if (BOTH(6)) GRID_BAR(); }
    if (IN(7)) { GEMM_PLAIN(MB, ws + WS_WOUT0, 1024, 1024, Y, 1024); if (BOTH(7)) GRID_BAR(); }
    if (IN(8)) { ph_norm_res(F, F.in[0], Y, F.in[2], F.out, XN); if (BOTH(8)) GRID_BAR(); }
    if (IN(9)) { GEMM_PLAIN(XN, ws + WS_WIN1, ODD_IN, 1024, Z, ODD_IN); if (BOTH(9)) GRID_BAR(); }
    if (IN(10)) { ph_s5_naive(F); ph_conv_naive(F); if (BOTH(10)) GRID_BAR(); }
    if (IN(11)) { GEMM_PLAIN(T1, ws + WS_WGLU, 1024, 512, Y, 1024); if (BOTH(11)) GRID_BAR(); }
    if (IN(12)) { ph_glu_gate(F); if (BOTH(12)) GRID_BAR(); }
    if (IN(13)) { GEMM_PLAIN(T2, ws + WS_WPW, 512, 512, Y, 512); if (BOTH(13)) GRID_BAR(); }
    if (IN(14)) { ph_conv_gate(F); if (BOTH(14)) GRID_BAR(); }
    if (IN(15)) { GEMM_PLAIN(MB, ws + WS_WOUT1, 1024, 1024, Y, 1024); if (BOTH(15)) GRID_BAR(); }
    if (IN(16)) { ph_norm_res(F, F.out, Y, F.in[2] + 1024, F.out, nullptr); }
#undef IN
#undef BOTH
}

extern "C" void kernel_launch(void* const* d_in, const int* in_sizes, int n_in, void* d_out, int out_size, void* d_ws, size_t ws_size, hipStream_t stream) {
    static int grid = 0;
    if (grid == 0) {
        if (n_in != 23 || in_sizes[0] != M * DM || out_size != M * DM || ws_size < WS_END) { fprintf(stderr, "kernel_launch: unexpected shapes n_in %d in0 %d out %d ws %zu\n", n_in, n_in > 0 ? in_sizes[0] : -1, out_size, ws_size); grid = -1; return; }
        int dev = 0, cus = 0, per_cu = 0;
        if (hipGetDevice(&dev) != hipSuccess || hipDeviceGetAttribute(&cus, hipDeviceAttributeMultiprocessorCount, dev) != hipSuccess) { grid = -1; return; }
        if (hipFuncSetAttribute((const void*)fwd_kernel, hipFuncAttributeMaxDynamicSharedMemorySize, LDS_BYTES) != hipSuccess) { fprintf(stderr, "kernel_launch: hipFuncSetAttribute failed\n"); grid = -1; return; }
        if (hipOccupancyMaxActiveBlocksPerMultiprocessor(&per_cu, (const void*)fwd_kernel, NWAVES * 64, LDS_BYTES) != hipSuccess || per_cu < 1) fprintf(stderr, "kernel_launch: occupancy query reports %d\n", per_cu);
        (void)hipGetLastError();
        grid = cus;
    }
    if (grid < 0) return;
    (void)hipMemsetAsync((char*)d_ws + WS_CTL, 0, CTL_ZERO_BYTES, stream);
    Args a{};
    for (int i = 0; i < 23; ++i) a.in[i] = (const float*)d_in[i];
    a.out = (float*)d_out; a.ws = (unsigned char*)d_ws;
    if (N_LAUNCHES == 1) { a.ph_lo = 0; a.ph_hi = N_PHASES; hipLaunchKernelGGL(fwd_kernel, dim3(grid), dim3(NWAVES * 64), LDS_BYTES, stream, a); }
    else for (int p = 0; p < N_PHASES; ++p) { a.ph_lo = p; a.ph_hi = p + 1; hipLaunchKernelGGL(fwd_kernel, dim3(grid), dim3(NWAVES * 64), LDS_BYTES, stream, a); }
}
```

```cpp
#include <hip/hip_runtime.h>
#include <cstdio>
#include <cstdint>
#include <cmath>
#define MK_N_LAUNCHES 1
namespace pg8 {
#define PG8_LAS __attribute__((address_space(3)))
typedef unsigned short bf16_t;
typedef short bf16x8 __attribute__((ext_vector_type(8)));
typedef float f32x4 __attribute__((ext_vector_type(4)));
typedef unsigned u32x4 __attribute__((ext_vector_type(4)));
constexpr int BM = 256, BK = 64, HALF = 128, HTB = HALF * BK * 2  , STAGE_BYTES = 8 * HTB, NXCD = 8, WGM = 8;

__host__ __device__ __forceinline__ int lds_byte(int r, int c) { const int st = (r >> 4) * 2 + (c >> 5), rr = r & 15, cc = c & 31, ob = rr * 64 + cc * 2; return st * 1024 + (ob ^ (((ob >> 9) & 1) << 5)); }
__host__ __device__ __forceinline__ void stage_rc(int b, int& R, int& C) { const int st = b / 1024, sb = b % 1024, swz = sb ^ (((sb >> 9) & 1) << 5); R = (st >> 1) * 16 + swz / 64; C = (st & 1) * 32 + (swz % 64) / 2; }
__host__ __device__ __forceinline__ int perm32(int rho) { const int n = rho >> 4, i = rho & 15; return 8 * (i >> 2) + 4 * n + (i & 3); }

struct Unit { int pm, pn; };
struct Gemm { const bf16_t* A; const bf16_t* Bt; int M, N, K; };

struct StaticOrder {
    int nM, nN, nwg, G, c;
    __host__ __device__ void init(int M, int N, int G_, int c_) { nM = M / BM; nN = N / BM; nwg = nM * nN; G = G_; c = c_; }
    __host__ __device__ bool next(int i, Unit& u) const {
        const long L = (long)i * G + c; if (L >= nwg) return false;
        int wgid = (int)L; { const int q = nwg / NXCD, r = nwg % NXCD, xcd = wgid % NXCD, off = wgid / NXCD; wgid = (xcd < r ? xcd * (q + 1) : r * (q + 1) + (xcd - r) * q) + off; }
        const int nig = WGM * nN, gid = wgid / nig, fm = gid * WGM, gsz = (nM - fm) < WGM ? (nM - fm) : WGM;
        u.pm = fm + ((wgid % nig) % gsz); u.pn = (wgid % nig) / gsz; return true;
    }
    __device__ __forceinline__ void a_ready(const Unit&) const {}
    __device__ __forceinline__ void done(const Unit&) const {}
};

__device__ __forceinline__ unsigned cvt_pk_bf16(float lo, float hi) { unsigned r; asm volatile("v_cvt_pk_bf16_f32 %0, %1, %2" : "=v"(r) : "v"(lo), "v"(hi)); return r; }
typedef float f32x2 __attribute__((ext_vector_type(2)));
__device__ __forceinline__ f32x2 gelu_pk(f32x2 v) {
    const f32x2 av = __builtin_elementwise_abs(v), d = av * 0.2316418882f + 1.0f;
    f32x2 t; t.x = __builtin_amdgcn_rcpf(d.x); t.y = __builtin_amdgcn_rcpf(d.y);
    f32x2 q = t * 0.5307027145f + (-0.7265760135f); q = q * t + 0.7107068705f; q = q * t + (-0.142248368f); q = q * t + 0.127414796f; q = q * t;
    const f32x2 s = (v * v) * (-0.72134752044f);
    f32x2 e; e.x = __builtin_amdgcn_exp2f(s.x); e.y = __builtin_amdgcn_exp2f(s.y);
    const f32x2 m = v * (q * e), r = v - m;
    f32x2 o; o.x = v.x < 0.f ? m.x : r.x; o.y = v.y < 0.f ? m.y : r.y; return o;
}

template <int ACT  > struct EpiBf16 {
    static constexpr bool PERM = true, AFTER_DRAIN = false; static_assert(ACT == 0 || ACT == 1, "EpiBf16: ACT is 0 (none) or 1 (gelu_pk)");
    bf16_t* O; int ldc; const float* bias; int split_cols; size_t split_stride; float scale0;
    __device__ __forceinline__ void operator()(const f32x4 (&acc)[2][2][4][2], const Unit& u, int wr, int wc, int fr, int fq) const {
        const int row0 = u.pm * BM + wr * 64 + fr; int colt = u.pn * BM; bf16_t* base = O;
        float sc = 1.f; if (split_cols) { const int t = colt / split_cols; base += (size_t)t * split_stride; colt -= t * split_cols; if (t == 0) sc = scale0; }
        const int col0 = colt + wc * 32 + 8 * fq, bcol0 = u.pn * BM + wc * 32 + 8 * fq;
        f32x4 bv[2][2];
#pragma unroll
        for (int bj = 0; bj < 2; ++bj)
#pragma unroll
            for (int n = 0; n < 2; ++n) bv[bj][n] = bias ? *(const f32x4*)(bias + bcol0 + bj * HALF + 4 * n) : (f32x4){0.f, 0.f, 0.f, 0.f};
#pragma unroll
        for (int ai = 0; ai < 2; ++ai)
#pragma unroll
            for (int m = 0; m < 4; ++m) { bf16_t* rowp = base + (size_t)(row0 + ai * HALF + m * 16) * ldc + col0;
#pragma unroll
                for (int bj = 0; bj < 2; ++bj) { f32x4 v0 = acc[ai][bj][m][0] + bv[bj][0], v1 = acc[ai][bj][m][1] + bv[bj][1];
                    if (ACT == 1) { f32x2 a = gelu_pk((f32x2){v0[0], v0[1]}), b = gelu_pk((f32x2){v0[2], v0[3]}), c = gelu_pk((f32x2){v1[0], v1[1]}), d = gelu_pk((f32x2){v1[2], v1[3]});
                        v0 = (f32x4){a.x, a.y, b.x, b.y}; v1 = (f32x4){c.x, c.y, d.x, d.y}; }
                    v0 = v0 * sc; v1 = v1 * sc; u32x4 w; w.x = cvt_pk_bf16(v0[0], v0[1]); w.y = cvt_pk_bf16(v0[2], v0[3]); w.z = cvt_pk_bf16(v1[0], v1[1]); w.w = cvt_pk_bf16(v1[2], v1[3]);
                    *(u32x4*)(rowp + bj * HALF) = w; } }
    }
};

struct PanelStats {
    unsigned* xbuf;
    unsigned* cnt;
    unsigned* tmo;
    int ntn; float eps;
    unsigned code;
    __device__ __forceinline__ bool run(const f32x4 (&v)[2][2][4][2], const Unit& u, int wr, int wc, int fr, int fq, PG8_LAS unsigned char* lds, int wid, int lane) const {
        typedef float f32x2v __attribute__((ext_vector_type(2)));
        PG8_LAS f32x2v* P = (PG8_LAS f32x2v*)lds;
        PG8_LAS f32x2v* S = (PG8_LAS f32x2v*)(lds + 8192);
        PG8_LAS unsigned* flag = (PG8_LAS unsigned*)(lds + 8192 + 2048);
#pragma unroll
        for (int ai = 0; ai < 2; ++ai)
#pragma unroll
            for (int m = 0; m < 4; ++m) {
                float s = 0.f;
#pragma unroll
                for (int bj = 0; bj < 2; ++bj)
#pragma unroll
                    for (int n = 0; n < 2; ++n) { const f32x4 x = v[ai][bj][m][n]; s += (x[0] + x[1]) + (x[2] + x[3]); }
                s += __shfl_xor(s, 16); s += __shfl_xor(s, 32);
                const float mw = s * (1.0f / 64.0f); float q = 0.f;
#pragma unroll
                for (int bj = 0; bj < 2; ++bj)
#pragma unroll
                    for (int n = 0; n < 2; ++n) { const f32x4 d = v[ai][bj][m][n] - mw; q += (d[0] * d[0] + d[1] * d[1]) + (d[2] * d[2] + d[3] * d[3]); }
                q += __shfl_xor(q, 16); q += __shfl_xor(q, 32);
                if (fq == 0) P[(ai * HALF + wr * 64 + m * 16 + fr) * 4 + wc] = (f32x2v){mw, q};
            }
        asm volatile("s_waitcnt lgkmcnt(0)" ::: "memory"); __builtin_amdgcn_s_barrier(); asm volatile("" ::: "memory");
#if defined(BROKEN_EXCHANGE_NO_WAIT)
#warning BROKEN CONTROL BUILD: the row-statistics exchange does not wait; results are wrong by design
        if (blockIdx.x >= 64) { const long long t0_ = clock64(); while (clock64() - t0_ < 60000) __builtin_amdgcn_s_sleep(8); }
#endif
        const int row = wid * 32 + (lane & 31);
        if (lane < 32) {
            const f32x2v a = P[row * 4 + 0], b = P[row * 4 + 1], c = P[row * 4 + 2], d = P[row * 4 + 3];
            const float mt = (a.x + b.x + c.x + d.x) * 0.25f;
            const float da = a.x - mt, db = b.x - mt, dc = c.x - mt, dd = d.x - mt;
            const float m2 = (a.y + b.y) + (c.y + d.y) + 64.0f * ((da * da + db * db) + (dc * dc + dd * dd));
            unsigned long long* slot = (unsigned long long*)xbuf + ((size_t)(u.pm * BM + row) * 4 + u.pn);
            __hip_atomic_store(slot, ((unsigned long long)__float_as_uint(m2) << 32) | __float_as_uint(mt), __ATOMIC_RELAXED, __HIP_MEMORY_SCOPE_AGENT);
        }
        asm volatile("s_waitcnt vmcnt(0)" ::: "memory");
        if (lane == 0) __hip_atomic_fetch_add(cnt + 64 * u.pm, 1u, __ATOMIC_RELAXED, __HIP_MEMORY_SCOPE_AGENT);
        if (wid == 0) {
            bool dead = false; const unsigned long long t0 = __builtin_amdgcn_s_memrealtime(); const unsigned want = 8u * (unsigned)ntn;
            for (;;) {
#if defined(BROKEN_EXCHANGE_NO_WAIT)
                break;
#endif
                if ((unsigned)__builtin_amdgcn_readfirstlane(__hip_atomic_load(cnt + 64 * u.pm, __ATOMIC_RELAXED, __HIP_MEMORY_SCOPE_AGENT)) >= want) break;
                if (__builtin_amdgcn_s_memrealtime() - t0 > 2000000ull) {
                    if (lane == 0) { unsigned expect = 0u; __hip_atomic_compare_exchange_strong(tmo + 1, &expect, code | (unsigned)(u.pm & 0xff), __ATOMIC_RELAXED, __ATOMIC_RELAXED, __HIP_MEMORY_SCOPE_AGENT);
                                     __hip_atomic_store(tmo, 1u, __ATOMIC_RELAXED, __HIP_MEMORY_SCOPE_AGENT); }
                    dead = true; break; }
                __builtin_amdgcn_s_sleep(2);
            }
            __builtin_amdgcn_fence(__ATOMIC_ACQUIRE, "agent");
            if (lane == 0) flag[0] = dead ? 1u : 0u;
        }
        asm volatile("s_waitcnt vmcnt(0) lgkmcnt(0)" ::: "memory"); __builtin_amdgcn_s_barrier(); asm volatile("" ::: "memory");
        const bool bad = flag[0] != 0u;
        if (lane < 32) {
            const unsigned long long* slot = (const unsigned long long*)xbuf + (size_t)(u.pm * BM + row) * 4; float mt[4], m2[4]; float ms = 0.f;
#pragma unroll
            for (int t = 0; t < 4; ++t) { if (t < ntn) { const unsigned long long w = __hip_atomic_load(slot + t, __ATOMIC_RELAXED, __HIP_MEMORY_SCOPE_AGENT); mt[t] = __uint_as_float((unsigned)w); m2[t] = __uint_as_float((unsigned)(w >> 32)); } else { mt[t] = 0.f; m2[t] = 0.f; } ms += mt[t]; }
            const float mean = ms / (float)ntn; float q = 0.f;
#pragma unroll
            for (int t = 0; t < 4; ++t) if (t < ntn) { const float dm = mt[t] - mean; q += m2[t] + 256.0f * dm * dm; }
            S[row] = (f32x2v){mean, 1.0f / sqrtf(q / (256.0f * (float)ntn) + eps)};
        }
        asm volatile("s_waitcnt lgkmcnt(0)" ::: "memory"); __builtin_amdgcn_s_barrier(); asm volatile("" ::: "memory");
        return bad;
    }
};
struct EpiLnRes {
    static constexpr bool PERM = false, AFTER_DRAIN = true;
    const float* base; float* out; int ldc; const float* bias; PanelStats st; unsigned poison;
    __device__ __forceinline__ void fused(f32x4 (&acc)[2][2][4][2], const Unit& u, int wr, int wc, int fr, int fq, PG8_LAS unsigned char* lds, int wid, int lane) const {
        typedef float f32x2v __attribute__((ext_vector_type(2)));
        const PG8_LAS f32x2v* S = (const PG8_LAS f32x2v*)(lds + 8192);
        const int col0 = u.pn * BM + wc * 32 + 4 * fq;
#pragma unroll
        for (int bj = 0; bj < 2; ++bj)
#pragma unroll
            for (int n = 0; n < 2; ++n) { const f32x4 bv = bias ? *(const f32x4*)(bias + col0 + bj * HALF + n * 16) : (f32x4){0.f, 0.f, 0.f, 0.f};
#pragma unroll
                for (int ai = 0; ai < 2; ++ai)
#pragma unroll
                    for (int m = 0; m < 4; ++m) acc[ai][bj][m][n] += bv; }
        f32x4 pre[4][2][2];
#pragma unroll
        for (int m = 0; m < 4; ++m) { const size_t off = (size_t)(u.pm * BM + wr * 64 + m * 16 + fr) * ldc + col0;
#pragma unroll
            for (int bj = 0; bj < 2; ++bj)
#pragma unroll
                for (int n = 0; n < 2; ++n) pre[m][bj][n] = *(const f32x4*)(base + off + bj * HALF + n * 16); }
        const bool bad = st.run(acc, u, wr, wc, fr, fq, lds, wid, lane) || poison != 0u;
        const float qnan = __builtin_nanf("");
#pragma unroll
        for (int ai = 0; ai < 2; ++ai)
#pragma unroll
            for (int m = 0; m < 4; ++m) { const int r = ai * HALF + wr * 64 + m * 16 + fr; const f32x2v sr = S[r]; const size_t off = (size_t)(u.pm * BM + r) * ldc + col0;
#pragma unroll
                for (int bj = 0; bj < 2; ++bj)
#pragma unroll
                    for (int n = 0; n < 2; ++n) { const f32x4 bs = ai == 0 ? pre[m][bj][n] : *(const f32x4*)(base + off + bj * HALF + n * 16); f32x4 o = bs + (acc[ai][bj][m][n] - sr.x) * sr.y;
                        if (bad) o = (f32x4){qnan, qnan, qnan, qnan}; *(f32x4*)(out + off + bj * HALF + n * 16) = o; }
                if (m & 1) asm volatile("" ::: "memory"); }
    }
};
struct EpiLnResLn {
    static constexpr bool PERM = false, AFTER_DRAIN = true;
    const float* base; float* out; bf16_t* xn; int ldc; const float* bias; PanelStats st1, st2; unsigned poison;
    __device__ __forceinline__ void fused(f32x4 (&acc)[2][2][4][2], const Unit& u, int wr, int wc, int fr, int fq, PG8_LAS unsigned char* lds, int wid, int lane) const {
        typedef float f32x2v __attribute__((ext_vector_type(2))); typedef unsigned u32x2v __attribute__((ext_vector_type(2)));
        const PG8_LAS f32x2v* S = (const PG8_LAS f32x2v*)(lds + 8192);
        const int col0 = u.pn * BM + wc * 32 + 4 * fq;
#pragma unroll
        for (int bj = 0; bj < 2; ++bj)
#pragma unroll
            for (int n = 0; n < 2; ++n) { const f32x4 bv = bias ? *(const f32x4*)(bias + col0 + bj * HALF + n * 16) : (f32x4){0.f, 0.f, 0.f, 0.f};
#pragma unroll
                for (int ai = 0; ai < 2; ++ai)
#pragma unroll
                    for (int m = 0; m < 4; ++m) acc[ai][bj][m][n] += bv; }
        bool bad = st1.run(acc, u, wr, wc, fr, fq, lds, wid, lane) || poison != 0u;
        const float qnan = __builtin_nanf("");
#pragma unroll
        for (int ai = 0; ai < 2; ++ai)
#pragma unroll
            for (int m = 0; m < 4; ++m) { const int r = ai * HALF + wr * 64 + m * 16 + fr; const f32x2v sr = S[r]; const size_t off = (size_t)(u.pm * BM + r) * ldc + col0;
#pragma unroll
                for (int bj = 0; bj < 2; ++bj)
#pragma unroll
                    for (int n = 0; n < 2; ++n) { const f32x4 bs = *(const f32x4*)(base + off + bj * HALF + n * 16); acc[ai][bj][m][n] = bs + (acc[ai][bj][m][n] - sr.x) * sr.y; }
                asm volatile("" : "+v"(acc[ai][0][m][0]), "+v"(acc[ai][0][m][1]), "+v"(acc[ai][1][m][0]), "+v"(acc[ai][1][m][1]));
                if (m & 1) asm volatile("" ::: "memory"); }
        const bool bad1 = bad;
        bad = st2.run(acc, u, wr, wc, fr, fq, lds, wid, lane) || bad;
#pragma unroll
        for (int ai = 0; ai < 2; ++ai)
#pragma unroll
            for (int m = 0; m < 4; ++m) { const int r = ai * HALF + wr * 64 + m * 16 + fr; const f32x2v sr = S[r]; const size_t off = (size_t)(u.pm * BM + r) * ldc + col0;
#pragma unroll
                for (int bj = 0; bj < 2; ++bj)
#pragma unroll
                    for (int n = 0; n < 2; ++n) { const f32x4 x1 = acc[ai][bj][m][n]; *(f32x4*)(out + off + bj * HALF + n * 16) = bad1 ? (f32x4){qnan, qnan, qnan, qnan} : x1;
                        const f32x4 o = (x1 - sr.x) * sr.y; u32x2v w; w.x = cvt_pk_bf16(o[0], o[1]); w.y = cvt_pk_bf16(o[2], o[3]);
                        if (bad) { w.x = 0x7fc07fc0u; w.y = 0x7fc07fc0u; } *(u32x2v*)(xn + off + bj * HALF + n * 16) = w; }
                asm volatile("" ::: "memory"); }
    }
};

template <class Epi, class Sched, bool ALIGN_EPI = false, bool SP2 = false>
__device__ __forceinline__ void gemm_phase(PG8_LAS unsigned char* lds, const Gemm g, const Sched& S, const Epi& E) {
    const int tid = threadIdx.x, wid = __builtin_amdgcn_readfirstlane(tid >> 6), lane = tid & 63, wr = wid >> 2, wc = wid & 3, fr = lane & 15, fq = lane >> 4;
    const int K = g.K, nt = K / BK;
    unsigned voffA[2], voffB[2];
#pragma unroll
    for (int i = 0; i < 2; ++i) { int R, C; stage_rc(tid * 16 + i * 8192, R, C); const int Rb = Epi::PERM ? ((R & ~31) + perm32(R & 31)) : R;
        voffA[i] = (unsigned)(R * K + C) * 2u; voffB[i] = (unsigned)(Rb * K + C) * 2u; }
    const size_t kstep = (size_t)(BK * 2);
    const size_t hstep = (size_t)HALF * K * 2;
    const size_t tstep = 2 * hstep;
    const unsigned ldsw = (unsigned)wid * 1024u;
    const int aoff = lds_byte(wr * 64 + fr, fq * 8), boff = lds_byte(wc * 32 + fr, fq * 8);
#define PG8_SA(b, h) (((b) * 2 + (h)) * HTB)
#define PG8_SB(b, h) ((4 + (b) * 2 + (h)) * HTB)
#define PG8_STAGE(bufoff, gbase, voff) do { _Pragma("unroll") for (int _i = 0; _i < 2; ++_i) \
        __builtin_amdgcn_global_load_lds((const unsigned*)((const char*)(gbase) + (voff)[_i]), (PG8_LAS unsigned*)(lds + (bufoff) + ldsw + _i * 8192), 16, 0, 0); } while (0)
#define PG8_LDA(dst, b, h) do { _Pragma("unroll") for (int m = 0; m < 4; ++m) _Pragma("unroll") for (int k = 0; k < 2; ++k) dst[m][k] = *(const PG8_LAS bf16x8*)(lds + PG8_SA(b, h) + aoff + m * 2048 + k * 1024); } while (0)
#define PG8_LDB(dst, b, h) do { _Pragma("unroll") for (int n = 0; n < 2; ++n) _Pragma("unroll") for (int k = 0; k < 2; ++k) dst[n][k] = *(const PG8_LAS bf16x8*)(lds + PG8_SB(b, h) + boff + n * 2048 + k * 1024); } while (0)
#define PG8_MMA(ai, bj, At, Bt) do { __builtin_amdgcn_s_setprio(1); _Pragma("unroll") for (int m = 0; m < 4; ++m) _Pragma("unroll") for (int n = 0; n < 2; ++n) _Pragma("unroll") for (int k = 0; k < 2; ++k) \
        acc[ai][bj][m][n] = __builtin_amdgcn_mfma_f32_16x16x32_bf16(Bt[n][k], At[m][k], acc[ai][bj][m][n], 0, 0, 0); __builtin_amdgcn_s_setprio(0); } while (0)
#define PG8_WAIT_V(n) asm volatile("s_waitcnt vmcnt(" #n ")" ::: "memory")
#define PG8_WAIT_L(n) asm volatile("s_waitcnt lgkmcnt(" #n ")" ::: "memory")
#define PG8_BAR __builtin_amdgcn_s_barrier()
#define PG8_SCHED __builtin_amdgcn_sched_barrier(0)
    Unit cur, nxt; int ui = 0;
    if (!S.next(0, cur)) return;
    f32x4 acc[2][2][4][2];
#pragma unroll
    for (int a = 0; a < 2; ++a)
#pragma unroll
        for (int b = 0; b < 2; ++b)
#pragma unroll
            for (int m = 0; m < 4; ++m)
#pragma unroll
                for (int n = 0; n < 2; ++n) acc[a][b][m][n] = (f32x4){0.f, 0.f, 0.f, 0.f};
    bf16x8 At[4][2], B0[2][2], B1[2][2];
    const char* cA = (const char*)g.A + (size_t)cur.pm * tstep; const char* cB = (const char*)g.Bt + (size_t)cur.pn * tstep;
    S.a_ready(cur);
    if constexpr (SP2) {
        PG8_STAGE(PG8_SB(0, 0), cB, voffB); PG8_STAGE(PG8_SB(0, 1), cB + hstep, voffB); PG8_STAGE(PG8_SA(0, 0), cA, voffA); PG8_STAGE(PG8_SA(0, 1), cA + hstep, voffA);
        if (wr == 1) PG8_BAR;
        PG8_WAIT_V(2); PG8_BAR;
        PG8_STAGE(PG8_SB(1, 0), cB + kstep, voffB); PG8_STAGE(PG8_SA(1, 0), cA + kstep, voffA); PG8_STAGE(PG8_SB(1, 1), cB + hstep + kstep, voffB);
        PG8_WAIT_V(6); PG8_BAR;
    } else {
        PG8_STAGE(PG8_SB(0, 0), cB, voffB); PG8_STAGE(PG8_SA(0, 0), cA, voffA); PG8_STAGE(PG8_SB(0, 1), cB + hstep, voffB); PG8_STAGE(PG8_SA(0, 1), cA + hstep, voffA);
        if (wr == 1) PG8_BAR;
        PG8_WAIT_V(4); PG8_BAR;
        PG8_STAGE(PG8_SB(1, 0), cB + kstep, voffB); PG8_STAGE(PG8_SA(1, 0), cA + kstep, voffA); PG8_STAGE(PG8_SB(1, 1), cB + hstep + kstep, voffB);
        PG8_WAIT_V(6); PG8_BAR;
    }
    for (;;) {
        const bool has_next = S.next(ui + 1, nxt);
        const char* nA = has_next ? (const char*)g.A + (size_t)nxt.pm * tstep : cA; const char* nB = has_next ? (const char*)g.Bt + (size_t)nxt.pn * tstep : cB;
        for (int t = 0; t < nt; t += 2) {
            const bool last = (t == nt - 2);
            const char* a1 = cA + (size_t)(t + 1) * kstep;
            const char* a2 = last ? nA : cA + (size_t)(t + 2) * kstep; const char* b2 = last ? nB : cB + (size_t)(t + 2) * kstep;
            const char* a3 = a2 + kstep; const char* b3 = b2 + kstep;
            if (last && has_next) S.a_ready(nxt);
            if constexpr (SP2) {
            PG8_LDB(B0, 0, 0); PG8_LDB(B1, 0, 1); PG8_SCHED; PG8_LDA(At, 0, 0); PG8_STAGE(PG8_SA(1, 1), a1 + hstep, voffA);
            PG8_WAIT_V(8); PG8_WAIT_L(0); PG8_BAR; PG8_MMA(0, 0, At, B0); PG8_MMA(0, 1, At, B1); PG8_BAR; PG8_SCHED;
            PG8_LDA(At, 0, 1); PG8_STAGE(PG8_SB(0, 0), b2, voffB); PG8_STAGE(PG8_SB(0, 1), b2 + hstep, voffB); PG8_STAGE(PG8_SA(0, 0), a2, voffA);
            PG8_WAIT_V(8); PG8_WAIT_L(0); PG8_BAR; PG8_MMA(1, 0, At, B0); PG8_MMA(1, 1, At, B1); PG8_BAR; PG8_SCHED;
            PG8_LDB(B0, 1, 0); PG8_LDB(B1, 1, 1); PG8_SCHED; PG8_LDA(At, 1, 0); PG8_STAGE(PG8_SA(0, 1), a2 + hstep, voffA);
            PG8_WAIT_V(8); PG8_WAIT_L(0); PG8_BAR; PG8_MMA(0, 0, At, B0); PG8_MMA(0, 1, At, B1); PG8_BAR; PG8_SCHED;
            PG8_LDA(At, 1, 1); PG8_STAGE(PG8_SB(1, 0), b3, voffB); PG8_STAGE(PG8_SB(1, 1), b3 + hstep, voffB); PG8_STAGE(PG8_SA(1, 0), a3, voffA);
            PG8_WAIT_V(8); PG8_WAIT_L(0); PG8_BAR; PG8_MMA(1, 0, At, B0); PG8_MMA(1, 1, At, B1); PG8_BAR; PG8_SCHED;
            } else {
            PG8_LDB(B0, 0, 0); PG8_SCHED; PG8_LDA(At, 0, 0); PG8_STAGE(PG8_SA(1, 1), a1 + hstep, voffA);
            PG8_WAIT_L(8); PG8_BAR; PG8_WAIT_L(0); PG8_MMA(0, 0, At, B0); PG8_BAR; PG8_SCHED;
            PG8_LDB(B1, 0, 1); PG8_STAGE(PG8_SB(0, 0), b2, voffB);
            PG8_BAR; PG8_WAIT_L(0); PG8_MMA(0, 1, At, B1); PG8_BAR;
            PG8_LDA(At, 0, 1); PG8_STAGE(PG8_SA(0, 0), a2, voffA);
            PG8_BAR; PG8_WAIT_L(0); PG8_MMA(1, 0, At, B0); PG8_BAR; PG8_SCHED;
            PG8_STAGE(PG8_SB(0, 1), b2 + hstep, voffB);
            PG8_WAIT_V(6); PG8_BAR; PG8_MMA(1, 1, At, B1); PG8_BAR;
            PG8_LDB(B0, 1, 0); PG8_SCHED; PG8_LDA(At, 1, 0); PG8_STAGE(PG8_SA(0, 1), a2 + hstep, voffA);
            PG8_WAIT_L(8); PG8_BAR; PG8_WAIT_L(0); PG8_MMA(0, 0, At, B0); PG8_BAR; PG8_SCHED;
            PG8_LDB(B1, 1, 1); PG8_STAGE(PG8_SB(1, 0), b3, voffB);
            PG8_BAR; PG8_WAIT_L(0); PG8_MMA(0, 1, At, B1); PG8_BAR;
            PG8_LDA(At, 1, 1); PG8_STAGE(PG8_SA(1, 0), a3, voffA);
            PG8_BAR; PG8_WAIT_L(0); PG8_MMA(1, 0, At, B0); PG8_BAR; PG8_SCHED;
            PG8_STAGE(PG8_SB(1, 1), b3 + hstep, voffB);
            PG8_WAIT_V(6); PG8_BAR; PG8_MMA(1, 1, At, B1); PG8_BAR;
            }
        }
        if constexpr (ALIGN_EPI) { if (wr == 0) PG8_BAR; }
        if constexpr (!Epi::AFTER_DRAIN) { E(acc, cur, wr, wc, fr, fq); S.done(cur); }
        if (!has_next) break;
#pragma unroll
        for (int a = 0; a < 2; ++a)
#pragma unroll
            for (int b = 0; b < 2; ++b)
#pragma unroll
                for (int m = 0; m < 4; ++m)
#pragma unroll
                    for (int n = 0; n < 2; ++n) acc[a][b][m][n] = (f32x4){0.f, 0.f, 0.f, 0.f};
        cur = nxt; cA = nA; cB = nB; ++ui;
        if constexpr (ALIGN_EPI) { if (wr == 1) PG8_BAR; }
    }
    PG8_WAIT_V(0);
    if constexpr (!ALIGN_EPI) { if (wr == 0) PG8_BAR; }
    PG8_BAR;
    if constexpr (Epi::AFTER_DRAIN) { E.fused(acc, cur, wr, wc, fr, fq, lds, wid, lane); S.done(cur); }
#undef PG8_SA
#undef PG8_SB
#undef PG8_STAGE
#undef PG8_LDA
#undef PG8_LDB
#undef PG8_MMA
#undef PG8_WAIT_V
#undef PG8_WAIT_L
#undef PG8_BAR
#undef PG8_SCHED
}
}

constexpr int NWAVES = 8;
#ifndef MK_N_LAUNCHES
#define MK_N_LAUNCHES 1
#endif
constexpr int N_LAUNCHES = MK_N_LAUNCHES;
constexpr int N_PHASES = 17;

constexpr int BATCH = 16, SEQ = 2048, DM = 1024, M = BATCH * SEQ;
constexpr int EVEN_IN = 3072, ODD_IN = 2560;
constexpr float EPS = 1e-6f;

constexpr size_t MiB = 1u << 20;
constexpr size_t WS_CTL = 0, CTL_ZERO_BYTES = 1 * MiB;
constexpr size_t WS_WIN0 = 2 * MiB;
constexpr size_t WS_WOUT0 = 8 * MiB;
constexpr size_t WS_WIN1 = 10 * MiB;
constexpr size_t WS_WGLU = 15 * MiB;
constexpr size_t WS_WPW = 16 * MiB;
constexpr size_t WS_WPOOL = 17 * MiB;
constexpr size_t WS_WOUT1 = 18 * MiB;
constexpr size_t WS_ROPE = 20 * MiB;
constexpr size_t WS_S5C = 21 * MiB;
constexpr size_t WS_KBAR = 22 * MiB;
constexpr size_t WS_XN = 32 * MiB;
constexpr size_t WS_Z = 96 * MiB;
constexpr size_t WS_MB = 288 * MiB;
constexpr size_t WS_Y = 352 * MiB;
constexpr size_t WS_T1 = 416 * MiB;
constexpr size_t WS_T2 = 448 * MiB;
constexpr size_t WS_END = 480 * MiB;
constexpr int CW_BAR = 4096;

constexpr int RING_OFF = 0, RING_BYTES = 131072;
constexpr int LDSCTL_OFF = RING_BYTES, MISC_OFF = LDSCTL_OFF + 320;
constexpr int LDS_BYTES = 147456;

#define GAS __attribute__((address_space(1)))
#define LAS __attribute__((address_space(3)))
typedef unsigned short bf16;
typedef unsigned v4u __attribute__((ext_vector_type(4)));
typedef unsigned v2u __attribute__((ext_vector_type(2)));
typedef float f32x4 __attribute__((ext_vector_type(4)));
#define LDS_WAIT() asm volatile("s_waitcnt lgkmcnt(0)" ::: "memory")
#define VM_WAIT() asm volatile("s_waitcnt vmcnt(0)" ::: "memory")
__device__ __forceinline__ unsigned f2bf(float f) { unsigned u = __builtin_bit_cast(unsigned, f); return (u + 0x7fffu + ((u >> 16) & 1u)) >> 16; }
__device__ __forceinline__ unsigned pk2(float lo, float hi) { return f2bf(lo) | (f2bf(hi) << 16); }
__device__ __forceinline__ float bf2f(unsigned short v) { return __builtin_bit_cast(float, (unsigned)v << 16); }
__device__ __forceinline__ float bflo(unsigned w) { return __builtin_bit_cast(float, w << 16); }
__device__ __forceinline__ float bfhi(unsigned w) { return __builtin_bit_cast(float, w & 0xffff0000u); }
__device__ __forceinline__ float sigmoidf_(float x) { return 1.0f / (1.0f + __expf(-x)); }
__device__ __forceinline__ float siluf_(float x) { return x / (1.0f + __expf(-x)); }

#define XB_TMO      128
#define XB_XCNT(j)  (256  + 64 * (j))
#define XB_XSUB(j)  (1280 + 64 * (j))
#define XB_XGEN(j)  (2304 + 64 * (j))
#define XB_TOP      3328
#define XB_TOPGEN   3392
#define XCD_BAR_WORDS 3456
#define XB_SPIN_CAP (1u << 18)
__device__ __forceinline__ unsigned xb_ld(unsigned* p)              { return __hip_atomic_load(p, __ATOMIC_RELAXED, __HIP_MEMORY_SCOPE_AGENT); }
__device__ __forceinline__ unsigned xb_add(unsigned* p, unsigned v) { return __hip_atomic_fetch_add(p, v, __ATOMIC_RELAXED, __HIP_MEMORY_SCOPE_AGENT); }
__device__ __forceinline__ unsigned xb_xcc_id() { return (unsigned)__builtin_amdgcn_s_getreg((3 << 11) | 20) & 0xFu; }
#define XB_SPIN(cond, bar) do { unsigned _sp = 0; while (cond) { __builtin_amdgcn_s_sleep(1); \
    if ((++_sp & 255u) == 0u) { if (xb_ld(&(bar)[XB_TMO])) break; if (_sp > XB_SPIN_CAP) { atomicAdd(&(bar)[XB_TMO], 1u); break; } } } } while (0)
struct XcdBarrier { unsigned* bar; unsigned x; volatile LAS unsigned* st; };
__device__ __forceinline__ XcdBarrier xcd_barrier_post(unsigned* bar, volatile LAS unsigned* st) {
    XcdBarrier b; b.bar = bar; b.x = xb_xcc_id(); b.st = st;
    if (threadIdx.x == 0) (void)xb_add(&bar[XB_XCNT(b.x)], 1u);
    return b;
}
__device__ __forceinline__ void xcd_barrier_complete(unsigned* bar, unsigned x, unsigned& nloc, unsigned& nx) {
    const unsigned G = gridDim.x * gridDim.y * gridDim.z;
    unsigned sum, cnt, mine, sp = 0u;
    for (;;) {
        sum = 0u; cnt = 0u; mine = 0u;
#pragma unroll
        for (unsigned j = 0; j < 16; ++j) { const unsigned c = xb_ld(&bar[XB_XCNT(j)]); sum += c; cnt += (c > 0u) ? 1u : 0u; mine = (j == x) ? c : mine; }
        if (sum == G) break;
        __builtin_amdgcn_s_sleep(1);
        if ((++sp & 255u) == 0u) { if (xb_ld(&bar[XB_TMO])) break; if (sp > XB_SPIN_CAP) { atomicAdd(&bar[XB_TMO], 1u); break; } }
    }
    nloc = mine > 0u ? mine : 1u; nx = cnt > 0u ? cnt : 1u;
}
__device__ __forceinline__ void xcd_barrier(const XcdBarrier& b) {
    asm volatile("s_waitcnt vmcnt(0)" ::: "memory");
    __syncthreads();
    if (threadIdx.x == 0) {
        unsigned* bar = b.bar;
        __builtin_amdgcn_s_waitcnt(0);
        unsigned nloc = b.st[0], nx = b.st[1];
        if (nloc == 0u) { xcd_barrier_complete(bar, b.x, nloc, nx); b.st[0] = nloc; b.st[1] = nx; }
        const unsigned old = xb_add(&bar[XB_XSUB(b.x)], 1u);
        const unsigned gen = old / nloc;
        if (old + 1u == (gen + 1u) * nloc) {
            __builtin_amdgcn_fence(__ATOMIC_RELEASE, "agent");
            asm volatile("s_waitcnt vmcnt(0)" ::: "memory");
            const unsigned og = xb_add(&bar[XB_TOP], 1u);
            const unsigned tg = og / nx;
            if (og + 1u == (tg + 1u) * nx) xb_add(&bar[XB_TOPGEN], 1u);
            else XB_SPIN(xb_ld(&bar[XB_TOPGEN]) == tg, bar);
            __builtin_amdgcn_fence(__ATOMIC_ACQUIRE, "agent");
            xb_add(&bar[XB_XGEN(b.x)], 1u);
            asm volatile("s_waitcnt vmcnt(0)" ::: "memory");
        } else {
            XB_SPIN(xb_ld(&bar[XB_XGEN(b.x)]) == gen, bar);
            __builtin_amdgcn_fence(__ATOMIC_ACQUIRE, "agent");
            asm volatile("s_waitcnt vmcnt(0)" ::: "memory");
        }
    }
    __syncthreads();
}

struct Frame {
    LAS unsigned char* lds;
    int tid, lane, wave;
    int vcu, G, gw, NGW;
    const float* in[23]; float* out; unsigned char* ws;
};
__device__ __forceinline__ float wave_sum(float v) {
#pragma unroll
    for (int o = 1; o < 64; o <<= 1) v += __shfl_xor(v, o);
    return v;
}
__device__ __forceinline__ float wave_max(float v) {
#pragma unroll
    for (int o = 1; o < 64; o <<= 1) v = fmaxf(v, __shfl_xor(v, o));
    return v;
}

__device__ __forceinline__ void p0_transpose_item(const float* W, int K, int N, bf16* WT, const float* gk, LAS float* scr, int item, int lane) {
    const int nblk = N / 32, kb = item / nblk, nb = item % nblk, k0 = 64 * kb, n0 = 32 * nb;
#pragma unroll 8
    for (int i = 0; i < 32; ++i) { const int kk = 2 * i + (lane >> 5); float v = W[(size_t)(k0 + kk) * N + n0 + (lane & 31)]; if (gk) v *= gk[k0 + kk]; scr[kk * 33 + (lane & 31)] = v; }
    LDS_WAIT(); asm volatile("" ::: "memory");
    const int c = lane & 7;
#pragma unroll
    for (int j = 0; j < 4; ++j) { const int n = (lane >> 3) + 8 * j; const LAS float* s = scr + (8 * c) * 33 + n;
        v4u o; o.x = pk2(s[0 * 33], s[1 * 33]); o.y = pk2(s[2 * 33], s[3 * 33]); o.z = pk2(s[4 * 33], s[5 * 33]); o.w = pk2(s[6 * 33], s[7 * 33]);
        *(GAS v4u*)(WT + (size_t)(n0 + n) * K + k0 + 8 * c) = o; }
    LDS_WAIT(); asm volatile("" ::: "memory");
}

__device__ __forceinline__ void ph_prologue(Frame& F) {
    LAS float* scr = (LAS float*)(F.lds + RING_OFF + F.wave * 16384);
    unsigned char* ws = F.ws;
    const int I_IN0 = (1024 / 64) * (EVEN_IN / 32), I_SQ = (1024 / 64) * (1024 / 32), I_IN1 = (1024 / 64) * (ODD_IN / 32), I_GLU = (512 / 64) * (1024 / 32), I_PW = (512 / 64) * (512 / 32);
    const int NITEMS = I_IN0 + I_SQ + I_IN1 + I_GLU + I_PW + I_SQ;
    for (int it = F.gw; it < NITEMS; it += F.NGW) {
        int r = it;
        if (r < I_IN0) { p0_transpose_item(F.in[3], 1024, EVEN_IN, (bf16*)(ws + WS_WIN0), F.in[1], scr, r, F.lane); continue; } r -= I_IN0;
        if (r < I_SQ) { p0_transpose_item(F.in[6], 1024, 1024, (bf16*)(ws + WS_WOUT0), nullptr, scr, r, F.lane); continue; } r -= I_SQ;
        if (r < I_IN1) { p0_transpose_item(F.in[7], 1024, ODD_IN, (bf16*)(ws + WS_WIN1), F.in[1] + 1024, scr, r, F.lane); continue; } r -= I_IN1;
        if (r < I_GLU) { p0_transpose_item(F.in[16], 512, 1024, (bf16*)(ws + WS_WGLU), nullptr, scr, r, F.lane); continue; } r -= I_GLU;
        if (r < I_PW) { p0_transpose_item(F.in[21], 512, 512, (bf16*)(ws + WS_WPW), nullptr, scr, r, F.lane); continue; } r -= I_PW;
        p0_transpose_item(F.in[22], 1024, 1024, (bf16*)(ws + WS_WOUT1), nullptr, scr, r, F.lane);
    }
    const int gt = F.gw * 64 + F.lane, NGT = F.NGW * 64;
    { bf16* wp = (bf16*)(ws + WS_WPOOL); const float* pw = F.in[4]; const float* ps = F.in[5];
      for (int i = gt; i < 512 * 512; i += NGT) { const int n = i >> 9, k = i & 511; float v = 0.f;
          if ((n >> 7) == (k >> 7)) v = pw[(size_t)(n >> 7) * 16384 + (k & 127) * 128 + (n & 127)] * ps[n];
          wp[i] = (bf16)f2bf(v); } }
    { float* rt = (float*)(ws + WS_ROPE);
      for (int i = gt; i < SEQ * 16; i += NGT) { const int t = i >> 4, j = i & 15;
          const float inv = (float)pow(500000.0, -(double)(2 * j) / 32.0); const float ang = (float)t * inv;
          rt[2 * i] = (float)cos((double)ang); rt[2 * i + 1] = (float)sin((double)ang); } }
    { float* sc = (float*)(ws + WS_S5C); float* Lre = sc, *Lim = sc + 2048, *BBre = sc + 4096, *BBim = sc + 4096 + 32768;
      const float* lam_re = F.in[8]; const float* lam_im = F.in[9]; const float* log_dt = F.in[10]; const float* b_re = F.in[11]; const float* b_im = F.in[12];
      for (int i = gt; i < 2048; i += NGT) { const int g = i >> 6;
          const double lr = lam_re[i], li = lam_im[i], dt = exp((double)log_dt[g]);
          const double mag = exp(lr * dt), are = mag * cos(li * dt), aim = mag * sin(li * dt);
          const double den = lr * lr + li * li, nre = are - 1.0;
          const double fre = (nre * lr + aim * li) / den, fim = (aim * lr - nre * li) / den;
          Lre[i] = (float)are; Lim[i] = (float)aim;
          for (int k = 0; k < 16; ++k) { const double br = b_re[(size_t)i * 16 + k], bi = b_im[(size_t)i * 16 + k];
              BBre[(size_t)i * 16 + k] = (float)(fre * br - fim * bi); BBim[(size_t)i * 16 + k] = (float)(fre * bi + fim * br); } } }
    { const float* x = F.in[0]; bf16* xn = (bf16*)(ws + WS_XN);
      for (int m = F.gw; m < M; m += F.NGW) {
          const GAS f32x4* xr = (const GAS f32x4*)(x + (size_t)m * DM) + F.lane;
          f32x4 v[4]; float s = 0.f;
#pragma unroll
          for (int j = 0; j < 4; ++j) { v[j] = xr[64 * j]; s += (v[j].x * v[j].x + v[j].y * v[j].y) + (v[j].z * v[j].z + v[j].w * v[j].w); }
          const float rstd = 1.0f / sqrtf(wave_sum(s) * (1.f / DM) + EPS);
          GAS v2u* o8 = (GAS v2u*)(xn + (size_t)m * DM) + F.lane;
#pragma unroll
          for (int j = 0; j < 4; ++j) { v2u w; w.x = pk2(v[j].x * rstd, v[j].y * rstd); w.y = pk2(v[j].z * rstd, v[j].w * rstd); o8[64 * j] = w; } } }
}

__device__ __forceinline__ void ph_rope(Frame& F) {
    bf16* Z = (bf16*)(F.ws + WS_Z); const float* rt = (const float*)(F.ws + WS_ROPE);
    const int gt = F.gw * 64 + F.lane, NGT = F.NGW * 64;
    for (int i = gt; i < M * 128; i += NGT) {
        const int row = i >> 7, r = i & 127, which = r >> 6, h = (r >> 4) & 3, j = r & 15, t = row & (SEQ - 1);
        bf16* p = Z + (size_t)row * EVEN_IN + which * 512 + h * 128 + j;
        const float x1 = bf2f(p[0]), x2 = bf2f(p[16]), c = rt[(t * 16 + j) * 2], s = rt[(t * 16 + j) * 2 + 1];
        p[0] = (bf16)f2bf(x1 * c - x2 * s); p[16] = (bf16)f2bf(x2 * c + x1 * s);
    }
}
__device__ __forceinline__ void ph_kbar(Frame& F) {
    const bf16* Z = (const bf16*)(F.ws + WS_Z); float* kb = (float*)(F.ws + WS_KBAR);
    const int gt = F.gw * 64 + F.lane, NGT = F.NGW * 64;
    for (int i = gt; i < BATCH * 8 * 512; i += NGT) { const int bn = i >> 9, c = i & 511; float s = 0.f;
        const bf16* p = Z + (size_t)bn * 256 * EVEN_IN + 512 + c;
        for (int k = 0; k < 256; ++k) s += bf2f(p[(size_t)k * EVEN_IN]);
        kb[i] = s * (1.f / 256.f); }
}
__device__ __forceinline__ void ph_attn_naive(Frame& F) {
    const bf16* Z = (const bf16*)(F.ws + WS_Z); const float* kbar = (const float*)(F.ws + WS_KBAR); bf16* MB = (bf16*)(F.ws + WS_MB);
    LAS float* qs = (LAS float*)(F.lds + RING_OFF + F.wave * 8192); LAS float* ps = qs + 128;
    const int lane = F.lane; const float scale = 0.08838834764831845f;
    for (int item = F.gw; item < M * 4; item += F.NGW) {
        const int row = item >> 2, h = item & 3, b = row >> 11, t = row & (SEQ - 1), qblk = t >> 8;
        const bf16* zrow = Z + (size_t)row * EVEN_IN;
        qs[lane] = bf2f(zrow[h * 128 + lane]); qs[lane + 64] = bf2f(zrow[h * 128 + 64 + lane]);
        LDS_WAIT(); asm volatile("" ::: "memory");
        float gate = -INFINITY;
        if (lane < 8 && lane < qblk) { const float* kb = kbar + (size_t)(b * 8 + lane) * 512 + h * 128; float a = 0.f; for (int d = 0; d < 128; ++d) a += qs[d] * bf2f((unsigned short)f2bf(kb[d])); gate = a; }
        float gv[8];
#pragma unroll
        for (int n = 0; n < 8; ++n) gv[n] = __shfl(gate, n);
        int blk[4];
#pragma unroll
        for (int r = 0; r < 3; ++r) { int best = -1; float bv = -INFINITY;
#pragma unroll
            for (int n = 0; n < 8; ++n) if (gv[n] > bv) { bv = gv[n]; best = n; }
#pragma unroll
            for (int n = 0; n < 8; ++n) if (n == best) gv[n] = -INFINITY;
            blk[r] = best; }
        blk[3] = qblk;
        float s[4][4];
#pragma unroll
        for (int j = 0; j < 4; ++j) {
#pragma unroll
            for (int i = 0; i < 4; ++i) s[j][i] = -INFINITY;
            if (blk[j] >= 0) {
#pragma unroll
                for (int i = 0; i < 4; ++i) { const int key = blk[j] * 256 + lane + 64 * i;
                    const GAS v4u* kr = (const GAS v4u*)(Z + (size_t)(b * SEQ + key) * EVEN_IN + 512 + h * 128); float a = 0.f;
                    for (int c = 0; c < 16; ++c) { const v4u w = kr[c]; const LAS float* q8 = qs + c * 8;
                        a += q8[0] * bflo(w.x) + q8[1] * bfhi(w.x) + q8[2] * bflo(w.y) + q8[3] * bfhi(w.y) + q8[4] * bflo(w.z) + q8[5] * bfhi(w.z) + q8[6] * bflo(w.w) + q8[7] * bfhi(w.w); }
                    a *= scale; if (j == 3 && key > t) a = -INFINITY; s[j][i] = a; } } }
        float mx = -INFINITY;
#pragma unroll
        for (int j = 0; j < 4; ++j)
#pragma unroll
            for (int i = 0; i < 4; ++i) mx = fmaxf(mx, s[j][i]);
        mx = wave_max(mx);
        float sum = 0.f;
#pragma unroll
        for (int j = 0; j < 4; ++j)
#pragma unroll
            for (int i = 0; i < 4; ++i) { const float p = __expf(s[j][i] - mx); sum += p; ps[j * 256 + lane + 64 * i] = p; }
        sum = wave_sum(sum);
        LDS_WAIT(); asm volatile("" ::: "memory");
        float a0 = 0.f, a1 = 0.f;
#pragma unroll
        for (int j = 0; j < 4; ++j) if (blk[j] >= 0) { const int nk = (j == 3) ? (t & 255) + 1 : 256;
            const bf16* vb = Z + (size_t)(b * SEQ + blk[j] * 256) * EVEN_IN + 1024 + h * 128 + 2 * lane;
            for (int k = 0; k < nk; ++k) { const unsigned w = *(const GAS unsigned*)(vb + (size_t)k * EVEN_IN); const float p = ps[j * 256 + k]; a0 += p * bflo(w); a1 += p * bfhi(w); } }
        const float inv = 1.0f / sum;
        const unsigned gw2 = *(const GAS unsigned*)(zrow + 1536 + h * 128 + 2 * lane);
        const float o0 = a0 * inv * siluf_(bflo(gw2)), o1 = a1 * inv * siluf_(bfhi(gw2));
        *(GAS unsigned*)(MB + (size_t)row * DM + h * 128 + 2 * lane) = pk2(o0, o1);
        LDS_WAIT(); asm volatile("" ::: "memory");
    }
}
__device__ __forceinline__ void ph_pool_naive(Frame& F) {
    const bf16* Z = (const bf16*)(F.ws + WS_Z); bf16* T1 = (bf16*)(F.ws + WS_T1);
    const int gt = F.gw * 64 + F.lane, NGT = F.NGW * 64;
    for (int i = gt; i < M * 512; i += NGT) { const int row = i >> 9, c = i & 511, g = c >> 7, w = 2 << g, t = row & (SEQ - 1);
        const int n = (t + 1 < w) ? t + 1 : w; const bf16* p = Z + (size_t)row * EVEN_IN + 2048 + c; float s = 0.f;
        for (int k = 0; k < n; ++k) s += bf2f(*(p - (size_t)k * EVEN_IN));
        T1[i] = (bf16)f2bf(s / (float)n - bf2f(p[0])); }
}
__device__ __forceinline__ void ph_pool_gate(Frame& F) {
    const bf16* Z = (const bf16*)(F.ws + WS_Z); const bf16* T2 = (const bf16*)(F.ws + WS_T2); bf16* MB = (bf16*)(F.ws + WS_MB);
    const int gt = F.gw * 64 + F.lane, NGT = F.NGW * 64;
    for (int i = gt; i < M * 512; i += NGT) { const int row = i >> 9, c = i & 511;
        MB[(size_t)row * DM + 512 + c] = (bf16)f2bf(bf2f(T2[i]) * siluf_(bf2f(Z[(size_t)row * EVEN_IN + 2560 + c]))); }
}
__device__ __forceinline__ void ph_norm_res(Frame& F, const float* base, const bf16* Y, const float* g, float* outp, bf16* xn) {
    for (int m = F.gw; m < M; m += F.NGW) {
        const GAS v2u* yr = (const GAS v2u*)(Y + (size_t)m * DM) + F.lane;
        float y[4][4]; float s = 0.f;
#pragma unroll
        for (int j = 0; j < 4; ++j) { const v2u w = yr[64 * j]; y[j][0] = bflo(w.x); y[j][1] = bfhi(w.x); y[j][2] = bflo(w.y); y[j][3] = bfhi(w.y);
            s += (y[j][0] * y[j][0] + y[j][1] * y[j][1]) + (y[j][2] * y[j][2] + y[j][3] * y[j][3]); }
        const float rstd = 1.0f / sqrtf(wave_sum(s) * (1.f / DM) + EPS);
        const GAS f32x4* br = (const GAS f32x4*)(base + (size_t)m * DM) + F.lane; const GAS f32x4* gr = (const GAS f32x4*)g + F.lane;
        GAS f32x4* orow = (GAS f32x4*)(outp + (size_t)m * DM) + F.lane;
        f32x4 x1[4]; float s1 = 0.f;
#pragma unroll
        for (int j = 0; j < 4; ++j) { const f32x4 bv = br[64 * j], gv = gr[64 * j];
            x1[j].x = bv.x + y[j][0] * rstd * gv.x; x1[j].y = bv.y + y[j][1] * rstd * gv.y; x1[j].z = bv.z + y[j][2] * rstd * gv.z; x1[j].w = bv.w + y[j][3] * rstd * gv.w;
            orow[64 * j] = x1[j]; s1 += (x1[j].x * x1[j].x + x1[j].y * x1[j].y) + (x1[j].z * x1[j].z + x1[j].w * x1[j].w); }
        if (xn) { const float r1 = 1.0f / sqrtf(wave_sum(s1) * (1.f / DM) + EPS);
            GAS v2u* o8 = (GAS v2u*)(xn + (size_t)m * DM) + F.lane;
#pragma unroll
            for (int j = 0; j < 4; ++j) { v2u w; w.x = pk2(x1[j].x * r1, x1[j].y * r1); w.y = pk2(x1[j].z * r1, x1[j].w * r1); o8[64 * j] = w; } }
    }
}
__device__ __forceinline__ void ph_s5_naive(Frame& F) {
    const bf16* Z = (const bf16*)(F.ws + WS_Z); bf16* T1 = (bf16*)(F.ws + WS_T1);
    const float* sc = (const float*)(F.ws + WS_S5C); const float* Lre = sc, *Lim = sc + 2048, *BBre = sc + 4096, *BBim = sc + 4096 + 32768;
    const float* c_re = F.in[13]; const float* c_im = F.in[14]; const float* dvec = F.in[15];
    const int lane = F.lane;
    for (int item = F.gw; item < BATCH * 32; item += F.NGW) {
        const int b = item >> 5, g = item & 31, gp = g * 64 + lane;
        const float are = Lre[gp], aim = Lim[gp];
        float bbr[16], bbi[16], cr[16], ci[16];
#pragma unroll
        for (int i = 0; i < 16; ++i) { bbr[i] = BBre[(size_t)gp * 16 + i]; bbi[i] = BBim[(size_t)gp * 16 + i]; cr[i] = c_re[(size_t)(g * 16 + i) * 64 + lane]; ci[i] = c_im[(size_t)(g * 16 + i) * 64 + lane]; }
        const float dmine = dvec[g * 16 + (lane & 15)];
        float xr = 0.f, xi = 0.f;
        for (int t = 0; t < SEQ; ++t) {
            const size_t row = (size_t)b * SEQ + t;
            const GAS v4u* up = (const GAS v4u*)(Z + row * ODD_IN + g * 16);
            const v4u w0 = up[0], w1 = up[1];
            float u[16];
            u[0] = bflo(w0.x); u[1] = bfhi(w0.x); u[2] = bflo(w0.y); u[3] = bfhi(w0.y); u[4] = bflo(w0.z); u[5] = bfhi(w0.z); u[6] = bflo(w0.w); u[7] = bfhi(w0.w);
            u[8] = bflo(w1.x); u[9] = bfhi(w1.x); u[10] = bflo(w1.y); u[11] = bfhi(w1.y); u[12] = bflo(w1.z); u[13] = bfhi(w1.z); u[14] = bflo(w1.w); u[15] = bfhi(w1.w);
            float bur = 0.f, bui = 0.f;
#pragma unroll
            for (int i = 0; i < 16; ++i) { bur += bbr[i] * u[i]; bui += bbi[i] * u[i]; }
            const float nr = are * xr - aim * xi + bur, ni = are * xi + aim * xr + bui; xr = nr; xi = ni;
            float mine = 0.f;
#pragma unroll
            for (int i = 0; i < 16; ++i) { const float v = wave_sum(xr * cr[i] - xi * ci[i]); if ((lane & 15) == i) mine = v; }
            if (lane < 16) { const float ui = bf2f(Z[row * ODD_IN + g * 16 + lane]); T1[row * 512 + g * 16 + lane] = (bf16)f2bf(mine + dmine * ui); }
        }
    }
}
__device__ __forceinline__ void ph_conv_naive(Frame& F) {
    const bf16* Z = (const bf16*)(F.ws + WS_Z); bf16* T2 = (bf16*)(F.ws + WS_T2);
    const float* dw = F.in[18]; const float* ln_g = F.in[19]; const float* ln_b = F.in[20];
    LAS float* red = (LAS float*)(F.lds + RING_OFF);
    const int c = F.tid;
    float wt[31];
#pragma unroll
    for (int j = 0; j < 31; ++j) wt[j] = dw[j * 512 + c];
    const float lg = ln_g[c], lb = ln_b[c];
    for (int row = blockIdx.x; row < M; row += F.G) {
        const int t = row & (SEQ - 1); float acc = 0.f;
#pragma unroll
        for (int j = 0; j < 31; ++j) { const int tt = t - 30 + j;
            if (tt >= 0) { const bf16* zr = Z + (size_t)(row - 30 + j) * ODD_IN; acc += bf2f(zr[1024 + c]) * sigmoidf_(bf2f(zr[1536 + c])) * wt[j]; } }
        float s = wave_sum(acc);
        __syncthreads();
        if (F.lane == 0) red[F.wave] = s;
        __syncthreads();
        float tot = 0.f;
#pragma unroll
        for (int w = 0; w < 8; ++w) tot += red[w];
        const float mu = tot * (1.f / 512.f), dlt = acc - mu;
        float q = wave_sum(dlt * dlt);
        __syncthreads();
        if (F.lane == 0) red[F.wave] = q;
        __syncthreads();
        float qt = 0.f;
#pragma unroll
        for (int w = 0; w < 8; ++w) qt += red[w];
        const float nrm = dlt * (1.0f / sqrtf(qt * (1.f / 512.f) + EPS)) * lg + lb;
        T2[(size_t)row * 512 + c] = (bf16)f2bf(siluf_(nrm));
    }
    __syncthreads();
}
__device__ __forceinline__ void ph_glu_gate(Frame& F) {
    const bf16* Z = (const bf16*)(F.ws + WS_Z); const bf16* Y = (const bf16*)(F.ws + WS_Y); bf16* MB = (bf16*)(F.ws + WS_MB); const float* gb = F.in[17];
    const int gt = F.gw * 64 + F.lane, NGT = F.NGW * 64;
    for (int i = gt; i < M * 512; i += NGT) { const int row = i >> 9, c = i & 511;
        const float ya = bf2f(Y[(size_t)row * 1024 + c]) + gb[c], yb = bf2f(Y[(size_t)row * 1024 + 512 + c]) + gb[512 + c];
        MB[(size_t)row * DM + c] = (bf16)f2bf(ya * sigmoidf_(yb) * siluf_(bf2f(Z[(size_t)row * ODD_IN + 512 + c]))); }
}
__device__ __forceinline__ void ph_conv_gate(Frame& F) {
    const bf16* Z = (const bf16*)(F.ws + WS_Z); const bf16* Y = (const bf16*)(F.ws + WS_Y); bf16* MB = (bf16*)(F.ws + WS_MB);
    const int gt = F.gw * 64 + F.lane, NGT = F.NGW * 64;
    for (int i = gt; i < M * 512; i += NGT) { const int row = i >> 9, c = i & 511;
        MB[(size_t)row * DM + 512 + c] = (bf16)f2bf(bf2f(Y[i]) * siluf_(bf2f(Z[(size_t)row * ODD_IN + 2048 + c]))); }
}


namespace swa {
constexpr int D = 128, ZP = 3072, OP = 1024;
constexpr float SCALE = 0.08838834764831845f;
constexpr float THR = 8.f;
constexpr int NW = 8, QBLK = 32, KVBLK = 64, QB = NW * QBLK;
constexpr int SHM_V = KVBLK * D * 2, SHM_K = KVBLK * D * 2;
constexpr int LDS_BYTES = 2 * SHM_V + 2 * SHM_K + NW * 64 * 4;
using bf16 = unsigned short;
typedef short bf16x8 __attribute__((ext_vector_type(8)));
typedef short s16x4 __attribute__((ext_vector_type(4)));
typedef float f32x16 __attribute__((ext_vector_type(16)));
typedef float f32x4 __attribute__((ext_vector_type(4)));
typedef unsigned u32x4 __attribute__((ext_vector_type(4)));
#define KSWZ(row, colB) ((row) * 256 + ((colB) ^ (((row) & 7) << 4)))
#define SBAR() __builtin_amdgcn_sched_barrier(0)
__device__ __forceinline__ int v_st(int k, int c) { const int kk = (k & ~0xC) | ((k & 4) << 1) | ((k & 8) >> 1); return ((kk >> 3) * 4 + (c >> 5)) * 512 + ((kk & 7) * 32 + (c & 31)) * 2; }
__device__ __forceinline__ int v_rd_base(int lane) { return ((lane & 3) << 3) | (((lane >> 2) & 3) << 6) | (((lane >> 4) & 1) << 5) | (((lane >> 5) & 1) << 8); }
constexpr int v_rd_off(int d0, int ks, int half) { return d0 * 512 + ks * 4096 + half * 2048; }
__device__ __forceinline__ int crow(int r, int hi) { return (r & 3) + 8 * (r >> 2) + 4 * hi; }
__device__ __forceinline__ unsigned cvtpk(float lo, float hi) { unsigned r; asm volatile("v_cvt_pk_bf16_f32 %0, %1, %2" : "=v"(r) : "v"(lo), "v"(hi)); return r; }
__device__ __forceinline__ bf16x8 load8(const bf16* p) { return *reinterpret_cast<const bf16x8*>(p); }
__device__ __forceinline__ void mask_tile(f32x16& p0, f32x16& p1, int dq) {
    const float NEG = -__builtin_inff();
#pragma unroll
    for (int r = 0; r < 16; ++r) {
        const int c = (r & 3) + 8 * (r >> 2);
        if (dq - c < 0) p0[r] = NEG;
        if (dq - c - 32 < 0) p1[r] = NEG;
    }
}
__device__ __forceinline__ void partialSM(f32x16& p0, f32x16& p1, float& m_reg, float& mn, float& alpha, bool sel) {
    float pmax = p0[0]; for (int r = 1; r < 16; ++r) pmax = fmaxf(pmax, p0[r]); for (int r = 0; r < 16; ++r) pmax = fmaxf(pmax, p1[r]);
    { auto rr = __builtin_amdgcn_permlane32_swap(__float_as_uint(pmax), __float_as_uint(pmax), false, false);
      pmax = fmaxf(__uint_as_float(rr[0]), __uint_as_float(rr[1])); }
    if (!sel) pmax = -__builtin_inff();
    constexpr float C2 = 1.4426950408889634f * SCALE;
    if (__builtin_expect(__all((pmax - m_reg) * SCALE <= THR), 1)) { mn = m_reg; alpha = 1.f; }
    else { mn = fmaxf(m_reg, pmax); alpha = __builtin_amdgcn_exp2f((m_reg - mn) * C2); m_reg = mn; }
    const float mnL = sel ? -mn * C2 : -__builtin_inff();
    for (int r = 0; r < 16; ++r) p0[r] = fmaf(p0[r], C2, mnL); for (int r = 0; r < 16; ++r) p1[r] = fmaf(p1[r], C2, mnL);
    for (int r = 0; r < 16; ++r) p0[r] = __builtin_amdgcn_exp2f(p0[r]);
}
__device__ __forceinline__ void finishSM(f32x16& p0, f32x16& p1, float alpha, float& l_reg, bf16x8& pa0, bf16x8& pa1, bf16x8& pa2, bf16x8& pa3) {
    for (int r = 0; r < 16; ++r) p1[r] = __builtin_amdgcn_exp2f(p1[r]);
    float ps = 0; for (int r = 0; r < 16; ++r) ps += p0[r]; for (int r = 0; r < 16; ++r) ps += p1[r];
    { auto rr = __builtin_amdgcn_permlane32_swap(__float_as_uint(ps), __float_as_uint(ps), false, false);
      ps = __uint_as_float(rr[0]) + __uint_as_float(rr[1]); }
    l_reg = l_reg * alpha + ps;
#define PK4(P, B_, OUT) do { unsigned a0 = cvtpk(P[B_+0], P[B_+1]), a1 = cvtpk(P[B_+2], P[B_+3]);                          \
        unsigned b0 = cvtpk(P[B_+4], P[B_+5]), b1 = cvtpk(P[B_+6], P[B_+7]);                                             \
        auto r0 = __builtin_amdgcn_permlane32_swap(a0, b0, false, false); auto r1 = __builtin_amdgcn_permlane32_swap(a1, b1, false, false); \
        u32x4 w = {r0[0], r1[0], r0[1], r1[1]}; OUT = *reinterpret_cast<bf16x8*>(&w); } while (0)
    PK4(p0, 0, pa0); PK4(p0, 8, pa1); PK4(p1, 0, pa2); PK4(p1, 8, pa3);
#undef PK4
}
template <int KB>
__device__ __forceinline__ void qkt(f32x16& p0, f32x16& p1, const char* K_lds, int r32, int hi, const bf16x8* qr) {
    p0 = f32x16{}; p1 = f32x16{};
    const char* kb[4];
#pragma unroll
    for (int dd = 0; dd < 4; ++dd) kb[dd] = K_lds + KB * SHM_K + KSWZ(r32, (dd * 16 + hi * 8) * 2);
#pragma unroll
    for (int d0 = 0; d0 < 8; ++d0) { const char* a = kb[d0 & 3] + (d0 >> 2) * 128;
        bf16x8 b0 = *reinterpret_cast<const bf16x8*>(a);
        bf16x8 b1 = *reinterpret_cast<const bf16x8*>(a + 32 * 256);
        p0 = __builtin_amdgcn_mfma_f32_32x32x16_bf16(b0, qr[d0], p0, 0, 0, 0);
        p1 = __builtin_amdgcn_mfma_f32_32x32x16_bf16(b1, qr[d0], p1, 0, 0, 0); }
}
template <int VB>
__device__ __forceinline__ void pv_tile(f32x16* o, int vb0, bf16x8 pa0, bf16x8 pa1, bf16x8 pa2, bf16x8 pa3) {
#define TRRD(dst, off) asm volatile("ds_read_b64_tr_b16 %0, %1 offset:%2" : "=&v"(dst) : "v"(vb0), "i"(off) : "memory")
#define PV_D0(d0) do { s16x4 l0, l1, l2, l3, h0, h1, h2, h3; constexpr int b_ = VB * SHM_V + v_rd_off(d0, 0, 0); \
        TRRD(l0, b_); TRRD(h0, b_ + 2048); TRRD(l1, b_ + 4096); TRRD(h1, b_ + 6144); TRRD(l2, b_ + 8192); TRRD(h2, b_ + 10240); TRRD(l3, b_ + 12288); TRRD(h3, b_ + 14336); \
        asm volatile("s_waitcnt lgkmcnt(0)" ::: "memory"); SBAR();   \
        o[d0] = __builtin_amdgcn_mfma_f32_32x32x16_bf16(pa0, (bf16x8){l0[0], l0[1], l0[2], l0[3], h0[0], h0[1], h0[2], h0[3]}, o[d0], 0, 0, 0);   \
        o[d0] = __builtin_amdgcn_mfma_f32_32x32x16_bf16(pa1, (bf16x8){l1[0], l1[1], l1[2], l1[3], h1[0], h1[1], h1[2], h1[3]}, o[d0], 0, 0, 0);   \
        o[d0] = __builtin_amdgcn_mfma_f32_32x32x16_bf16(pa2, (bf16x8){l2[0], l2[1], l2[2], l2[3], h2[0], h2[1], h2[2], h2[3]}, o[d0], 0, 0, 0);   \
        o[d0] = __builtin_amdgcn_mfma_f32_32x32x16_bf16(pa3, (bf16x8){l3[0], l3[1], l3[2], l3[3], h3[0], h3[1], h3[2], h3[3]}, o[d0], 0, 0, 0); } while (0)
    PV_D0(0); PV_D0(1); PV_D0(2); PV_D0(3);
#undef PV_D0
#undef TRRD
}
struct BlockRef { const bf16* Q; const bf16* K; const bf16* V; bf16* O; const bf16* GA; const float* KBAR; int qblk; };
struct Seam { bf16x8 qr[8]; bf16x8 st_v0, st_v1, st_k0, st_k1; };
#define ROW(p, k0, rr) ((p) + (size_t)((k0) + (rr)) * ZP + sc)
#define VMW() asm volatile("s_waitcnt vmcnt(0)" ::: "memory")
#define VMWN(n) asm volatile("s_waitcnt vmcnt(%0)" :: "i"(n) : "memory")
#define SLOAD_H(Kp, Vp, k0) do { S.st_v0 = load8(ROW(Vp, k0, sr)); S.st_v1 = load8(ROW(Vp, k0, 32 + sr));              \
                         S.st_k0 = load8(ROW(Kp, k0, sr)); S.st_k1 = load8(ROW(Kp, k0, 32 + sr)); } while (0)
#define SWRITE_HK(bf) do { *(bf16x8*)(K_lds + (bf) * SHM_K + kws) = S.st_k0; *(bf16x8*)(K_lds + (bf) * SHM_K + kws + 32 * 256) = S.st_k1; } while (0)
#define SWRITE_HV(bf) do { *(bf16x8*)(V_lds + (bf) * SHM_V + vst0) = S.st_v0; *(bf16x8*)(V_lds + (bf) * SHM_V + vst1) = S.st_v1; } while (0)
#define SWRITE_H(bf) do { SWRITE_HV(bf); SWRITE_HK(bf); } while (0)
__device__ __forceinline__ void prime(const BlockRef& cur, char* lds, Seam& S) {
    const int tid = threadIdx.x, wid = __builtin_amdgcn_readfirstlane(tid >> 6), lane = tid & 63, r32 = lane & 31, hi = lane >> 5;
    const int sr = tid >> 4, sc = (tid & 15) * 8, kws = KSWZ(sr, sc * 2); char* K_lds = lds + 2 * SHM_V;
    for (int d0 = 0; d0 < 8; ++d0) S.qr[d0] = load8(cur.Q + (size_t)(wid * QBLK + r32) * ZP + d0 * 16 + hi * 8);
    SLOAD_H(cur.K, cur.V, 0); VMW(); SWRITE_HK(0);
    __syncthreads();
}
__device__ __forceinline__ unsigned select_blocks(const BlockRef& cur, const bf16x8* qr, int r32, int hi) {
    const int qblk = cur.qblk;
    f32x16 g = {};
#pragma unroll
    for (int d0 = 0; d0 < 8; ++d0) {
        bf16x8 a = {0, 0, 0, 0, 0, 0, 0, 0};
        if (r32 < 8) { const float* kp = cur.KBAR + (size_t)r32 * 512 + d0 * 16 + hi * 8; const f32x4 x = *(const f32x4*)kp, y = *(const f32x4*)(kp + 4);
            u32x4 w = {cvtpk(x[0], x[1]), cvtpk(x[2], x[3]), cvtpk(y[0], y[1]), cvtpk(y[2], y[3])}; a = *reinterpret_cast<bf16x8*>(&w); }
        g = __builtin_amdgcn_mfma_f32_32x32x16_bf16(a, qr[d0], g, 0, 0, 0);
    }
    float gv[8];
#pragma unroll
    for (int r = 0; r < 4; ++r) { auto rr = __builtin_amdgcn_permlane32_swap(__float_as_uint(g[r]), __float_as_uint(g[r]), false, false);
        gv[r] = __uint_as_float(rr[0]); gv[4 + r] = __uint_as_float(rr[1]); }
    const float NEG = -__builtin_inff();
#pragma unroll
    for (int n = 0; n < 8; ++n) if (n >= qblk) gv[n] = NEG;
    unsigned bits = 1u << qblk;
#pragma unroll
    for (int k = 0; k < 3; ++k) { int best = -1; float bv = NEG;
#pragma unroll
        for (int n = 0; n < 8; ++n) if (gv[n] > bv) { bv = gv[n]; best = n; }
#pragma unroll
        for (int n = 0; n < 8; ++n) if (n == best) gv[n] = NEG;
        if (best >= 0) bits |= 1u << best; }
    return bits;
}
__device__ __forceinline__ void block(const BlockRef& cur, const BlockRef& nxt, char* lds, Seam& S) {
    const int tid = threadIdx.x, wid = __builtin_amdgcn_readfirstlane(tid >> 6), lane = tid & 63, r32 = lane & 31, hi = lane >> 5;
    const int P0 = cur.qblk * QB;
    const int NT = 4 * cur.qblk + 4;
    const int qlo = P0 + wid * QBLK, qm = qlo + r32 - 4 * hi;
    char* V_lds = lds; char* K_lds = lds + 2 * SHM_V;
    float* ws = (float*)(lds + 2 * SHM_V + 2 * SHM_K) + wid * 64; float* li_l = ws, * al_l = ws + 32;
    float m_reg = -1e30f, l_reg = 0; f32x16 o[4] = {};
    const int sr = tid >> 4, sc = (tid & 15) * 8, vst0 = v_st(sr, sc), vst1 = v_st(32 + sr, sc), kws = KSWZ(sr, sc * 2);
    const int vb0 = (int)(uintptr_t)V_lds + v_rd_base(lane);
    const bf16* Kh = cur.K; const bf16* Vh = cur.V;
    const unsigned selbits = select_blocks(cur, S.qr, r32, hi);
#define RESC(a) do { if (__any((a) < 1.f)) { if (hi == 0) al_l[r32] = (a); asm volatile("s_waitcnt lgkmcnt(0)" ::: "memory");              \
                     for (int d_ = 0; d_ < 4; ++d_) for (int r = 0; r < 16; ++r) o[d_][r] *= al_l[crow(r, hi)]; } } while (0)
#define KBASE(t) ((t) * KVBLK)
#define SEL(t) (((selbits >> ((t) >> 2)) & 1u) != 0u)
#define MASKT(P0_, P1_, t) do { const int kb_ = KBASE(t); if (kb_ + KVBLK - 1 > qlo) mask_tile(P0_, P1_, qm - kb_); } while (0)
    constexpr int NQL = 8;
#define SEAM_K0() do { VMWN(NQL); SWRITE_HK(0); SBAR(); } while (0)
    f32x16 pA0, pA1, pB0, pB1; float mnA, mnB, alA, alB; bf16x8 pa0, pa1, pa2, pa3;
    SWRITE_HV(0); SBAR();
    if (NT > 1) { SLOAD_H(Kh, Vh, KBASE(1)); }
    SBAR(); qkt<0>(pA0, pA1, K_lds, r32, hi, S.qr);
    MASKT(pA0, pA1, 0); partialSM(pA0, pA1, m_reg, mnA, alA, SEL(0));
    if (NT > 1) { VMW(); SWRITE_H(1); }
    __syncthreads();
#define HALF_STEP(PX0, PX1, mnX, alX, PY0, PY1, alY, t, KB, VB, SB) do {                                                      \
        SBAR(); qkt<KB>(PX0, PX1, K_lds, r32, hi, S.qr);                                             \
        finishSM(PY0, PY1, alY, l_reg, pa0, pa1, pa2, pa3); SBAR();                                                           \
        if ((t) + 1 < NT) { SLOAD_H(Kh, Vh, KBASE((t) + 1)); SBAR(); }                                               \
        pv_tile<VB>(o, vb0, pa0, pa1, pa2, pa3); MASKT(PX0, PX1, (t)); partialSM(PX0, PX1, m_reg, mnX, alX, SEL(t));                                        \
        __syncthreads();                                                                                                      \
        if ((t) + 1 < NT) { VMW(); SWRITE_H(SB); }                                                                          \
        RESC(alX); __syncthreads(); } while (0)
    for (int t = 1; t + 1 < NT; t += 2) {
        HALF_STEP(pB0, pB1, mnB, alB, pA0, pA1, alA, t, 1, 0, 0);
        HALF_STEP(pA0, pA1, mnA, alA, pB0, pB1, alB, t + 1, 0, 1, 1);
    }
    { SBAR(); qkt<1>(pB0, pB1, K_lds, r32, hi, S.qr); SBAR(); }
    SLOAD_H(nxt.K, nxt.V, 0); SBAR();
#pragma unroll
    for (int d0 = 0; d0 < 8; ++d0) S.qr[d0] = load8(nxt.Q + (size_t)(wid * QBLK + r32) * ZP + d0 * 16 + hi * 8);
    SBAR();
    finishSM(pA0, pA1, alA, l_reg, pa0, pa1, pa2, pa3); SBAR();
    pv_tile<0>(o, vb0, pa0, pa1, pa2, pa3);
    { MASKT(pB0, pB1, NT - 1); partialSM(pB0, pB1, m_reg, mnB, alB, SEL(NT - 1)); __syncthreads(); RESC(alB);
      finishSM(pB0, pB1, alB, l_reg, pa0, pa1, pa2, pa3); SBAR(); pv_tile<1>(o, vb0, pa0, pa1, pa2, pa3); }
    SBAR(); SEAM_K0();
    if (hi == 0) li_l[r32] = l_reg; asm volatile("s_waitcnt lgkmcnt(0)" ::: "memory");
    float rli[16];
#pragma unroll
    for (int r = 0; r < 16; ++r) rli[r] = __builtin_amdgcn_rcpf(li_l[crow(r, hi)]);
    int hi2 = hi, r2 = r32; asm volatile("" : "+v"(hi2), "+v"(r2));
    bf16* Ow = cur.O + (size_t)(wid * QBLK + 4 * hi2) * OP + r2; const bf16* Gw = cur.GA + (size_t)(wid * QBLK + 4 * hi2) * ZP + r2;
#pragma unroll
    for (int r = 0; r < 16; ++r) { const int orow = (r & 3) + 8 * (r >> 2);
#pragma unroll
        for (int d0 = 0; d0 < 4; ++d0) { const float gat = __builtin_bit_cast(float, (unsigned)Gw[(size_t)orow * ZP + d0 * 32] << 16);
            const float v = o[d0][r] * rli[r] * (gat / (1.0f + __expf(-gat)));
            const float vn = __shfl_xor(v, 1);
            if ((r2 & 1) == 0) *(unsigned*)(Ow + (size_t)orow * OP + d0 * 32) = cvtpk(v, vn); } }
    __syncthreads();
#undef RESC
#undef KBASE
#undef SEL
#undef MASKT
#undef SEAM_K0
#undef HALF_STEP
}
#undef ROW
#undef VMW
#undef VMWN
#undef SLOAD_H
#undef SWRITE_HK
#undef SWRITE_HV
#undef SWRITE_H
#undef KSWZ
#undef SBAR
}

__device__ __forceinline__ swa::BlockRef attn_ref(unsigned char* ws, bf16* Obase, int bh, int qblk) {
    const int b = bh >> 2, h = bh & 3; const bf16* Z = (const bf16*)(ws + WS_Z);
    swa::BlockRef r; const size_t row0 = (size_t)b * SEQ + (size_t)qblk * 256;
    r.Q = Z + row0 * EVEN_IN + h * 128; r.K = Z + (size_t)b * SEQ * EVEN_IN + 512 + h * 128; r.V = Z + (size_t)b * SEQ * EVEN_IN + 1024 + h * 128;
    r.GA = Z + row0 * EVEN_IN + 1536 + h * 128; r.O = Obase + row0 * DM + h * 128;
    r.KBAR = (const float*)(ws + WS_KBAR) + (size_t)b * 8 * 512 + h * 128; r.qblk = qblk; return r;
}
__device__ __forceinline__ void ph_attn(Frame& F, bf16* Obase) {
    char* lds = (char*)F.lds + RING_OFF;
    const int total = BATCH * 4 * 4;
    int L = F.vcu; if (L >= total) return;
    int pass = 0;
    swa::BlockRef cur = attn_ref(F.ws, Obase, L >> 2, L & 3);
    swa::Seam S;
    swa::prime(cur, lds, S);
    for (;;) {
        const bool more_pass = pass == 0, more_item = L + F.G < total, last = !more_pass && !more_item;
        int passn = pass + 1, Ln = L;
        if (!more_pass) { passn = 0; Ln = more_item ? L + F.G : L; }
        const int sn = Ln & 3;
        const swa::BlockRef nxt = last ? cur : attn_ref(F.ws, Obase, Ln >> 2, passn ? 7 - sn : sn);
        swa::block(cur, nxt, lds, S);
        if (last) break;
        cur = nxt; pass = passn; L = Ln;
    }
}
#ifdef PROBE_ATTN
__device__ __forceinline__ void ph_probe_cmp(Frame& F, const bf16* A, const bf16* B, unsigned* word) {
    const int gt = F.gw * 64 + F.lane, NGT = F.NGW * 64; float sm = 0.f;
    for (int i = gt; i < M * 512; i += NGT) { const int row = i >> 9, c = i & 511; float d = fabsf(bf2f(A[(size_t)row * DM + c]) - bf2f(B[(size_t)row * DM + c])); if (!(d == d)) d = 1000.f; sm += d; }
    sm = wave_sum(sm);
    if (F.lane == 0) atomicAdd((float*)word, sm * (1.0f / (float)(M * 512)));
}
#endif
struct Args { const float* in[23]; float* out; unsigned char* ws; int ph_lo, ph_hi; };
__global__ void __launch_bounds__(NWAVES * 64, 2) fwd_kernel(Args args) {
    extern __shared__ __attribute__((aligned(16))) unsigned char lds[];
    Frame F;
    F.lds = (LAS unsigned char*)lds;
    volatile LAS unsigned* MISC = (volatile LAS unsigned*)(F.lds + MISC_OFF);
    F.tid = threadIdx.x; F.lane = F.tid & 63; F.wave = __builtin_amdgcn_readfirstlane(F.tid >> 6);
    F.G = gridDim.x; { const int bx = blockIdx.x; F.vcu = (F.G % 8 == 0) ? (bx % 8) * (F.G / 8) + bx / 8 : bx; }
    F.gw = blockIdx.x * NWAVES + F.wave; F.NGW = F.G * NWAVES;
#pragma unroll
    for (int i = 0; i < 23; ++i) F.in[i] = args.in[i];
    F.out = args.out; F.ws = args.ws;
    unsigned* ctl = (unsigned*)(args.ws + WS_CTL);
    for (int u = F.tid; u < (LDS_BYTES - LDSCTL_OFF) / 4; u += NWAVES * 64) ((LAS unsigned*)(F.lds + LDSCTL_OFF))[u] = 0u;
    __syncthreads();
    XcdBarrier bar; bar.bar = ctl + CW_BAR; bar.x = 0; bar.st = nullptr;
    if (N_LAUNCHES == 1) bar = xcd_barrier_post(ctl + CW_BAR, MISC + 8);
#define GRID_BAR() do { if (N_LAUNCHES == 1) xcd_barrier(bar); } while (0)
    const int lo = args.ph_lo, hi = args.ph_hi;
#define IN(k) (lo <= (k) && (k) < hi)
#define BOTH(k) (IN(k) && IN((k) + 1))
    unsigned char* ws = args.ws;
    bf16* XN = (bf16*)(ws + WS_XN); bf16* Z = (bf16*)(ws + WS_Z); bf16* MB = (bf16*)(ws + WS_MB); bf16* Y = (bf16*)(ws + WS_Y); bf16* T1 = (bf16*)(ws + WS_T1); bf16* T2 = (bf16*)(ws + WS_T2);
    typedef pg8::EpiBf16<0> EpiP;
#define GEMM_PLAIN(Aptr, Wptr, Nn, Kk, Optr, ldc_) do { pg8::Gemm g{(const pg8::bf16_t*)(Aptr), (const pg8::bf16_t*)(Wptr), M, (Nn), (Kk)}; pg8::StaticOrder S; S.init(M, (Nn), F.G, (int)blockIdx.x); \
        EpiP E{(pg8::bf16_t*)(Optr), (ldc_), nullptr, 0, 0, 1.f}; pg8::gemm_phase<EpiP, pg8::StaticOrder, true, true>(F.lds + RING_OFF, g, S, E); } while (0)

    if (IN(0)) { ph_prologue(F); if (BOTH(0)) GRID_BAR(); }
    if (IN(1)) { GEMM_PLAIN(XN, ws + WS_WIN0, EVEN_IN, 1024, Z, EVEN_IN); if (BOTH(1)) GRID_BAR(); }
    if (IN(2)) { ph_rope(F); if (BOTH(2)) GRID_BAR(); }
    if (IN(3)) { ph_kbar(F); if (BOTH(3)) GRID_BAR(); }
    #ifdef PROBE_ATTN
    if (IN(4)) { ph_attn_naive(F); __syncthreads(); ph_attn(F, Y); ph_pool_naive(F); GRID_BAR(); ph_probe_cmp(F, MB, Y, ctl + 64); if (BOTH(4)) GRID_BAR(); }
#else
    if (IN(4)) { ph_attn(F, MB); ph_pool_naive(F); if (BOTH(4)) GRID_BAR(); }
#endif
    if (IN(5)) { GEMM_PLAIN(T1, ws + WS_WPOOL, 512, 512, T2, 512); if (BOTH(5)) GRID_BAR(); }
    if (IN(6)) { ph_pool_gate(F); if (BOTH(6)) GRID_BAR(); }
    if (IN(7)) { GEMM_PLAIN(MB, ws + WS_WOUT0, 1024, 1024, Y, 1024); if (BOTH(7)) GRID_BAR(); }
    if (IN(8)) { ph_norm_res(F, F.in[0], Y, F.in[2], F.out, XN); if (BOTH(8)) GRID_BAR(); }
    if (IN(9)) { GEMM_PLAIN(XN, ws + WS_WIN1, ODD_IN, 1024, Z, ODD_IN); if (BOTH(9)) GRID_BAR(); }
    if (IN(10)) { ph_s5_naive(F); ph_conv_naive(F); if (BOTH(10)) GRID_BAR(); }
    if (IN(11)) { GEMM_PLAIN(T1, ws + WS_WGLU, 1024, 512, Y, 1024); if (BOTH(11)) GRID_BAR(); }
    if (IN(12)) { ph_glu_gate(F); if (BOTH(12)) GRID_BAR(); }
    if (IN(13)) { GEMM_PLAIN(T2, ws + WS_WPW, 512, 512, Y, 512); if (BOTH(13)) GRID_BAR(); }
    if (IN(14)) { ph_conv_gate(F); if (BOTH(14)) GRID_BAR(); }
    if (IN(15)) { GEMM_PLAIN(MB, ws + WS_WOUT1, 1024, 1024, Y, 1024); if (BOTH(15)) GRID_BAR(); }
    if (IN(16)) { ph_norm_res(F, F.out, Y, F.in[2] + 1024, F.out, nullptr); }
#ifdef PROBE_ATTN
    GRID_BAR();
    if (blockIdx.x == 0 && F.tid == 0) { const float mxd = __builtin_bit_cast(float, __hip_atomic_load(ctl + 64, __ATOMIC_RELAXED, __HIP_MEMORY_SCOPE_AGENT)); F.out[0] = 100.f + 1.0e9f * mxd; }
#endif
#undef IN
#undef BOTH
}

extern "C" void kernel_launch(void* const* d_in, const int* in_sizes, int n_in, void* d_out, int out_size, void* d_ws, size_t ws_size, hipStream_t stream) {
    static int grid = 0;
    if (grid == 0) {
        if (n_in != 23 || in_sizes[0] != M * DM || out_size != M * DM || ws_size < WS_END) { fprintf(stderr, "kernel_launch: unexpected shapes n_in %d in0 %d out %d ws %zu\n", n_in, n_in > 0 ? in_sizes[0] : -1, out_size, ws_size); grid = -1; return; }
        int dev = 0, cus = 0, per_cu = 0;
        if (hipGetDevice(&dev) != hipSuccess || hipDeviceGetAttribute(&cus, hipDeviceAttributeMultiprocessorCount, dev) != hipSuccess) { grid = -1; return; }
        if (hipFuncSetAttribute((const void*)fwd_kernel, hipFuncAttributeMaxDynamicSharedMemorySize, LDS_BYTES) != hipSuccess) { fprintf(stderr, "kernel_launch: hipFuncSetAttribute failed\n"); grid = -1; return; }
        if (hipOccupancyMaxActiveBlocksPerMultiprocessor(&per_cu, (const void*)fwd_kernel, NWAVES * 64, LDS_BYTES) != hipSuccess || per_cu < 1) fprintf(stderr, "kernel_launch: occupancy query reports %d\n", per_cu);
        (void)hipGetLastError();
        grid = cus;
    }
    if (grid < 0) return;
    (void)hipMemsetAsync((char*)d_ws + WS_CTL, 0, CTL_ZERO_BYTES, stream);
    Args a{};
    for (int i = 0; i < 23; ++i) a.in[i] = (const float*)d_in[i];
    a.out = (float*)d_out; a.ws = (unsigned char*)d_ws;
    if (N_LAUNCHES == 1) { a.ph_lo = 0; a.ph_hi = N_PHASES; hipLaunchKernelGGL(fwd_kernel, dim3(grid), dim3(NWAVES * 64), LDS_BYTES, stream, a); }
    else for (int p = 0; p < N_PHASES; ++p) { a.ph_lo = p; a.ph_hi = p + 1; hipLaunchKernelGGL(fwd_kernel, dim3(grid), dim3(NWAVES * 64), LDS_BYTES, stream, a); }
}
```

```cpp
#include <hip/hip_runtime.h>
#include <cstdio>
#include <cstdint>
#include <cmath>
#define MK_N_LAUNCHES 1
namespace pg8 {
#define PG8_LAS __attribute__((address_space(3)))
typedef unsigned short bf16_t;
typedef short bf16x8 __attribute__((ext_vector_type(8)));
typedef float f32x4 __attribute__((ext_vector_type(4)));
typedef unsigned u32x4 __attribute__((ext_vector_type(4)));
constexpr int BM = 256, BK = 64, HALF = 128, HTB = HALF * BK * 2  , STAGE_BYTES = 8 * HTB, NXCD = 8, WGM = 8;

__host__ __device__ __forceinline__ int lds_byte(int r, int c) { const int st = (r >> 4) * 2 + (c >> 5), rr = r & 15, cc = c & 31, ob = rr * 64 + cc * 2; return st * 1024 + (ob ^ (((ob >> 9) & 1) << 5)); }
__host__ __device__ __forceinline__ void stage_rc(int b, int& R, int& C) { const int st = b / 1024, sb = b % 1024, swz = sb ^ (((sb >> 9) & 1) << 5); R = (st >> 1) * 16 + swz / 64; C = (st & 1) * 32 + (swz % 64) / 2; }
__host__ __device__ __forceinline__ int perm32(int rho) { const int n = rho >> 4, i = rho & 15; return 8 * (i >> 2) + 4 * n + (i & 3); }

struct Unit { int pm, pn; };
struct Gemm { const bf16_t* A; const bf16_t* Bt; int M, N, K; };

struct StaticOrder {
    int nM, nN, nwg, G, c;
    __host__ __device__ void init(int M, int N, int G_, int c_) { nM = M / BM; nN = N / BM; nwg = nM * nN; G = G_; c = c_; }
    __host__ __device__ bool next(int i, Unit& u) const {
        const long L = (long)i * G + c; if (L >= nwg) return false;
        int wgid = (int)L; { const int q = nwg / NXCD, r = nwg % NXCD, xcd = wgid % NXCD, off = wgid / NXCD; wgid = (xcd < r ? xcd * (q + 1) : r * (q + 1) + (xcd - r) * q) + off; }
        const int nig = WGM * nN, gid = wgid / nig, fm = gid * WGM, gsz = (nM - fm) < WGM ? (nM - fm) : WGM;
        u.pm = fm + ((wgid % nig) % gsz); u.pn = (wgid % nig) / gsz; return true;
    }
    __device__ __forceinline__ void a_ready(const Unit&) const {}
    __device__ __forceinline__ void done(const Unit&) const {}
};

__device__ __forceinline__ unsigned cvt_pk_bf16(float lo, float hi) { unsigned r; asm volatile("v_cvt_pk_bf16_f32 %0, %1, %2" : "=v"(r) : "v"(lo), "v"(hi)); return r; }
typedef float f32x2 __attribute__((ext_vector_type(2)));
__device__ __forceinline__ f32x2 gelu_pk(f32x2 v) {
    const f32x2 av = __builtin_elementwise_abs(v), d = av * 0.2316418882f + 1.0f;
    f32x2 t; t.x = __builtin_amdgcn_rcpf(d.x); t.y = __builtin_amdgcn_rcpf(d.y);
    f32x2 q = t * 0.5307027145f + (-0.7265760135f); q = q * t + 0.7107068705f; q = q * t + (-0.142248368f); q = q * t + 0.127414796f; q = q * t;
    const f32x2 s = (v * v) * (-0.72134752044f);
    f32x2 e; e.x = __builtin_amdgcn_exp2f(s.x); e.y = __builtin_amdgcn_exp2f(s.y);
    const f32x2 m = v * (q * e), r = v - m;
    f32x2 o; o.x = v.x < 0.f ? m.x : r.x; o.y = v.y < 0.f ? m.y : r.y; return o;
}

template <int ACT  > struct EpiBf16 {
    static constexpr bool PERM = true, AFTER_DRAIN = false; static_assert(ACT == 0 || ACT == 1, "EpiBf16: ACT is 0 (none) or 1 (gelu_pk)");
    bf16_t* O; int ldc; const float* bias; int split_cols; size_t split_stride; float scale0;
    __device__ __forceinline__ void operator()(const f32x4 (&acc)[2][2][4][2], const Unit& u, int wr, int wc, int fr, int fq) const {
        const int row0 = u.pm * BM + wr * 64 + fr; int colt = u.pn * BM; bf16_t* base = O;
        float sc = 1.f; if (split_cols) { const int t = colt / split_cols; base += (size_t)t * split_stride; colt -= t * split_cols; if (t == 0) sc = scale0; }
        const int col0 = colt + wc * 32 + 8 * fq, bcol0 = u.pn * BM + wc * 32 + 8 * fq;
        f32x4 bv[2][2];
#pragma unroll
        for (int bj = 0; bj < 2; ++bj)
#pragma unroll
            for (int n = 0; n < 2; ++n) bv[bj][n] = bias ? *(const f32x4*)(bias + bcol0 + bj * HALF + 4 * n) : (f32x4){0.f, 0.f, 0.f, 0.f};
#pragma unroll
        for (int ai = 0; ai < 2; ++ai)
#pragma unroll
            for (int m = 0; m < 4; ++m) { bf16_t* rowp = base + (size_t)(row0 + ai * HALF + m * 16) * ldc + col0;
#pragma unroll
                for (int bj = 0; bj < 2; ++bj) { f32x4 v0 = acc[ai][bj][m][0] + bv[bj][0], v1 = acc[ai][bj][m][1] + bv[bj][1];
                    if (ACT == 1) { f32x2 a = gelu_pk((f32x2){v0[0], v0[1]}), b = gelu_pk((f32x2){v0[2], v0[3]}), c = gelu_pk((f32x2){v1[0], v1[1]}), d = gelu_pk((f32x2){v1[2], v1[3]});
                        v0 = (f32x4){a.x, a.y, b.x, b.y}; v1 = (f32x4){c.x, c.y, d.x, d.y}; }
                    v0 = v0 * sc; v1 = v1 * sc; u32x4 w; w.x = cvt_pk_bf16(v0[0], v0[1]); w.y = cvt_pk_bf16(v0[2], v0[3]); w.z = cvt_pk_bf16(v1[0], v1[1]); w.w = cvt_pk_bf16(v1[2], v1[3]);
                    *(u32x4*)(rowp + bj * HALF) = w; } }
    }
};

struct PanelStats {
    unsigned* xbuf;
    unsigned* cnt;
    unsigned* tmo;
    int ntn; float eps;
    unsigned code;
    __device__ __forceinline__ bool run(const f32x4 (&v)[2][2][4][2], const Unit& u, int wr, int wc, int fr, int fq, PG8_LAS unsigned char* lds, int wid, int lane) const {
        typedef float f32x2v __attribute__((ext_vector_type(2)));
        PG8_LAS f32x2v* P = (PG8_LAS f32x2v*)lds;
        PG8_LAS f32x2v* S = (PG8_LAS f32x2v*)(lds + 8192);
        PG8_LAS unsigned* flag = (PG8_LAS unsigned*)(lds + 8192 + 2048);
#pragma unroll
        for (int ai = 0; ai < 2; ++ai)
#pragma unroll
            for (int m = 0; m < 4; ++m) {
                float s = 0.f;
#pragma unroll
                for (int bj = 0; bj < 2; ++bj)
#pragma unroll
                    for (int n = 0; n < 2; ++n) { const f32x4 x = v[ai][bj][m][n]; s += (x[0] + x[1]) + (x[2] + x[3]); }
                s += __shfl_xor(s, 16); s += __shfl_xor(s, 32);
                const float mw = s * (1.0f / 64.0f); float q = 0.f;
#pragma unroll
                for (int bj = 0; bj < 2; ++bj)
#pragma unroll
                    for (int n = 0; n < 2; ++n) { const f32x4 d = v[ai][bj][m][n] - mw; q += (d[0] * d[0] + d[1] * d[1]) + (d[2] * d[2] + d[3] * d[3]); }
                q += __shfl_xor(q, 16); q += __shfl_xor(q, 32);
                if (fq == 0) P[(ai * HALF + wr * 64 + m * 16 + fr) * 4 + wc] = (f32x2v){mw, q};
            }
        asm volatile("s_waitcnt lgkmcnt(0)" ::: "memory"); __builtin_amdgcn_s_barrier(); asm volatile("" ::: "memory");
#if defined(BROKEN_EXCHANGE_NO_WAIT)
#warning BROKEN CONTROL BUILD: the row-statistics exchange does not wait; results are wrong by design
        if (blockIdx.x >= 64) { const long long t0_ = clock64(); while (clock64() - t0_ < 60000) __builtin_amdgcn_s_sleep(8); }
#endif
        const int row = wid * 32 + (lane & 31);
        if (lane < 32) {
            const f32x2v a = P[row * 4 + 0], b = P[row * 4 + 1], c = P[row * 4 + 2], d = P[row * 4 + 3];
            const float mt = (a.x + b.x + c.x + d.x) * 0.25f;
            const float da = a.x - mt, db = b.x - mt, dc = c.x - mt, dd = d.x - mt;
            const float m2 = (a.y + b.y) + (c.y + d.y) + 64.0f * ((da * da + db * db) + (dc * dc + dd * dd));
            unsigned long long* slot = (unsigned long long*)xbuf + ((size_t)(u.pm * BM + row) * 4 + u.pn);
            __hip_atomic_store(slot, ((unsigned long long)__float_as_uint(m2) << 32) | __float_as_uint(mt), __ATOMIC_RELAXED, __HIP_MEMORY_SCOPE_AGENT);
        }
        asm volatile("s_waitcnt vmcnt(0)" ::: "memory");
        if (lane == 0) __hip_atomic_fetch_add(cnt + 64 * u.pm, 1u, __ATOMIC_RELAXED, __HIP_MEMORY_SCOPE_AGENT);
        if (wid == 0) {
            bool dead = false; const unsigned long long t0 = __builtin_amdgcn_s_memrealtime(); const unsigned want = 8u * (unsigned)ntn;
            for (;;) {
#if defined(BROKEN_EXCHANGE_NO_WAIT)
                break;
#endif
                if ((unsigned)__builtin_amdgcn_readfirstlane(__hip_atomic_load(cnt + 64 * u.pm, __ATOMIC_RELAXED, __HIP_MEMORY_SCOPE_AGENT)) >= want) break;
                if (__builtin_amdgcn_s_memrealtime() - t0 > 2000000ull) {
                    if (lane == 0) { unsigned expect = 0u; __hip_atomic_compare_exchange_strong(tmo + 1, &expect, code | (unsigned)(u.pm & 0xff), __ATOMIC_RELAXED, __ATOMIC_RELAXED, __HIP_MEMORY_SCOPE_AGENT);
                                     __hip_atomic_store(tmo, 1u, __ATOMIC_RELAXED, __HIP_MEMORY_SCOPE_AGENT); }
                    dead = true; break; }
                __builtin_amdgcn_s_sleep(2);
            }
            __builtin_amdgcn_fence(__ATOMIC_ACQUIRE, "agent");
            if (lane == 0) flag[0] = dead ? 1u : 0u;
        }
        asm volatile("s_waitcnt vmcnt(0) lgkmcnt(0)" ::: "memory"); __builtin_amdgcn_s_barrier(); asm volatile("" ::: "memory");
        const bool bad = flag[0] != 0u;
        if (lane < 32) {
            const unsigned long long* slot = (const unsigned long long*)xbuf + (size_t)(u.pm * BM + row) * 4; float mt[4], m2[4]; float ms = 0.f;
#pragma unroll
            for (int t = 0; t < 4; ++t) { if (t < ntn) { const unsigned long long w = __hip_atomic_load(slot + t, __ATOMIC_RELAXED, __HIP_MEMORY_SCOPE_AGENT); mt[t] = __uint_as_float((unsigned)w); m2[t] = __uint_as_float((unsigned)(w >> 32)); } else { mt[t] = 0.f; m2[t] = 0.f; } ms += mt[t]; }
            const float mean = ms / (float)ntn; float q = 0.f;
#pragma unroll
            for (int t = 0; t < 4; ++t) if (t < ntn) { const float dm = mt[t] - mean; q += m2[t] + 256.0f * dm * dm; }
            S[row] = (f32x2v){mean, 1.0f / sqrtf(q / (256.0f * (float)ntn) + eps)};
        }
        asm volatile("s_waitcnt lgkmcnt(0)" ::: "memory"); __builtin_amdgcn_s_barrier(); asm volatile("" ::: "memory");
        return bad;
    }
};
struct EpiLnRes {
    static constexpr bool PERM = false, AFTER_DRAIN = true;
    const float* base; float* out; int ldc; const float* bias; PanelStats st; unsigned poison;
    __device__ __forceinline__ void fused(f32x4 (&acc)[2][2][4][2], const Unit& u, int wr, int wc, int fr, int fq, PG8_LAS unsigned char* lds, int wid, int lane) const {
        typedef float f32x2v __attribute__((ext_vector_type(2)));
        const PG8_LAS f32x2v* S = (const PG8_LAS f32x2v*)(lds + 8192);
        const int col0 = u.pn * BM + wc * 32 + 4 * fq;
#pragma unroll
        for (int bj = 0; bj < 2; ++bj)
#pragma unroll
            for (int n = 0; n < 2; ++n) { const f32x4 bv = bias ? *(const f32x4*)(bias + col0 + bj * HALF + n * 16) : (f32x4){0.f, 0.f, 0.f, 0.f};
#pragma unroll
                for (int ai = 0; ai < 2; ++ai)
#pragma unroll
                    for (int m = 0; m < 4; ++m) acc[ai][bj][m][n] += bv; }
        f32x4 pre[4][2][2];
#pragma unroll
        for (int m = 0; m < 4; ++m) { const size_t off = (size_t)(u.pm * BM + wr * 64 + m * 16 + fr) * ldc + col0;
#pragma unroll
            for (int bj = 0; bj < 2; ++bj)
#pragma unroll
                for (int n = 0; n < 2; ++n) pre[m][bj][n] = *(const f32x4*)(base + off + bj * HALF + n * 16); }
        const bool bad = st.run(acc, u, wr, wc, fr, fq, lds, wid, lane) || poison != 0u;
        const float qnan = __builtin_nanf("");
#pragma unroll
        for (int ai = 0; ai < 2; ++ai)
#pragma unroll
            for (int m = 0; m < 4; ++m) { const int r = ai * HALF + wr * 64 + m * 16 + fr; const f32x2v sr = S[r]; const size_t off = (size_t)(u.pm * BM + r) * ldc + col0;
#pragma unroll
                for (int bj = 0; bj < 2; ++bj)
#pragma unroll
                    for (int n = 0; n < 2; ++n) { const f32x4 bs = ai == 0 ? pre[m][bj][n] : *(const f32x4*)(base + off + bj * HALF + n * 16); f32x4 o = bs + (acc[ai][bj][m][n] - sr.x) * sr.y;
                        if (bad) o = (f32x4){qnan, qnan, qnan, qnan}; *(f32x4*)(out + off + bj * HALF + n * 16) = o; }
                if (m & 1) asm volatile("" ::: "memory"); }
    }
};
struct EpiLnResLn {
    static constexpr bool PERM = false, AFTER_DRAIN = true;
    const float* base; float* out; bf16_t* xn; int ldc; const float* bias; PanelStats st1, st2; unsigned poison;
    __device__ __forceinline__ void fused(f32x4 (&acc)[2][2][4][2], const Unit& u, int wr, int wc, int fr, int fq, PG8_LAS unsigned char* lds, int wid, int lane) const {
        typedef float f32x2v __attribute__((ext_vector_type(2))); typedef unsigned u32x2v __attribute__((ext_vector_type(2)));
        const PG8_LAS f32x2v* S = (const PG8_LAS f32x2v*)(lds + 8192);
        const int col0 = u.pn * BM + wc * 32 + 4 * fq;
#pragma unroll
        for (int bj = 0; bj < 2; ++bj)
#pragma unroll
            for (int n = 0; n < 2; ++n) { const f32x4 bv = bias ? *(const f32x4*)(bias + col0 + bj * HALF + n * 16) : (f32x4){0.f, 0.f, 0.f, 0.f};
#pragma unroll
                for (int ai = 0; ai < 2; ++ai)
#pragma unroll
                    for (int m = 0; m < 4; ++m) acc[ai][bj][m][n] += bv; }
        bool bad = st1.run(acc, u, wr, wc, fr, fq, lds, wid, lane) || poison != 0u;
        const float qnan = __builtin_nanf("");
#pragma unroll
        for (int ai = 0; ai < 2; ++ai)
#pragma unroll
            for (int m = 0; m < 4; ++m) { const int r = ai * HALF + wr * 64 + m * 16 + fr; const f32x2v sr = S[r]; const size_t off = (size_t)(u.pm * BM + r) * ldc + col0;
#pragma unroll
                for (int bj = 0; bj < 2; ++bj)
#pragma unroll
                    for (int n = 0; n < 2; ++n) { const f32x4 bs = *(const f32x4*)(base + off + bj * HALF + n * 16); acc[ai][bj][m][n] = bs + (acc[ai][bj][m][n] - sr.x) * sr.y; }
                asm volatile("" : "+v"(acc[ai][0][m][0]), "+v"(acc[ai][0][m][1]), "+v"(acc[ai][1][m][0]), "+v"(acc[ai][1][m][1]));
                if (m & 1) asm volatile("" ::: "memory"); }
        const bool bad1 = bad;
        bad = st2.run(acc, u, wr, wc, fr, fq, lds, wid, lane) || bad;
#pragma unroll
        for (int ai = 0; ai < 2; ++ai)
#pragma unroll
            for (int m = 0; m < 4; ++m) { const int r = ai * HALF + wr * 64 + m * 16 + fr; const f32x2v sr = S[r]; const size_t off = (size_t)(u.pm * BM + r) * ldc + col0;
#pragma unroll
                for (int bj = 0; bj < 2; ++bj)
#pragma unroll
                    for (int n = 0; n < 2; ++n) { const f32x4 x1 = acc[ai][bj][m][n]; *(f32x4*)(out + off + bj * HALF + n * 16) = bad1 ? (f32x4){qnan, qnan, qnan, qnan} : x1;
                        const f32x4 o = (x1 - sr.x) * sr.y; u32x2v w; w.x = cvt_pk_bf16(o[0], o[1]); w.y = cvt_pk_bf16(o[2], o[3]);
                        if (bad) { w.x = 0x7fc07fc0u; w.y = 0x7fc07fc0u; } *(u32x2v*)(xn + off + bj * HALF + n * 16) = w; }
                asm volatile("" ::: "memory"); }
    }
};

template <class Epi, class Sched, bool ALIGN_EPI = false, bool SP2 = false>
__device__ __forceinline__ void gemm_phase(PG8_LAS unsigned char* lds, const Gemm g, const Sched& S, const Epi& E) {
    const int tid = threadIdx.x, wid = __builtin_amdgcn_readfirstlane(tid >> 6), lane = tid & 63, wr = wid >> 2, wc = wid & 3, fr = lane & 15, fq = lane >> 4;
    const int K = g.K, nt = K / BK;
    unsigned voffA[2], voffB[2];
#pragma unroll
    for (int i = 0; i < 2; ++i) { int R, C; stage_rc(tid * 16 + i * 8192, R, C); const int Rb = Epi::PERM ? ((R & ~31) + perm32(R & 31)) : R;
        voffA[i] = (unsigned)(R * K + C) * 2u; voffB[i] = (unsigned)(Rb * K + C) * 2u; }
    const size_t kstep = (size_t)(BK * 2);
    const size_t hstep = (size_t)HALF * K * 2;
    const size_t tstep = 2 * hstep;
    const unsigned ldsw = (unsigned)wid * 1024u;
    const int aoff = lds_byte(wr * 64 + fr, fq * 8), boff = lds_byte(wc * 32 + fr, fq * 8);
#define PG8_SA(b, h) (((b) * 2 + (h)) * HTB)
#define PG8_SB(b, h) ((4 + (b) * 2 + (h)) * HTB)
#define PG8_STAGE(bufoff, gbase, voff) do { _Pragma("unroll") for (int _i = 0; _i < 2; ++_i) \
        __builtin_amdgcn_global_load_lds((const unsigned*)((const char*)(gbase) + (voff)[_i]), (PG8_LAS unsigned*)(lds + (bufoff) + ldsw + _i * 8192), 16, 0, 0); } while (0)
#define PG8_LDA(dst, b, h) do { _Pragma("unroll") for (int m = 0; m < 4; ++m) _Pragma("unroll") for (int k = 0; k < 2; ++k) dst[m][k] = *(const PG8_LAS bf16x8*)(lds + PG8_SA(b, h) + aoff + m * 2048 + k * 1024); } while (0)
#define PG8_LDB(dst, b, h) do { _Pragma("unroll") for (int n = 0; n < 2; ++n) _Pragma("unroll") for (int k = 0; k < 2; ++k) dst[n][k] = *(const PG8_LAS bf16x8*)(lds + PG8_SB(b, h) + boff + n * 2048 + k * 1024); } while (0)
#define PG8_MMA(ai, bj, At, Bt) do { __builtin_amdgcn_s_setprio(1); _Pragma("unroll") for (int m = 0; m < 4; ++m) _Pragma("unroll") for (int n = 0; n < 2; ++n) _Pragma("unroll") for (int k = 0; k < 2; ++k) \
        acc[ai][bj][m][n] = __builtin_amdgcn_mfma_f32_16x16x32_bf16(Bt[n][k], At[m][k], acc[ai][bj][m][n], 0, 0, 0); __builtin_amdgcn_s_setprio(0); } while (0)
#define PG8_WAIT_V(n) asm volatile("s_waitcnt vmcnt(" #n ")" ::: "memory")
#define PG8_WAIT_L(n) asm volatile("s_waitcnt lgkmcnt(" #n ")" ::: "memory")
#define PG8_BAR __builtin_amdgcn_s_barrier()
#define PG8_SCHED __builtin_amdgcn_sched_barrier(0)
    Unit cur, nxt; int ui = 0;
    if (!S.next(0, cur)) return;
    f32x4 acc[2][2][4][2];
#pragma unroll
    for (int a = 0; a < 2; ++a)
#pragma unroll
        for (int b = 0; b < 2; ++b)
#pragma unroll
            for (int m = 0; m < 4; ++m)
#pragma unroll
                for (int n = 0; n < 2; ++n) acc[a][b][m][n] = (f32x4){0.f, 0.f, 0.f, 0.f};
    bf16x8 At[4][2], B0[2][2], B1[2][2];
    const char* cA = (const char*)g.A + (size_t)cur.pm * tstep; const char* cB = (const char*)g.Bt + (size_t)cur.pn * tstep;
    S.a_ready(cur);
    if constexpr (SP2) {
        PG8_STAGE(PG8_SB(0, 0), cB, voffB); PG8_STAGE(PG8_SB(0, 1), cB + hstep, voffB); PG8_STAGE(PG8_SA(0, 0), cA, voffA); PG8_STAGE(PG8_SA(0, 1), cA + hstep, voffA);
        if (wr == 1) PG8_BAR;
        PG8_WAIT_V(2); PG8_BAR;
        PG8_STAGE(PG8_SB(1, 0), cB + kstep, voffB); PG8_STAGE(PG8_SA(1, 0), cA + kstep, voffA); PG8_STAGE(PG8_SB(1, 1), cB + hstep + kstep, voffB);
        PG8_WAIT_V(6); PG8_BAR;
    } else {
        PG8_STAGE(PG8_SB(0, 0), cB, voffB); PG8_STAGE(PG8_SA(0, 0), cA, voffA); PG8_STAGE(PG8_SB(0, 1), cB + hstep, voffB); PG8_STAGE(PG8_SA(0, 1), cA + hstep, voffA);
        if (wr == 1) PG8_BAR;
        PG8_WAIT_V(4); PG8_BAR;
        PG8_STAGE(PG8_SB(1, 0), cB + kstep, voffB); PG8_STAGE(PG8_SA(1, 0), cA + kstep, voffA); PG8_STAGE(PG8_SB(1, 1), cB + hstep + kstep, voffB);
        PG8_WAIT_V(6); PG8_BAR;
    }
    for (;;) {
        const bool has_next = S.next(ui + 1, nxt);
        const char* nA = has_next ? (const char*)g.A + (size_t)nxt.pm * tstep : cA; const char* nB = has_next ? (const char*)g.Bt + (size_t)nxt.pn * tstep : cB;
        for (int t = 0; t < nt; t += 2) {
            const bool last = (t == nt - 2);
            const char* a1 = cA + (size_t)(t + 1) * kstep;
            const char* a2 = last ? nA : cA + (size_t)(t + 2) * kstep; const char* b2 = last ? nB : cB + (size_t)(t + 2) * kstep;
            const char* a3 = a2 + kstep; const char* b3 = b2 + kstep;
            if (last && has_next) S.a_ready(nxt);
            if constexpr (SP2) {
            PG8_LDB(B0, 0, 0); PG8_LDB(B1, 0, 1); PG8_SCHED; PG8_LDA(At, 0, 0); PG8_STAGE(PG8_SA(1, 1), a1 + hstep, voffA);
            PG8_WAIT_V(8); PG8_WAIT_L(0); PG8_BAR; PG8_MMA(0, 0, At, B0); PG8_MMA(0, 1, At, B1); PG8_BAR; PG8_SCHED;
            PG8_LDA(At, 0, 1); PG8_STAGE(PG8_SB(0, 0), b2, voffB); PG8_STAGE(PG8_SB(0, 1), b2 + hstep, voffB); PG8_STAGE(PG8_SA(0, 0), a2, voffA);
            PG8_WAIT_V(8); PG8_WAIT_L(0); PG8_BAR; PG8_MMA(1, 0, At, B0); PG8_MMA(1, 1, At, B1); PG8_BAR; PG8_SCHED;
            PG8_LDB(B0, 1, 0); PG8_LDB(B1, 1, 1); PG8_SCHED; PG8_LDA(At, 1, 0); PG8_STAGE(PG8_SA(0, 1), a2 + hstep, voffA);
            PG8_WAIT_V(8); PG8_WAIT_L(0); PG8_BAR; PG8_MMA(0, 0, At, B0); PG8_MMA(0, 1, At, B1); PG8_BAR; PG8_SCHED;
            PG8_LDA(At, 1, 1); PG8_STAGE(PG8_SB(1, 0), b3, voffB); PG8_STAGE(PG8_SB(1, 1), b3 + hstep, voffB); PG8_STAGE(PG8_SA(1, 0), a3, voffA);
            PG8_WAIT_V(8); PG8_WAIT_L(0); PG8_BAR; PG8_MMA(1, 0, At, B0); PG8_MMA(1, 1, At, B1); PG8_BAR; PG8_SCHED;
            } else {
            PG8_LDB(B0, 0, 0); PG8_SCHED; PG8_LDA(At, 0, 0); PG8_STAGE(PG8_SA(1, 1), a1 + hstep, voffA);
            PG8_WAIT_L(8); PG8_BAR; PG8_WAIT_L(0); PG8_MMA(0, 0, At, B0); PG8_BAR; PG8_SCHED;
            PG8_LDB(B1, 0, 1); PG8_STAGE(PG8_SB(0, 0), b2, voffB);
            PG8_BAR; PG8_WAIT_L(0); PG8_MMA(0, 1, At, B1); PG8_BAR;
            PG8_LDA(At, 0, 1); PG8_STAGE(PG8_SA(0, 0), a2, voffA);
            PG8_BAR; PG8_WAIT_L(0); PG8_MMA(1, 0, At, B0); PG8_BAR; PG8_SCHED;
            PG8_STAGE(PG8_SB(0, 1), b2 + hstep, voffB);
            PG8_WAIT_V(6); PG8_BAR; PG8_MMA(1, 1, At, B1); PG8_BAR;
            PG8_LDB(B0, 1, 0); PG8_SCHED; PG8_LDA(At, 1, 0); PG8_STAGE(PG8_SA(0, 1), a2 + hstep, voffA);
            PG8_WAIT_L(8); PG8_BAR; PG8_WAIT_L(0); PG8_MMA(0, 0, At, B0); PG8_BAR; PG8_SCHED;
            PG8_LDB(B1, 1, 1); PG8_STAGE(PG8_SB(1, 0), b3, voffB);
            PG8_BAR; PG8_WAIT_L(0); PG8_MMA(0, 1, At, B1); PG8_BAR;
            PG8_LDA(At, 1, 1); PG8_STAGE(PG8_SA(1, 0), a3, voffA);
            PG8_BAR; PG8_WAIT_L(0); PG8_MMA(1, 0, At, B0); PG8_BAR; PG8_SCHED;
            PG8_STAGE(PG8_SB(1, 1), b3 + hstep, voffB);
            PG8_WAIT_V(6); PG8_BAR; PG8_MMA(1, 1, At, B1); PG8_BAR;
            }
        }
        if constexpr (ALIGN_EPI) { if (wr == 0) PG8_BAR; }
        if constexpr (!Epi::AFTER_DRAIN) { E(acc, cur, wr, wc, fr, fq); S.done(cur); }
        if (!has_next) break;
#pragma unroll
        for (int a = 0; a < 2; ++a)
#pragma unroll
            for (int b = 0; b < 2; ++b)
#pragma unroll
                for (int m = 0; m < 4; ++m)
#pragma unroll
                    for (int n = 0; n < 2; ++n) acc[a][b][m][n] = (f32x4){0.f, 0.f, 0.f, 0.f};
        cur = nxt; cA = nA; cB = nB; ++ui;
        if constexpr (ALIGN_EPI) { if (wr == 1) PG8_BAR; }
    }
    PG8_WAIT_V(0);
    if constexpr (!ALIGN_EPI) { if (wr == 0) PG8_BAR; }
    PG8_BAR;
    if constexpr (Epi::AFTER_DRAIN) { E.fused(acc, cur, wr, wc, fr, fq, lds, wid, lane); S.done(cur); }
#undef PG8_SA
#undef PG8_SB
#undef PG8_STAGE
#undef PG8_LDA
#undef PG8_LDB
#undef PG8_MMA
#undef PG8_WAIT_V
#undef PG8_WAIT_L
#undef PG8_BAR
#undef PG8_SCHED
}
}

constexpr int NWAVES = 8;
#ifndef MK_N_LAUNCHES
#define MK_N_LAUNCHES 1
#endif
constexpr int N_LAUNCHES = MK_N_LAUNCHES;
constexpr int N_PHASES = 17;

constexpr int BATCH = 16, SEQ = 2048, DM = 1024, M = BATCH * SEQ;
constexpr int EVEN_IN = 3072, ODD_IN = 2560;
constexpr float EPS = 1e-6f;

constexpr size_t MiB = 1u << 20;
constexpr size_t WS_CTL = 0, CTL_ZERO_BYTES = 1 * MiB;
constexpr size_t WS_WIN0 = 2 * MiB;
constexpr size_t WS_WOUT0 = 8 * MiB;
constexpr size_t WS_WIN1 = 10 * MiB;
constexpr size_t WS_WGLU = 15 * MiB;
constexpr size_t WS_WPW = 16 * MiB;
constexpr size_t WS_WPOOL = 17 * MiB;
constexpr size_t WS_WOUT1 = 18 * MiB;
constexpr size_t WS_ROPE = 20 * MiB;
constexpr size_t WS_S5C = 21 * MiB;
constexpr size_t WS_KBAR = 22 * MiB;
constexpr size_t WS_S5PW = 23 * MiB;
constexpr size_t WS_S5A16 = 24 * MiB;
constexpr size_t WS_S5F = 25 * MiB;
constexpr size_t WS_S5G = 26 * MiB;
constexpr size_t WS_S5H = 28 * MiB;
constexpr size_t WS_XN = 32 * MiB;
constexpr size_t WS_Z = 96 * MiB;
constexpr size_t WS_MB = 288 * MiB;
constexpr size_t WS_Y = 352 * MiB;
constexpr size_t WS_T1 = 416 * MiB;
constexpr size_t WS_T2 = 448 * MiB;
constexpr size_t WS_END = 480 * MiB;
constexpr int CW_BAR = 4096;

constexpr int RING_OFF = 0, RING_BYTES = 131072;
constexpr int LDSCTL_OFF = RING_BYTES, MISC_OFF = LDSCTL_OFF + 320;
constexpr int LDS_BYTES = 147456;

#define GAS __attribute__((address_space(1)))
#define LAS __attribute__((address_space(3)))
typedef unsigned short bf16;
typedef unsigned v4u __attribute__((ext_vector_type(4)));
typedef unsigned v2u __attribute__((ext_vector_type(2)));
typedef float f32x4 __attribute__((ext_vector_type(4)));
#define LDS_WAIT() asm volatile("s_waitcnt lgkmcnt(0)" ::: "memory")
#define VM_WAIT() asm volatile("s_waitcnt vmcnt(0)" ::: "memory")
__device__ __forceinline__ unsigned f2bf(float f) { unsigned u = __builtin_bit_cast(unsigned, f); return (u + 0x7fffu + ((u >> 16) & 1u)) >> 16; }
__device__ __forceinline__ unsigned pk2(float lo, float hi) { return f2bf(lo) | (f2bf(hi) << 16); }
__device__ __forceinline__ float bf2f(unsigned short v) { return __builtin_bit_cast(float, (unsigned)v << 16); }
__device__ __forceinline__ float bflo(unsigned w) { return __builtin_bit_cast(float, w << 16); }
__device__ __forceinline__ float bfhi(unsigned w) { return __builtin_bit_cast(float, w & 0xffff0000u); }
__device__ __forceinline__ float sigmoidf_(float x) { return 1.0f / (1.0f + __expf(-x)); }
__device__ __forceinline__ float siluf_(float x) { return x / (1.0f + __expf(-x)); }

#define XB_TMO      128
#define XB_XCNT(j)  (256  + 64 * (j))
#define XB_XSUB(j)  (1280 + 64 * (j))
#define XB_XGEN(j)  (2304 + 64 * (j))
#define XB_TOP      3328
#define XB_TOPGEN   3392
#define XCD_BAR_WORDS 3456
#define XB_SPIN_CAP (1u << 18)
__device__ __forceinline__ unsigned xb_ld(unsigned* p)              { return __hip_atomic_load(p, __ATOMIC_RELAXED, __HIP_MEMORY_SCOPE_AGENT); }
__device__ __forceinline__ unsigned xb_add(unsigned* p, unsigned v) { return __hip_atomic_fetch_add(p, v, __ATOMIC_RELAXED, __HIP_MEMORY_SCOPE_AGENT); }
__device__ __forceinline__ unsigned xb_xcc_id() { return (unsigned)__builtin_amdgcn_s_getreg((3 << 11) | 20) & 0xFu; }
#define XB_SPIN(cond, bar) do { unsigned _sp = 0; while (cond) { __builtin_amdgcn_s_sleep(1); \
    if ((++_sp & 255u) == 0u) { if (xb_ld(&(bar)[XB_TMO])) break; if (_sp > XB_SPIN_CAP) { atomicAdd(&(bar)[XB_TMO], 1u); break; } } } } while (0)
struct XcdBarrier { unsigned* bar; unsigned x; volatile LAS unsigned* st; };
__device__ __forceinline__ XcdBarrier xcd_barrier_post(unsigned* bar, volatile LAS unsigned* st) {
    XcdBarrier b; b.bar = bar; b.x = xb_xcc_id(); b.st = st;
    if (threadIdx.x == 0) (void)xb_add(&bar[XB_XCNT(b.x)], 1u);
    return b;
}
__device__ __forceinline__ void xcd_barrier_complete(unsigned* bar, unsigned x, unsigned& nloc, unsigned& nx) {
    const unsigned G = gridDim.x * gridDim.y * gridDim.z;
    unsigned sum, cnt, mine, sp = 0u;
    for (;;) {
        sum = 0u; cnt = 0u; mine = 0u;
#pragma unroll
        for (unsigned j = 0; j < 16; ++j) { const unsigned c = xb_ld(&bar[XB_XCNT(j)]); sum += c; cnt += (c > 0u) ? 1u : 0u; mine = (j == x) ? c : mine; }
        if (sum == G) break;
        __builtin_amdgcn_s_sleep(1);
        if ((++sp & 255u) == 0u) { if (xb_ld(&bar[XB_TMO])) break; if (sp > XB_SPIN_CAP) { atomicAdd(&bar[XB_TMO], 1u); break; } }
    }
    nloc = mine > 0u ? mine : 1u; nx = cnt > 0u ? cnt : 1u;
}
__device__ __forceinline__ void xcd_barrier(const XcdBarrier& b) {
    asm volatile("s_waitcnt vmcnt(0)" ::: "memory");
    __syncthreads();
    if (threadIdx.x == 0) {
        unsigned* bar = b.bar;
        __builtin_amdgcn_s_waitcnt(0);
        unsigned nloc = b.st[0], nx = b.st[1];
        if (nloc == 0u) { xcd_barrier_complete(bar, b.x, nloc, nx); b.st[0] = nloc; b.st[1] = nx; }
        const unsigned old = xb_add(&bar[XB_XSUB(b.x)], 1u);
        const unsigned gen = old / nloc;
        if (old + 1u == (gen + 1u) * nloc) {
            __builtin_amdgcn_fence(__ATOMIC_RELEASE, "agent");
            asm volatile("s_waitcnt vmcnt(0)" ::: "memory");
            const unsigned og = xb_add(&bar[XB_TOP], 1u);
            const unsigned tg = og / nx;
            if (og + 1u == (tg + 1u) * nx) xb_add(&bar[XB_TOPGEN], 1u);
            else XB_SPIN(xb_ld(&bar[XB_TOPGEN]) == tg, bar);
            __builtin_amdgcn_fence(__ATOMIC_ACQUIRE, "agent");
            xb_add(&bar[XB_XGEN(b.x)], 1u);
            asm volatile("s_waitcnt vmcnt(0)" ::: "memory");
        } else {
            XB_SPIN(xb_ld(&bar[XB_XGEN(b.x)]) == gen, bar);
            __builtin_amdgcn_fence(__ATOMIC_ACQUIRE, "agent");
            asm volatile("s_waitcnt vmcnt(0)" ::: "memory");
        }
    }
    __syncthreads();
}

struct Frame {
    LAS unsigned char* lds;
    int tid, lane, wave;
    int vcu, G, gw, NGW;
    const float* in[23]; float* out; unsigned char* ws;
};
__device__ __forceinline__ float wave_sum(float v) {
#pragma unroll
    for (int o = 1; o < 64; o <<= 1) v += __shfl_xor(v, o);
    return v;
}
__device__ __forceinline__ float wave_max(float v) {
#pragma unroll
    for (int o = 1; o < 64; o <<= 1) v = fmaxf(v, __shfl_xor(v, o));
    return v;
}

__device__ __forceinline__ void p0_transpose_item(const float* W, int K, int N, bf16* WT, const float* gk, LAS float* scr, int item, int lane) {
    const int nblk = N / 32, kb = item / nblk, nb = item % nblk, k0 = 64 * kb, n0 = 32 * nb;
#pragma unroll 8
    for (int i = 0; i < 32; ++i) { const int kk = 2 * i + (lane >> 5); float v = W[(size_t)(k0 + kk) * N + n0 + (lane & 31)]; if (gk) v *= gk[k0 + kk]; scr[kk * 33 + (lane & 31)] = v; }
    LDS_WAIT(); asm volatile("" ::: "memory");
    const int c = lane & 7;
#pragma unroll
    for (int j = 0; j < 4; ++j) { const int n = (lane >> 3) + 8 * j; const LAS float* s = scr + (8 * c) * 33 + n;
        v4u o; o.x = pk2(s[0 * 33], s[1 * 33]); o.y = pk2(s[2 * 33], s[3 * 33]); o.z = pk2(s[4 * 33], s[5 * 33]); o.w = pk2(s[6 * 33], s[7 * 33]);
        *(GAS v4u*)(WT + (size_t)(n0 + n) * K + k0 + 8 * c) = o; }
    LDS_WAIT(); asm volatile("" ::: "memory");
}

__device__ __forceinline__ void ph_prologue(Frame& F) {
    LAS float* scr = (LAS float*)(F.lds + RING_OFF + F.wave * 16384);
    unsigned char* ws = F.ws;
    const int I_IN0 = (1024 / 64) * (EVEN_IN / 32), I_SQ = (1024 / 64) * (1024 / 32), I_IN1 = (1024 / 64) * (ODD_IN / 32), I_GLU = (512 / 64) * (1024 / 32), I_PW = (512 / 64) * (512 / 32);
    const int NITEMS = I_IN0 + I_SQ + I_IN1 + I_GLU + I_PW + I_SQ;
    for (int it = F.gw; it < NITEMS; it += F.NGW) {
        int r = it;
        if (r < I_IN0) { p0_transpose_item(F.in[3], 1024, EVEN_IN, (bf16*)(ws + WS_WIN0), F.in[1], scr, r, F.lane); continue; } r -= I_IN0;
        if (r < I_SQ) { p0_transpose_item(F.in[6], 1024, 1024, (bf16*)(ws + WS_WOUT0), nullptr, scr, r, F.lane); continue; } r -= I_SQ;
        if (r < I_IN1) { p0_transpose_item(F.in[7], 1024, ODD_IN, (bf16*)(ws + WS_WIN1), F.in[1] + 1024, scr, r, F.lane); continue; } r -= I_IN1;
        if (r < I_GLU) { p0_transpose_item(F.in[16], 512, 1024, (bf16*)(ws + WS_WGLU), nullptr, scr, r, F.lane); continue; } r -= I_GLU;
        if (r < I_PW) { p0_transpose_item(F.in[21], 512, 512, (bf16*)(ws + WS_WPW), nullptr, scr, r, F.lane); continue; } r -= I_PW;
        p0_transpose_item(F.in[22], 1024, 1024, (bf16*)(ws + WS_WOUT1), nullptr, scr, r, F.lane);
    }
    const int gt = F.gw * 64 + F.lane, NGT = F.NGW * 64;
    { bf16* wp = (bf16*)(ws + WS_WPOOL); const float* pw = F.in[4]; const float* ps = F.in[5];
      for (int i = gt; i < 512 * 512; i += NGT) { const int n = i >> 9, k = i & 511; float v = 0.f;
          if ((n >> 7) == (k >> 7)) v = pw[(size_t)(n >> 7) * 16384 + (k & 127) * 128 + (n & 127)] * ps[n];
          wp[i] = (bf16)f2bf(v); } }
    { float* rt = (float*)(ws + WS_ROPE);
      for (int i = gt; i < SEQ * 16; i += NGT) { const int t = i >> 4, j = i & 15;
          const float inv = (float)pow(500000.0, -(double)(2 * j) / 32.0); const float ang = (float)t * inv;
          rt[2 * i] = (float)cos((double)ang); rt[2 * i + 1] = (float)sin((double)ang); } }
    { float* sc = (float*)(ws + WS_S5C); float* Lre = sc, *Lim = sc + 2048, *BBre = sc + 4096, *BBim = sc + 4096 + 32768;
      const float* lam_re = F.in[8]; const float* lam_im = F.in[9]; const float* log_dt = F.in[10]; const float* b_re = F.in[11]; const float* b_im = F.in[12];
      for (int i = gt; i < 2048; i += NGT) { const int g = i >> 6;
          const double lr = lam_re[i], li = lam_im[i], dt = exp((double)log_dt[g]);
          const double mag = exp(lr * dt), are = mag * cos(li * dt), aim = mag * sin(li * dt);
          const double den = lr * lr + li * li, nre = are - 1.0;
          const double fre = (nre * lr + aim * li) / den, fim = (aim * lr - nre * li) / den;
          Lre[i] = (float)are; Lim[i] = (float)aim;
          { double* pw = (double*)(ws + WS_S5PW); double pr = 1.0, pi = 0.0; const int p = i & 63;
            for (int e = 0; e <= 16; ++e) { pw[((size_t)(g * 17 + e) * 64 + p) * 2] = pr; pw[((size_t)(g * 17 + e) * 64 + p) * 2 + 1] = pi; const double nr = pr * are - pi * aim, ni = pr * aim + pi * are; pr = nr; pi = ni;
                if (e == 15) { float* a16 = (float*)(ws + WS_S5A16); a16[2 * i] = (float)pr; a16[2 * i + 1] = (float)pi; } } }
          for (int k = 0; k < 16; ++k) { const double br = b_re[(size_t)i * 16 + k], bi = b_im[(size_t)i * 16 + k];
              BBre[(size_t)i * 16 + k] = (float)(fre * br - fim * bi); BBim[(size_t)i * 16 + k] = (float)(fre * bi + fim * br); } } }
    { const float* x = F.in[0]; bf16* xn = (bf16*)(ws + WS_XN);
      for (int m = F.gw; m < M; m += F.NGW) {
          const GAS f32x4* xr = (const GAS f32x4*)(x + (size_t)m * DM) + F.lane;
          f32x4 v[4]; float s = 0.f;
#pragma unroll
          for (int j = 0; j < 4; ++j) { v[j] = xr[64 * j]; s += (v[j].x * v[j].x + v[j].y * v[j].y) + (v[j].z * v[j].z + v[j].w * v[j].w); }
          const float rstd = 1.0f / sqrtf(wave_sum(s) * (1.f / DM) + EPS);
          GAS v2u* o8 = (GAS v2u*)(xn + (size_t)m * DM) + F.lane;
#pragma unroll
          for (int j = 0; j < 4; ++j) { v2u w; w.x = pk2(v[j].x * rstd, v[j].y * rstd); w.y = pk2(v[j].z * rstd, v[j].w * rstd); o8[64 * j] = w; } } }
}

__device__ __forceinline__ void ph_rope(Frame& F) {
    bf16* Z = (bf16*)(F.ws + WS_Z); const float* rt = (const float*)(F.ws + WS_ROPE);
    const int gt = F.gw * 64 + F.lane, NGT = F.NGW * 64;
    for (int i = gt; i < M * 128; i += NGT) {
        const int row = i >> 7, r = i & 127, which = r >> 6, h = (r >> 4) & 3, j = r & 15, t = row & (SEQ - 1);
        bf16* p = Z + (size_t)row * EVEN_IN + which * 512 + h * 128 + j;
        const float x1 = bf2f(p[0]), x2 = bf2f(p[16]), c = rt[(t * 16 + j) * 2], s = rt[(t * 16 + j) * 2 + 1];
        p[0] = (bf16)f2bf(x1 * c - x2 * s); p[16] = (bf16)f2bf(x2 * c + x1 * s);
    }
}
__device__ __forceinline__ void ph_kbar(Frame& F) {
    const bf16* Z = (const bf16*)(F.ws + WS_Z); float* kb = (float*)(F.ws + WS_KBAR);
    const int gt = F.gw * 64 + F.lane, NGT = F.NGW * 64;
    for (int i = gt; i < BATCH * 8 * 512; i += NGT) { const int bn = i >> 9, c = i & 511; float s = 0.f;
        const bf16* p = Z + (size_t)bn * 256 * EVEN_IN + 512 + c;
        for (int k = 0; k < 256; ++k) s += bf2f(p[(size_t)k * EVEN_IN]);
        kb[i] = s * (1.f / 256.f); }
}
__device__ __forceinline__ void ph_attn_naive(Frame& F) {
    const bf16* Z = (const bf16*)(F.ws + WS_Z); const float* kbar = (const float*)(F.ws + WS_KBAR); bf16* MB = (bf16*)(F.ws + WS_MB);
    LAS float* qs = (LAS float*)(F.lds + RING_OFF + F.wave * 8192); LAS float* ps = qs + 128;
    const int lane = F.lane; const float scale = 0.08838834764831845f;
    for (int item = F.gw; item < M * 4; item += F.NGW) {
        const int row = item >> 2, h = item & 3, b = row >> 11, t = row & (SEQ - 1), qblk = t >> 8;
        const bf16* zrow = Z + (size_t)row * EVEN_IN;
        qs[lane] = bf2f(zrow[h * 128 + lane]); qs[lane + 64] = bf2f(zrow[h * 128 + 64 + lane]);
        LDS_WAIT(); asm volatile("" ::: "memory");
        float gate = -INFINITY;
        if (lane < 8 && lane < qblk) { const float* kb = kbar + (size_t)(b * 8 + lane) * 512 + h * 128; float a = 0.f; for (int d = 0; d < 128; ++d) a += qs[d] * bf2f((unsigned short)f2bf(kb[d])); gate = a; }
        float gv[8];
#pragma unroll
        for (int n = 0; n < 8; ++n) gv[n] = __shfl(gate, n);
        int blk[4];
#pragma unroll
        for (int r = 0; r < 3; ++r) { int best = -1; float bv = -INFINITY;
#pragma unroll
            for (int n = 0; n < 8; ++n) if (gv[n] > bv) { bv = gv[n]; best = n; }
#pragma unroll
            for (int n = 0; n < 8; ++n) if (n == best) gv[n] = -INFINITY;
            blk[r] = best; }
        blk[3] = qblk;
        float s[4][4];
#pragma unroll
        for (int j = 0; j < 4; ++j) {
#pragma unroll
            for (int i = 0; i < 4; ++i) s[j][i] = -INFINITY;
            if (blk[j] >= 0) {
#pragma unroll
                for (int i = 0; i < 4; ++i) { const int key = blk[j] * 256 + lane + 64 * i;
                    const GAS v4u* kr = (const GAS v4u*)(Z + (size_t)(b * SEQ + key) * EVEN_IN + 512 + h * 128); float a = 0.f;
                    for (int c = 0; c < 16; ++c) { const v4u w = kr[c]; const LAS float* q8 = qs + c * 8;
                        a += q8[0] * bflo(w.x) + q8[1] * bfhi(w.x) + q8[2] * bflo(w.y) + q8[3] * bfhi(w.y) + q8[4] * bflo(w.z) + q8[5] * bfhi(w.z) + q8[6] * bflo(w.w) + q8[7] * bfhi(w.w); }
                    a *= scale; if (j == 3 && key > t) a = -INFINITY; s[j][i] = a; } } }
        float mx = -INFINITY;
#pragma unroll
        for (int j = 0; j < 4; ++j)
#pragma unroll
            for (int i = 0; i < 4; ++i) mx = fmaxf(mx, s[j][i]);
        mx = wave_max(mx);
        float sum = 0.f;
#pragma unroll
        for (int j = 0; j < 4; ++j)
#pragma unroll
            for (int i = 0; i < 4; ++i) { const float p = __expf(s[j][i] - mx); sum += p; ps[j * 256 + lane + 64 * i] = p; }
        sum = wave_sum(sum);
        LDS_WAIT(); asm volatile("" ::: "memory");
        float a0 = 0.f, a1 = 0.f;
#pragma unroll
        for (int j = 0; j < 4; ++j) if (blk[j] >= 0) { const int nk = (j == 3) ? (t & 255) + 1 : 256;
            const bf16* vb = Z + (size_t)(b * SEQ + blk[j] * 256) * EVEN_IN + 1024 + h * 128 + 2 * lane;
            for (int k = 0; k < nk; ++k) { const unsigned w = *(const GAS unsigned*)(vb + (size_t)k * EVEN_IN); const float p = ps[j * 256 + k]; a0 += p * bflo(w); a1 += p * bfhi(w); } }
        const float inv = 1.0f / sum;
        const unsigned gw2 = *(const GAS unsigned*)(zrow + 1536 + h * 128 + 2 * lane);
        const float o0 = a0 * inv * siluf_(bflo(gw2)), o1 = a1 * inv * siluf_(bfhi(gw2));
        *(GAS unsigned*)(MB + (size_t)row * DM + h * 128 + 2 * lane) = pk2(o0, o1);
        LDS_WAIT(); asm volatile("" ::: "memory");
    }
}
__device__ __forceinline__ void ph_pool_naive(Frame& F) {
    const bf16* Z = (const bf16*)(F.ws + WS_Z); bf16* T1 = (bf16*)(F.ws + WS_T1);
    const int gt = F.gw * 64 + F.lane, NGT = F.NGW * 64;
    for (int i = gt; i < M * 512; i += NGT) { const int row = i >> 9, c = i & 511, g = c >> 7, w = 2 << g, t = row & (SEQ - 1);
        const int n = (t + 1 < w) ? t + 1 : w; const bf16* p = Z + (size_t)row * EVEN_IN + 2048 + c; float s = 0.f;
        for (int k = 0; k < n; ++k) s += bf2f(*(p - (size_t)k * EVEN_IN));
        T1[i] = (bf16)f2bf(s / (float)n - bf2f(p[0])); }
}
__device__ __forceinline__ void ph_pool_gate(Frame& F) {
    const bf16* Z = (const bf16*)(F.ws + WS_Z); const bf16* T2 = (const bf16*)(F.ws + WS_T2); bf16* MB = (bf16*)(F.ws + WS_MB);
    const int gt = F.gw * 64 + F.lane, NGT = F.NGW * 64;
    for (int i = gt; i < M * 512; i += NGT) { const int row = i >> 9, c = i & 511;
        MB[(size_t)row * DM + 512 + c] = (bf16)f2bf(bf2f(T2[i]) * siluf_(bf2f(Z[(size_t)row * EVEN_IN + 2560 + c]))); }
}
__device__ __forceinline__ void ph_norm_res(Frame& F, const float* base, const bf16* Y, const float* g, float* outp, bf16* xn) {
    for (int m = F.gw; m < M; m += F.NGW) {
        const GAS v2u* yr = (const GAS v2u*)(Y + (size_t)m * DM) + F.lane;
        float y[4][4]; float s = 0.f;
#pragma unroll
        for (int j = 0; j < 4; ++j) { const v2u w = yr[64 * j]; y[j][0] = bflo(w.x); y[j][1] = bfhi(w.x); y[j][2] = bflo(w.y); y[j][3] = bfhi(w.y);
            s += (y[j][0] * y[j][0] + y[j][1] * y[j][1]) + (y[j][2] * y[j][2] + y[j][3] * y[j][3]); }
        const float rstd = 1.0f / sqrtf(wave_sum(s) * (1.f / DM) + EPS);
        const GAS f32x4* br = (const GAS f32x4*)(base + (size_t)m * DM) + F.lane; const GAS f32x4* gr = (const GAS f32x4*)g + F.lane;
        GAS f32x4* orow = (GAS f32x4*)(outp + (size_t)m * DM) + F.lane;
        f32x4 x1[4]; float s1 = 0.f;
#pragma unroll
        for (int j = 0; j < 4; ++j) { const f32x4 bv = br[64 * j], gv = gr[64 * j];
            x1[j].x = bv.x + y[j][0] * rstd * gv.x; x1[j].y = bv.y + y[j][1] * rstd * gv.y; x1[j].z = bv.z + y[j][2] * rstd * gv.z; x1[j].w = bv.w + y[j][3] * rstd * gv.w;
            orow[64 * j] = x1[j]; s1 += (x1[j].x * x1[j].x + x1[j].y * x1[j].y) + (x1[j].z * x1[j].z + x1[j].w * x1[j].w); }
        if (xn) { const float r1 = 1.0f / sqrtf(wave_sum(s1) * (1.f / DM) + EPS);
            GAS v2u* o8 = (GAS v2u*)(xn + (size_t)m * DM) + F.lane;
#pragma unroll
            for (int j = 0; j < 4; ++j) { v2u w; w.x = pk2(x1[j].x * r1, x1[j].y * r1); w.y = pk2(x1[j].z * r1, x1[j].w * r1); o8[64 * j] = w; } }
    }
}
__device__ __forceinline__ void ph_s5_naive(Frame& F) {
    const bf16* Z = (const bf16*)(F.ws + WS_Z); bf16* T1 = (bf16*)(F.ws + WS_T1);
    const float* sc = (const float*)(F.ws + WS_S5C); const float* Lre = sc, *Lim = sc + 2048, *BBre = sc + 4096, *BBim = sc + 4096 + 32768;
    const float* c_re = F.in[13]; const float* c_im = F.in[14]; const float* dvec = F.in[15];
    const int lane = F.lane;
    for (int item = F.gw; item < BATCH * 32; item += F.NGW) {
        const int b = item >> 5, g = item & 31, gp = g * 64 + lane;
        const float are = Lre[gp], aim = Lim[gp];
        float bbr[16], bbi[16], cr[16], ci[16];
#pragma unroll
        for (int i = 0; i < 16; ++i) { bbr[i] = BBre[(size_t)gp * 16 + i]; bbi[i] = BBim[(size_t)gp * 16 + i]; cr[i] = c_re[(size_t)(g * 16 + i) * 64 + lane]; ci[i] = c_im[(size_t)(g * 16 + i) * 64 + lane]; }
        const float dmine = dvec[g * 16 + (lane & 15)];
        float xr = 0.f, xi = 0.f;
        for (int t = 0; t < SEQ; ++t) {
            const size_t row = (size_t)b * SEQ + t;
            const GAS v4u* up = (const GAS v4u*)(Z + row * ODD_IN + g * 16);
            const v4u w0 = up[0], w1 = up[1];
            float u[16];
            u[0] = bflo(w0.x); u[1] = bfhi(w0.x); u[2] = bflo(w0.y); u[3] = bfhi(w0.y); u[4] = bflo(w0.z); u[5] = bfhi(w0.z); u[6] = bflo(w0.w); u[7] = bfhi(w0.w);
            u[8] = bflo(w1.x); u[9] = bfhi(w1.x); u[10] = bflo(w1.y); u[11] = bfhi(w1.y); u[12] = bflo(w1.z); u[13] = bfhi(w1.z); u[14] = bflo(w1.w); u[15] = bfhi(w1.w);
            float bur = 0.f, bui = 0.f;
#pragma unroll
            for (int i = 0; i < 16; ++i) { bur += bbr[i] * u[i]; bui += bbi[i] * u[i]; }
            const float nr = are * xr - aim * xi + bur, ni = are * xi + aim * xr + bui; xr = nr; xi = ni;
            float mine = 0.f;
#pragma unroll
            for (int i = 0; i < 16; ++i) { const float v = wave_sum(xr * cr[i] - xi * ci[i]); if ((lane & 15) == i) mine = v; }
            if (lane < 16) { const float ui = bf2f(Z[row * ODD_IN + g * 16 + lane]); T1[row * 512 + g * 16 + lane] = (bf16)f2bf(mine + dmine * ui); }
        }
    }
}
__device__ __forceinline__ void ph_conv_naive(Frame& F) {
    const bf16* Z = (const bf16*)(F.ws + WS_Z); bf16* T2 = (bf16*)(F.ws + WS_T2);
    const float* dw = F.in[18]; const float* ln_g = F.in[19]; const float* ln_b = F.in[20];
    LAS float* red = (LAS float*)(F.lds + RING_OFF);
    const int c = F.tid;
    float wt[31];
#pragma unroll
    for (int j = 0; j < 31; ++j) wt[j] = dw[j * 512 + c];
    const float lg = ln_g[c], lb = ln_b[c];
    for (int row = blockIdx.x; row < M; row += F.G) {
        const int t = row & (SEQ - 1); float acc = 0.f;
#pragma unroll
        for (int j = 0; j < 31; ++j) { const int tt = t - 30 + j;
            if (tt >= 0) { const bf16* zr = Z + (size_t)(row - 30 + j) * ODD_IN; acc += bf2f(zr[1024 + c]) * sigmoidf_(bf2f(zr[1536 + c])) * wt[j]; } }
        float s = wave_sum(acc);
        __syncthreads();
        if (F.lane == 0) red[F.wave] = s;
        __syncthreads();
        float tot = 0.f;
#pragma unroll
        for (int w = 0; w < 8; ++w) tot += red[w];
        const float mu = tot * (1.f / 512.f), dlt = acc - mu;
        float q = wave_sum(dlt * dlt);
        __syncthreads();
        if (F.lane == 0) red[F.wave] = q;
        __syncthreads();
        float qt = 0.f;
#pragma unroll
        for (int w = 0; w < 8; ++w) qt += red[w];
        const float nrm = dlt * (1.0f / sqrtf(qt * (1.f / 512.f) + EPS)) * lg + lb;
        T2[(size_t)row * 512 + c] = (bf16)f2bf(siluf_(nrm));
    }
    __syncthreads();
}
__device__ __forceinline__ void ph_glu_gate(Frame& F) {
    const bf16* Z = (const bf16*)(F.ws + WS_Z); const bf16* Y = (const bf16*)(F.ws + WS_Y); bf16* MB = (bf16*)(F.ws + WS_MB); const float* gb = F.in[17];
    const int gt = F.gw * 64 + F.lane, NGT = F.NGW * 64;
    for (int i = gt; i < M * 512; i += NGT) { const int row = i >> 9, c = i & 511;
        const float ya = bf2f(Y[(size_t)row * 1024 + c]) + gb[c], yb = bf2f(Y[(size_t)row * 1024 + 512 + c]) + gb[512 + c];
        MB[(size_t)row * DM + c] = (bf16)f2bf(ya * sigmoidf_(yb) * siluf_(bf2f(Z[(size_t)row * ODD_IN + 512 + c]))); }
}
__device__ __forceinline__ void ph_conv_gate(Frame& F) {
    const bf16* Z = (const bf16*)(F.ws + WS_Z); const bf16* Y = (const bf16*)(F.ws + WS_Y); bf16* MB = (bf16*)(F.ws + WS_MB);
    const int gt = F.gw * 64 + F.lane, NGT = F.NGW * 64;
    for (int i = gt; i < M * 512; i += NGT) { const int row = i >> 9, c = i & 511;
        MB[(size_t)row * DM + 512 + c] = (bf16)f2bf(bf2f(Y[i]) * siluf_(bf2f(Z[(size_t)row * ODD_IN + 2048 + c]))); }
}


namespace swa {
constexpr int D = 128, ZP = 3072, OP = 1024;
constexpr float SCALE = 0.08838834764831845f;
constexpr float THR = 8.f;
constexpr int NW = 8, QBLK = 32, KVBLK = 64, QB = NW * QBLK;
constexpr int SHM_V = KVBLK * D * 2, SHM_K = KVBLK * D * 2;
constexpr int LDS_BYTES = 2 * SHM_V + 2 * SHM_K + NW * 64 * 4;
using bf16 = unsigned short;
typedef short bf16x8 __attribute__((ext_vector_type(8)));
typedef short s16x4 __attribute__((ext_vector_type(4)));
typedef float f32x16 __attribute__((ext_vector_type(16)));
typedef float f32x4 __attribute__((ext_vector_type(4)));
typedef unsigned u32x4 __attribute__((ext_vector_type(4)));
#define KSWZ(row, colB) ((row) * 256 + ((colB) ^ (((row) & 7) << 4)))
#define SBAR() __builtin_amdgcn_sched_barrier(0)
__device__ __forceinline__ int v_st(int k, int c) { const int kk = (k & ~0xC) | ((k & 4) << 1) | ((k & 8) >> 1); return ((kk >> 3) * 4 + (c >> 5)) * 512 + ((kk & 7) * 32 + (c & 31)) * 2; }
__device__ __forceinline__ int v_rd_base(int lane) { return ((lane & 3) << 3) | (((lane >> 2) & 3) << 6) | (((lane >> 4) & 1) << 5) | (((lane >> 5) & 1) << 8); }
constexpr int v_rd_off(int d0, int ks, int half) { return d0 * 512 + ks * 4096 + half * 2048; }
__device__ __forceinline__ int crow(int r, int hi) { return (r & 3) + 8 * (r >> 2) + 4 * hi; }
__device__ __forceinline__ unsigned cvtpk(float lo, float hi) { unsigned r; asm volatile("v_cvt_pk_bf16_f32 %0, %1, %2" : "=v"(r) : "v"(lo), "v"(hi)); return r; }
__device__ __forceinline__ bf16x8 load8(const bf16* p) { return *reinterpret_cast<const bf16x8*>(p); }
__device__ __forceinline__ void mask_tile(f32x16& p0, f32x16& p1, int dq) {
    const float NEG = -__builtin_inff();
#pragma unroll
    for (int r = 0; r < 16; ++r) {
        const int c = (r & 3) + 8 * (r >> 2);
        if (dq - c < 0) p0[r] = NEG;
        if (dq - c - 32 < 0) p1[r] = NEG;
    }
}
__device__ __forceinline__ void partialSM(f32x16& p0, f32x16& p1, float& m_reg, float& mn, float& alpha, bool sel) {
    float pmax = p0[0]; for (int r = 1; r < 16; ++r) pmax = fmaxf(pmax, p0[r]); for (int r = 0; r < 16; ++r) pmax = fmaxf(pmax, p1[r]);
    { auto rr = __builtin_amdgcn_permlane32_swap(__float_as_uint(pmax), __float_as_uint(pmax), false, false);
      pmax = fmaxf(__uint_as_float(rr[0]), __uint_as_float(rr[1])); }
    if (!sel) pmax = -__builtin_inff();
    constexpr float C2 = 1.4426950408889634f * SCALE;
    if (__builtin_expect(__all((pmax - m_reg) * SCALE <= THR), 1)) { mn = m_reg; alpha = 1.f; }
    else { mn = fmaxf(m_reg, pmax); alpha = __builtin_amdgcn_exp2f((m_reg - mn) * C2); m_reg = mn; }
    const float mnL = sel ? -mn * C2 : -__builtin_inff();
    for (int r = 0; r < 16; ++r) p0[r] = fmaf(p0[r], C2, mnL); for (int r = 0; r < 16; ++r) p1[r] = fmaf(p1[r], C2, mnL);
    for (int r = 0; r < 16; ++r) p0[r] = __builtin_amdgcn_exp2f(p0[r]);
}
__device__ __forceinline__ void finishSM(f32x16& p0, f32x16& p1, float alpha, float& l_reg, bf16x8& pa0, bf16x8& pa1, bf16x8& pa2, bf16x8& pa3) {
    for (int r = 0; r < 16; ++r) p1[r] = __builtin_amdgcn_exp2f(p1[r]);
    float ps = 0; for (int r = 0; r < 16; ++r) ps += p0[r]; for (int r = 0; r < 16; ++r) ps += p1[r];
    { auto rr = __builtin_amdgcn_permlane32_swap(__float_as_uint(ps), __float_as_uint(ps), false, false);
      ps = __uint_as_float(rr[0]) + __uint_as_float(rr[1]); }
    l_reg = l_reg * alpha + ps;
#define PK4(P, B_, OUT) do { unsigned a0 = cvtpk(P[B_+0], P[B_+1]), a1 = cvtpk(P[B_+2], P[B_+3]);                          \
        unsigned b0 = cvtpk(P[B_+4], P[B_+5]), b1 = cvtpk(P[B_+6], P[B_+7]);                                             \
        auto r0 = __builtin_amdgcn_permlane32_swap(a0, b0, false, false); auto r1 = __builtin_amdgcn_permlane32_swap(a1, b1, false, false); \
        u32x4 w = {r0[0], r1[0], r0[1], r1[1]}; OUT = *reinterpret_cast<bf16x8*>(&w); } while (0)
    PK4(p0, 0, pa0); PK4(p0, 8, pa1); PK4(p1, 0, pa2); PK4(p1, 8, pa3);
#undef PK4
}
template <int KB>
__device__ __forceinline__ void qkt(f32x16& p0, f32x16& p1, const char* K_lds, int r32, int hi, const bf16x8* qr) {
    p0 = f32x16{}; p1 = f32x16{};
    const char* kb[4];
#pragma unroll
    for (int dd = 0; dd < 4; ++dd) kb[dd] = K_lds + KB * SHM_K + KSWZ(r32, (dd * 16 + hi * 8) * 2);
#pragma unroll
    for (int d0 = 0; d0 < 8; ++d0) { const char* a = kb[d0 & 3] + (d0 >> 2) * 128;
        bf16x8 b0 = *reinterpret_cast<const bf16x8*>(a);
        bf16x8 b1 = *reinterpret_cast<const bf16x8*>(a + 32 * 256);
        p0 = __builtin_amdgcn_mfma_f32_32x32x16_bf16(b0, qr[d0], p0, 0, 0, 0);
        p1 = __builtin_amdgcn_mfma_f32_32x32x16_bf16(b1, qr[d0], p1, 0, 0, 0); }
}
template <int VB>
__device__ __forceinline__ void pv_tile(f32x16* o, int vb0, bf16x8 pa0, bf16x8 pa1, bf16x8 pa2, bf16x8 pa3) {
#define TRRD(dst, off) asm volatile("ds_read_b64_tr_b16 %0, %1 offset:%2" : "=&v"(dst) : "v"(vb0), "i"(off) : "memory")
#define PV_D0(d0) do { s16x4 l0, l1, l2, l3, h0, h1, h2, h3; constexpr int b_ = VB * SHM_V + v_rd_off(d0, 0, 0); \
        TRRD(l0, b_); TRRD(h0, b_ + 2048); TRRD(l1, b_ + 4096); TRRD(h1, b_ + 6144); TRRD(l2, b_ + 8192); TRRD(h2, b_ + 10240); TRRD(l3, b_ + 12288); TRRD(h3, b_ + 14336); \
        asm volatile("s_waitcnt lgkmcnt(0)" ::: "memory"); SBAR();   \
        o[d0] = __builtin_amdgcn_mfma_f32_32x32x16_bf16(pa0, (bf16x8){l0[0], l0[1], l0[2], l0[3], h0[0], h0[1], h0[2], h0[3]}, o[d0], 0, 0, 0);   \
        o[d0] = __builtin_amdgcn_mfma_f32_32x32x16_bf16(pa1, (bf16x8){l1[0], l1[1], l1[2], l1[3], h1[0], h1[1], h1[2], h1[3]}, o[d0], 0, 0, 0);   \
        o[d0] = __builtin_amdgcn_mfma_f32_32x32x16_bf16(pa2, (bf16x8){l2[0], l2[1], l2[2], l2[3], h2[0], h2[1], h2[2], h2[3]}, o[d0], 0, 0, 0);   \
        o[d0] = __builtin_amdgcn_mfma_f32_32x32x16_bf16(pa3, (bf16x8){l3[0], l3[1], l3[2], l3[3], h3[0], h3[1], h3[2], h3[3]}, o[d0], 0, 0, 0); } while (0)
    PV_D0(0); PV_D0(1); PV_D0(2); PV_D0(3);
#undef PV_D0
#undef TRRD
}
struct BlockRef { const bf16* Q; const bf16* K; const bf16* V; bf16* O; const bf16* GA; const float* KBAR; int qblk; };
struct Seam { bf16x8 qr[8]; bf16x8 st_v0, st_v1, st_k0, st_k1; };
#define ROW(p, k0, rr) ((p) + (size_t)((k0) + (rr)) * ZP + sc)
#define VMW() asm volatile("s_waitcnt vmcnt(0)" ::: "memory")
#define VMWN(n) asm volatile("s_waitcnt vmcnt(%0)" :: "i"(n) : "memory")
#define SLOAD_H(Kp, Vp, k0) do { S.st_v0 = load8(ROW(Vp, k0, sr)); S.st_v1 = load8(ROW(Vp, k0, 32 + sr));              \
                         S.st_k0 = load8(ROW(Kp, k0, sr)); S.st_k1 = load8(ROW(Kp, k0, 32 + sr)); } while (0)
#define SWRITE_HK(bf) do { *(bf16x8*)(K_lds + (bf) * SHM_K + kws) = S.st_k0; *(bf16x8*)(K_lds + (bf) * SHM_K + kws + 32 * 256) = S.st_k1; } while (0)
#define SWRITE_HV(bf) do { *(bf16x8*)(V_lds + (bf) * SHM_V + vst0) = S.st_v0; *(bf16x8*)(V_lds + (bf) * SHM_V + vst1) = S.st_v1; } while (0)
#define SWRITE_H(bf) do { SWRITE_HV(bf); SWRITE_HK(bf); } while (0)
__device__ __forceinline__ void prime(const BlockRef& cur, char* lds, Seam& S) {
    const int tid = threadIdx.x, wid = __builtin_amdgcn_readfirstlane(tid >> 6), lane = tid & 63, r32 = lane & 31, hi = lane >> 5;
    const int sr = tid >> 4, sc = (tid & 15) * 8, kws = KSWZ(sr, sc * 2); char* K_lds = lds + 2 * SHM_V;
    for (int d0 = 0; d0 < 8; ++d0) S.qr[d0] = load8(cur.Q + (size_t)(wid * QBLK + r32) * ZP + d0 * 16 + hi * 8);
    SLOAD_H(cur.K, cur.V, 0); VMW(); SWRITE_HK(0);
    __syncthreads();
}
__device__ __forceinline__ unsigned select_blocks(const BlockRef& cur, const bf16x8* qr, int r32, int hi) {
    const int qblk = cur.qblk;
    f32x16 g = {};
#pragma unroll
    for (int d0 = 0; d0 < 8; ++d0) {
        bf16x8 a = {0, 0, 0, 0, 0, 0, 0, 0};
        if (r32 < 8) { const float* kp = cur.KBAR + (size_t)r32 * 512 + d0 * 16 + hi * 8; const f32x4 x = *(const f32x4*)kp, y = *(const f32x4*)(kp + 4);
            u32x4 w = {cvtpk(x[0], x[1]), cvtpk(x[2], x[3]), cvtpk(y[0], y[1]), cvtpk(y[2], y[3])}; a = *reinterpret_cast<bf16x8*>(&w); }
        g = __builtin_amdgcn_mfma_f32_32x32x16_bf16(a, qr[d0], g, 0, 0, 0);
    }
    float gv[8];
#pragma unroll
    for (int r = 0; r < 4; ++r) { auto rr = __builtin_amdgcn_permlane32_swap(__float_as_uint(g[r]), __float_as_uint(g[r]), false, false);
        gv[r] = __uint_as_float(rr[0]); gv[4 + r] = __uint_as_float(rr[1]); }
    const float NEG = -__builtin_inff();
#pragma unroll
    for (int n = 0; n < 8; ++n) if (n >= qblk) gv[n] = NEG;
    unsigned bits = 1u << qblk;
#pragma unroll
    for (int k = 0; k < 3; ++k) { int best = -1; float bv = NEG;
#pragma unroll
        for (int n = 0; n < 8; ++n) if (gv[n] > bv) { bv = gv[n]; best = n; }
#pragma unroll
        for (int n = 0; n < 8; ++n) if (n == best) gv[n] = NEG;
        if (best >= 0) bits |= 1u << best; }
    return bits;
}
__device__ __forceinline__ void block(const BlockRef& cur, const BlockRef& nxt, char* lds, Seam& S) {
    const int tid = threadIdx.x, wid = __builtin_amdgcn_readfirstlane(tid >> 6), lane = tid & 63, r32 = lane & 31, hi = lane >> 5;
    const int P0 = cur.qblk * QB;
    const int NT = 4 * cur.qblk + 4;
    const int qlo = P0 + wid * QBLK, qm = qlo + r32 - 4 * hi;
    char* V_lds = lds; char* K_lds = lds + 2 * SHM_V;
    float* ws = (float*)(lds + 2 * SHM_V + 2 * SHM_K) + wid * 64; float* li_l = ws, * al_l = ws + 32;
    float m_reg = -1e30f, l_reg = 0; f32x16 o[4] = {};
    const int sr = tid >> 4, sc = (tid & 15) * 8, vst0 = v_st(sr, sc), vst1 = v_st(32 + sr, sc), kws = KSWZ(sr, sc * 2);
    const int vb0 = (int)(uintptr_t)V_lds + v_rd_base(lane);
    const bf16* Kh = cur.K; const bf16* Vh = cur.V;
    const unsigned selbits = select_blocks(cur, S.qr, r32, hi);
#define RESC(a) do { if (__any((a) < 1.f)) { if (hi == 0) al_l[r32] = (a); asm volatile("s_waitcnt lgkmcnt(0)" ::: "memory");              \
                     for (int d_ = 0; d_ < 4; ++d_) for (int r = 0; r < 16; ++r) o[d_][r] *= al_l[crow(r, hi)]; } } while (0)
#define KBASE(t) ((t) * KVBLK)
#define SEL(t) (((selbits >> ((t) >> 2)) & 1u) != 0u)
#define MASKT(P0_, P1_, t) do { const int kb_ = KBASE(t); if (kb_ + KVBLK - 1 > qlo) mask_tile(P0_, P1_, qm - kb_); } while (0)
    constexpr int NQL = 8;
#define SEAM_K0() do { VMWN(NQL); SWRITE_HK(0); SBAR(); } while (0)
    f32x16 pA0, pA1, pB0, pB1; float mnA, mnB, alA, alB; bf16x8 pa0, pa1, pa2, pa3;
    SWRITE_HV(0); SBAR();
    if (NT > 1) { SLOAD_H(Kh, Vh, KBASE(1)); }
    SBAR(); qkt<0>(pA0, pA1, K_lds, r32, hi, S.qr);
    MASKT(pA0, pA1, 0); partialSM(pA0, pA1, m_reg, mnA, alA, SEL(0));
    if (NT > 1) { VMW(); SWRITE_H(1); }
    __syncthreads();
#define HALF_STEP(PX0, PX1, mnX, alX, PY0, PY1, alY, t, KB, VB, SB) do {                                                      \
        SBAR(); qkt<KB>(PX0, PX1, K_lds, r32, hi, S.qr);                                             \
        finishSM(PY0, PY1, alY, l_reg, pa0, pa1, pa2, pa3); SBAR();                                                           \
        if ((t) + 1 < NT) { SLOAD_H(Kh, Vh, KBASE((t) + 1)); SBAR(); }                                               \
        pv_tile<VB>(o, vb0, pa0, pa1, pa2, pa3); MASKT(PX0, PX1, (t)); partialSM(PX0, PX1, m_reg, mnX, alX, SEL(t));                                        \
        __syncthreads();                                                                                                      \
        if ((t) + 1 < NT) { VMW(); SWRITE_H(SB); }                                                                          \
        RESC(alX); __syncthreads(); } while (0)
    for (int t = 1; t + 1 < NT; t += 2) {
        HALF_STEP(pB0, pB1, mnB, alB, pA0, pA1, alA, t, 1, 0, 0);
        HALF_STEP(pA0, pA1, mnA, alA, pB0, pB1, alB, t + 1, 0, 1, 1);
    }
    { SBAR(); qkt<1>(pB0, pB1, K_lds, r32, hi, S.qr); SBAR(); }
    SLOAD_H(nxt.K, nxt.V, 0); SBAR();
#pragma unroll
    for (int d0 = 0; d0 < 8; ++d0) S.qr[d0] = load8(nxt.Q + (size_t)(wid * QBLK + r32) * ZP + d0 * 16 + hi * 8);
    SBAR();
    finishSM(pA0, pA1, alA, l_reg, pa0, pa1, pa2, pa3); SBAR();
    pv_tile<0>(o, vb0, pa0, pa1, pa2, pa3);
    { MASKT(pB0, pB1, NT - 1); partialSM(pB0, pB1, m_reg, mnB, alB, SEL(NT - 1)); __syncthreads(); RESC(alB);
      finishSM(pB0, pB1, alB, l_reg, pa0, pa1, pa2, pa3); SBAR(); pv_tile<1>(o, vb0, pa0, pa1, pa2, pa3); }
    SBAR(); SEAM_K0();
    if (hi == 0) li_l[r32] = l_reg; asm volatile("s_waitcnt lgkmcnt(0)" ::: "memory");
    float rli[16];
#pragma unroll
    for (int r = 0; r < 16; ++r) rli[r] = __builtin_amdgcn_rcpf(li_l[crow(r, hi)]);
    int hi2 = hi, r2 = r32; asm volatile("" : "+v"(hi2), "+v"(r2));
    bf16* Ow = cur.O + (size_t)(wid * QBLK + 4 * hi2) * OP + r2; const bf16* Gw = cur.GA + (size_t)(wid * QBLK + 4 * hi2) * ZP + r2;
#pragma unroll
    for (int r = 0; r < 16; ++r) { const int orow = (r & 3) + 8 * (r >> 2);
#pragma unroll
        for (int d0 = 0; d0 < 4; ++d0) { const float gat = __builtin_bit_cast(float, (unsigned)Gw[(size_t)orow * ZP + d0 * 32] << 16);
            const float v = o[d0][r] * rli[r] * (gat / (1.0f + __expf(-gat)));
            const float vn = __shfl_xor(v, 1);
            if ((r2 & 1) == 0) *(unsigned*)(Ow + (size_t)orow * OP + d0 * 32) = cvtpk(v, vn); } }
    __syncthreads();
#undef RESC
#undef KBASE
#undef SEL
#undef MASKT
#undef SEAM_K0
#undef HALF_STEP
}
#undef ROW
#undef VMW
#undef VMWN
#undef SLOAD_H
#undef SWRITE_HK
#undef SWRITE_HV
#undef SWRITE_H
#undef KSWZ
#undef SBAR
}

__device__ __forceinline__ swa::BlockRef attn_ref(unsigned char* ws, bf16* Obase, int bh, int qblk) {
    const int b = bh >> 2, h = bh & 3; const bf16* Z = (const bf16*)(ws + WS_Z);
    swa::BlockRef r; const size_t row0 = (size_t)b * SEQ + (size_t)qblk * 256;
    r.Q = Z + row0 * EVEN_IN + h * 128; r.K = Z + (size_t)b * SEQ * EVEN_IN + 512 + h * 128; r.V = Z + (size_t)b * SEQ * EVEN_IN + 1024 + h * 128;
    r.GA = Z + row0 * EVEN_IN + 1536 + h * 128; r.O = Obase + row0 * DM + h * 128;
    r.KBAR = (const float*)(ws + WS_KBAR) + (size_t)b * 8 * 512 + h * 128; r.qblk = qblk; return r;
}
__device__ __forceinline__ void ph_attn(Frame& F, bf16* Obase) {
    char* lds = (char*)F.lds + RING_OFF;
    const int total = BATCH * 4 * 4;
    int L = F.vcu; if (L >= total) return;
    int pass = 0;
    swa::BlockRef cur = attn_ref(F.ws, Obase, L >> 2, L & 3);
    swa::Seam S;
    swa::prime(cur, lds, S);
    for (;;) {
        const bool more_pass = pass == 0, more_item = L + F.G < total, last = !more_pass && !more_item;
        int passn = pass + 1, Ln = L;
        if (!more_pass) { passn = 0; Ln = more_item ? L + F.G : L; }
        const int sn = Ln & 3;
        const swa::BlockRef nxt = last ? cur : attn_ref(F.ws, Obase, Ln >> 2, passn ? 7 - sn : sn);
        swa::block(cur, nxt, lds, S);
        if (last) break;
        cur = nxt; pass = passn; L = Ln;
    }
}
#ifdef PROBE_ATTN
__device__ __forceinline__ void ph_probe_cmp(Frame& F, const bf16* A, const bf16* B, unsigned* word) {
    const int gt = F.gw * 64 + F.lane, NGT = F.NGW * 64; float sm = 0.f;
    for (int i = gt; i < M * 512; i += NGT) { const int row = i >> 9, c = i & 511; float d = fabsf(bf2f(A[(size_t)row * DM + c]) - bf2f(B[(size_t)row * DM + c])); if (!(d == d)) d = 1000.f; sm += d; }
    sm = wave_sum(sm);
    if (F.lane == 0) atomicAdd((float*)word, sm * (1.0f / (float)(M * 512)));
}
#endif

__device__ __forceinline__ void ph_s5_frags(Frame& F) {
    const unsigned char* ws = F.ws; const double* pw = (const double*)(ws + WS_S5PW);
    const float* sc = (const float*)(ws + WS_S5C); const float* BBre = sc + 4096, *BBim = sc + 4096 + 32768;
    const float* c_re = F.in[13]; const float* c_im = F.in[14];
    bf16* Ff = (bf16*)(F.ws + WS_S5F); bf16* Gf = (bf16*)(F.ws + WS_S5G); bf16* Hf = (bf16*)(F.ws + WS_S5H);
    const int gt = F.gw * 64 + F.lane, NGT = F.NGW * 64;
    for (int i = gt; i < 32 * 32768; i += NGT) { const int g = i >> 15, r = i & 32767, ks = r >> 12, nt = (r >> 9) & 7, lane = (r >> 3) & 63, jj = r & 7, q = lane >> 4;
        const int s = 2 * ks + (q >> 1), j = 8 * (q & 1) + jj, n = 16 * nt + (lane & 15), p = n & 63;
        const double ar = pw[((size_t)(g * 17 + 15 - s) * 64 + p) * 2], ai = pw[((size_t)(g * 17 + 15 - s) * 64 + p) * 2 + 1];
        const double br = BBre[(size_t)(g * 64 + p) * 16 + j], bi = BBim[(size_t)(g * 64 + p) * 16 + j];
        Gf[i] = (bf16)f2bf((float)(n < 64 ? ar * br - ai * bi : ar * bi + ai * br)); }
    for (int i = gt; i < 32 * 32768; i += NGT) { const int g = i >> 15, r = i & 32767, k4 = r >> 13, tau = (r >> 9) & 15, lane = (r >> 3) & 63, jj = r & 7, q = lane >> 4;
        const int ci = lane & 15, k = 32 * k4 + 8 * q + jj, p = k & 63;
        const double ar = pw[((size_t)(g * 17 + tau + 1) * 64 + p) * 2], ai = pw[((size_t)(g * 17 + tau + 1) * 64 + p) * 2 + 1];
        const double cr = c_re[(size_t)(g * 16 + ci) * 64 + p], cim = c_im[(size_t)(g * 16 + ci) * 64 + p];
        Hf[i] = (bf16)f2bf((float)(k < 64 ? cr * ar - cim * ai : -(cr * ai + cim * ar))); }
    for (int i = gt; i < 32 * 8192; i += NGT) { const int g = i >> 13, r = i & 8191, d = r >> 9, lane = (r >> 3) & 63, jj = r & 7, q = lane >> 4;
        const int ci = lane & 15, lag = d - (q >> 1), j = 8 * (q & 1) + jj; double acc = 0.0;
        if (lag >= 0) for (int p = 0; p < 64; ++p) {
            const double ar = pw[((size_t)(g * 17 + lag) * 64 + p) * 2], ai = pw[((size_t)(g * 17 + lag) * 64 + p) * 2 + 1];
            const double br = BBre[(size_t)(g * 64 + p) * 16 + j], bi = BBim[(size_t)(g * 64 + p) * 16 + j];
            const double zr = ar * br - ai * bi, zi = ar * bi + ai * br;
            acc += (double)c_re[(size_t)(g * 16 + ci) * 64 + p] * zr - (double)c_im[(size_t)(g * 16 + ci) * 64 + p] * zi; }
        Ff[i] = (bf16)f2bf((float)acc); }
}
__device__ __forceinline__ void ph_conv(Frame& F) {
    const bf16* Z = (const bf16*)(F.ws + WS_Z); bf16* T2 = (bf16*)(F.ws + WS_T2);
    const float* dw = F.in[18]; const float* ln_g = F.in[19]; const float* ln_b = F.in[20];
    LAS unsigned short* cbuf = (LAS unsigned short*)(F.lds + RING_OFF);
    const int ch = F.tid;
    float dwt[31];
#pragma unroll
    for (int j = 0; j < 31; ++j) dwt[j] = dw[j * 512 + ch];
    for (int run = blockIdx.x; run < M / 128; run += F.G) {
        const int row0 = run * 128, t0 = row0 & (SEQ - 1);
        float win[31];
#pragma unroll
        for (int j = 0; j < 31; ++j) win[j] = 0.f;
        for (int base = 0; base < 186; base += 31) {
            unsigned short ra[31], rb[31];
#pragma unroll
            for (int k = 0; k < 31; ++k) { const int n = base + k, s = n - 30; ra[k] = 0; rb[k] = 0;
                if (n < 158 && t0 + s >= 0) { const bf16* zr = Z + (size_t)(row0 + s) * ODD_IN; ra[k] = zr[1024 + ch]; rb[k] = zr[1536 + ch]; } }
#pragma unroll
            for (int k = 0; k < 31; ++k) { const int n = base + k, s = n - 30;
                if (n < 158) {
                    win[k] = bf2f(ra[k]) * sigmoidf_(bf2f(rb[k]));
                    if (s >= 0) { float acc = 0.f;
#pragma unroll
                        for (int j = 0; j < 31; ++j) acc += dwt[j] * win[(k + 1 + j) % 31];
                        cbuf[s * 512 + ch] = (unsigned short)f2bf(acc); } } }
        }
        __syncthreads();
        { const int lane = F.lane; float lg[8], lb[8];
#pragma unroll
          for (int e = 0; e < 8; ++e) { lg[e] = ln_g[8 * lane + e]; lb[e] = ln_b[8 * lane + e]; }
          for (int tk = F.wave; tk < 128; tk += 8) {
              const v4u w = *(const LAS v4u*)(cbuf + tk * 512 + 8 * lane);
              float v[8]; v[0] = bflo(w.x); v[1] = bfhi(w.x); v[2] = bflo(w.y); v[3] = bfhi(w.y); v[4] = bflo(w.z); v[5] = bfhi(w.z); v[6] = bflo(w.w); v[7] = bfhi(w.w);
              float s = 0.f;
#pragma unroll
              for (int e = 0; e < 8; ++e) s += v[e];
              const float mu = wave_sum(s) * (1.f / 512.f); float qq = 0.f;
#pragma unroll
              for (int e = 0; e < 8; ++e) { v[e] -= mu; qq += v[e] * v[e]; }
              const float rstd = 1.0f / sqrtf(wave_sum(qq) * (1.f / 512.f) + EPS);
              float o[8];
#pragma unroll
              for (int e = 0; e < 8; ++e) o[e] = siluf_(v[e] * rstd * lg[e] + lb[e]);
              v4u ow; ow.x = pk2(o[0], o[1]); ow.y = pk2(o[2], o[3]); ow.z = pk2(o[4], o[5]); ow.w = pk2(o[6], o[7]);
              *(GAS v4u*)(T2 + (size_t)(row0 + tk) * 512 + 8 * lane) = ow; } }
        __syncthreads();
    }
}
typedef short s5_bf16x8 __attribute__((ext_vector_type(8)));
__device__ __forceinline__ void s5_item(Frame& F, int b, int g) {
    const bf16* Z = (const bf16*)(F.ws + WS_Z); bf16* T1 = (bf16*)(F.ws + WS_T1);
    LAS unsigned char* CST = F.lds + RING_OFF;
    LAS unsigned char* SX = F.lds + RING_OFF + 65536;
    const int w = F.wave, lane = F.lane, q = lane >> 4, cl = lane & 15, chunk = 16 * w + cl, tid = F.tid;
    { const GAS v4u* src = (const GAS v4u*)(F.ws + WS_S5G + (size_t)g * 65536);
#pragma unroll
      for (int i = 0; i < 8; ++i) *(LAS v4u*)(CST + (size_t)(i * 512 + tid) * 16) = src[i * 512 + tid]; }
    s5_bf16x8 U[8];
    { const bf16* up = Z + ((size_t)b * SEQ + (size_t)chunk * 16 + (q >> 1)) * ODD_IN + g * 16 + 8 * (q & 1);
#pragma unroll
      for (int ks = 0; ks < 8; ++ks) U[ks] = *(const s5_bf16x8*)(up + (size_t)(2 * ks) * ODD_IN); }
    __syncthreads();
#pragma unroll
    for (int nt = 0; nt < 8; ++nt) { f32x4 acc = {0.f, 0.f, 0.f, 0.f};
#pragma unroll
        for (int ks = 0; ks < 8; ++ks) { const s5_bf16x8 gf = *(const LAS s5_bf16x8*)(CST + (size_t)((ks * 8 + nt) * 64 + lane) * 16);
            acc = __builtin_amdgcn_mfma_f32_16x16x32_bf16(gf, U[ks], acc, 0, 0, 0); }
        *(LAS f32x4*)(SX + (size_t)chunk * 512 + (16 * nt + 4 * q) * 4) = acc; }
    __syncthreads();
    { const GAS v4u* src = (const GAS v4u*)(F.ws + WS_S5H + (size_t)g * 65536);
#pragma unroll
      for (int i = 0; i < 8; ++i) *(LAS v4u*)(CST + (size_t)(i * 512 + tid) * 16) = src[i * 512 + tid]; }
    if (w == 0) { const float* a16 = (const float*)(F.ws + WS_S5A16) + 2 * (g * 64 + lane); const float ar = a16[0], ai = a16[1]; float xr = 0.f, xi = 0.f;
        for (int c0 = 0; c0 < 128; c0 += 8) { float sr[8], si[8];
#pragma unroll
            for (int e = 0; e < 8; ++e) { sr[e] = *(const LAS float*)(SX + (size_t)(c0 + e) * 512 + lane * 4); si[e] = *(const LAS float*)(SX + (size_t)(c0 + e) * 512 + 256 + lane * 4); }
            LDS_WAIT(); asm volatile("" ::: "memory");
#pragma unroll
            for (int e = 0; e < 8; ++e) { *(LAS unsigned short*)(SX + (size_t)(c0 + e) * 272 + lane * 2) = (unsigned short)f2bf(xr); *(LAS unsigned short*)(SX + (size_t)(c0 + e) * 272 + 128 + lane * 2) = (unsigned short)f2bf(xi);
                const float nr = ar * xr - ai * xi + sr[e], ni = ar * xi + ai * xr + si[e]; xr = nr; xi = ni; }
            LDS_WAIT(); asm volatile("" ::: "memory"); } }
    s5_bf16x8 Fq[16];
    { const s5_bf16x8* fp = (const s5_bf16x8*)(F.ws + WS_S5F + (size_t)g * 16384) + lane;
#pragma unroll
      for (int d = 0; d < 16; ++d) Fq[d] = fp[d * 64]; }
    const f32x4 dv = *(const f32x4*)(F.in[15] + g * 16 + 4 * q);
    __syncthreads();
    s5_bf16x8 XA[4];
#pragma unroll
    for (int k4 = 0; k4 < 4; ++k4) XA[k4] = *(const LAS s5_bf16x8*)(SX + (size_t)chunk * 272 + 64 * k4 + 16 * q);
    const size_t rowc = (size_t)b * SEQ + (size_t)chunk * 16;
#pragma unroll
    for (int tau = 0; tau < 16; ++tau) { f32x4 acc = {0.f, 0.f, 0.f, 0.f};
#pragma unroll
        for (int ks = 0; ks <= tau / 2; ++ks) acc = __builtin_amdgcn_mfma_f32_16x16x32_bf16(Fq[tau - 2 * ks], U[ks], acc, 0, 0, 0);
#pragma unroll
        for (int k4 = 0; k4 < 4; ++k4) { const s5_bf16x8 hf = *(const LAS s5_bf16x8*)(CST + (size_t)((k4 * 16 + tau) * 64 + lane) * 16);
            acc = __builtin_amdgcn_mfma_f32_16x16x32_bf16(hf, XA[k4], acc, 0, 0, 0); }
        const v2u uw = *(const GAS v2u*)(Z + (rowc + tau) * ODD_IN + g * 16 + 4 * q);
        v2u ow; ow.x = pk2(acc[0] + dv[0] * bflo(uw.x), acc[1] + dv[1] * bfhi(uw.x)); ow.y = pk2(acc[2] + dv[2] * bflo(uw.y), acc[3] + dv[3] * bfhi(uw.y));
        *(GAS v2u*)(T1 + (rowc + tau) * 512 + g * 16 + 4 * q) = ow; }
    __syncthreads();
}
__device__ __forceinline__ void ph_s5(Frame& F) {
    for (int item = 2 * F.vcu; item < BATCH * 32; item += 2 * F.G) { s5_item(F, item >> 5, item & 31); s5_item(F, (item + 1) >> 5, (item + 1) & 31); }
}
struct Args { const float* in[23]; float* out; unsigned char* ws; int ph_lo, ph_hi; };
__global__ void __launch_bounds__(NWAVES * 64, 2) fwd_kernel(Args args) {
    extern __shared__ __attribute__((aligned(16))) unsigned char lds[];
    Frame F;
    F.lds = (LAS unsigned char*)lds;
    volatile LAS unsigned* MISC = (volatile LAS unsigned*)(F.lds + MISC_OFF);
    F.tid = threadIdx.x; F.lane = F.tid & 63; F.wave = __builtin_amdgcn_readfirstlane(F.tid >> 6);
    F.G = gridDim.x; { const int bx = blockIdx.x; F.vcu = (F.G % 8 == 0) ? (bx % 8) * (F.G / 8) + bx / 8 : bx; }
    F.gw = blockIdx.x * NWAVES + F.wave; F.NGW = F.G * NWAVES;
#pragma unroll
    for (int i = 0; i < 23; ++i) F.in[i] = args.in[i];
    F.out = args.out; F.ws = args.ws;
    unsigned* ctl = (unsigned*)(args.ws + WS_CTL);
    for (int u = F.tid; u < (LDS_BYTES - LDSCTL_OFF) / 4; u += NWAVES * 64) ((LAS unsigned*)(F.lds + LDSCTL_OFF))[u] = 0u;
    __syncthreads();
    XcdBarrier bar; bar.bar = ctl + CW_BAR; bar.x = 0; bar.st = nullptr;
    if (N_LAUNCHES == 1) bar = xcd_barrier_post(ctl + CW_BAR, MISC + 8);
#define GRID_BAR() do { if (N_LAUNCHES == 1) xcd_barrier(bar); } while (0)
    const int lo = args.ph_lo, hi = args.ph_hi;
#define IN(k) (lo <= (k) && (k) < hi)
#define BOTH(k) (IN(k) && IN((k) + 1))
    unsigned char* ws = args.ws;
    bf16* XN = (bf16*)(ws + WS_XN); bf16* Z = (bf16*)(ws + WS_Z); bf16* MB = (bf16*)(ws + WS_MB); bf16* Y = (bf16*)(ws + WS_Y); bf16* T1 = (bf16*)(ws + WS_T1); bf16* T2 = (bf16*)(ws + WS_T2);
    typedef pg8::EpiBf16<0> EpiP;
#define GEMM_PLAIN(Aptr, Wptr, Nn, Kk, Optr, ldc_) do { pg8::Gemm g{(const pg8::bf16_t*)(Aptr), (const pg8::bf16_t*)(Wptr), M, (Nn), (Kk)}; pg8::StaticOrder S; S.init(M, (Nn), F.G, (int)blockIdx.x); \
        EpiP E{(pg8::bf16_t*)(Optr), (ldc_), nullptr, 0, 0, 1.f}; pg8::gemm_phase<EpiP, pg8::StaticOrder, true, true>(F.lds + RING_OFF, g, S, E); } while (0)

    if (IN(0)) { ph_prologue(F); if (BOTH(0)) GRID_BAR(); }
    if (IN(1)) { ph_s5_frags(F); __syncthreads(); GEMM_PLAIN(XN, ws + WS_WIN0, EVEN_IN, 1024, Z, EVEN_IN); if (BOTH(1)) GRID_BAR(); }
    if (IN(2)) { ph_rope(F); if (BOTH(2)) GRID_BAR(); }
    if (IN(3)) { ph_kbar(F); if (BOTH(3)) GRID_BAR(); }
    #ifdef PROBE_ATTN
    if (IN(4)) { ph_attn_naive(F); __syncthreads(); ph_attn(F, Y); ph_pool_naive(F); GRID_BAR(); ph_probe_cmp(F, MB, Y, ctl + 64); if (BOTH(4)) GRID_BAR(); }
#else
    if (IN(4)) { ph_attn(F, MB); ph_pool_naive(F); if (BOTH(4)) GRID_BAR(); }
#endif
    if (IN(5)) { GEMM_PLAIN(T1, ws + WS_WPOOL, 512, 512, T2, 512); if (BOTH(5)) GRID_BAR(); }
    if (IN(6)) { ph_pool_gate(F); if (BOTH(6)) GRID_BAR(); }
    if (IN(7)) { GEMM_PLAIN(MB, ws + WS_WOUT0, 1024, 1024, Y, 1024); if (BOTH(7)) GRID_BAR(); }
    if (IN(8)) { ph_norm_res(F, F.in[0], Y, F.in[2], F.out, XN); if (BOTH(8)) GRID_BAR(); }
    if (IN(9)) { GEMM_PLAIN(XN, ws + WS_WIN1, ODD_IN, 1024, Z, ODD_IN); if (BOTH(9)) GRID_BAR(); }
    #ifdef PROBE_L1
    if (IN(10)) { ph_s5_naive(F); ph_conv_naive(F); __syncthreads(); GRID_BAR();
        { bf16* T1s = T1; bf16* T2s = T2; (void)T1s; (void)T2s; }
        ph_probe_l1(F, ctl + 64); if (BOTH(10)) GRID_BAR(); }
#else
    if (IN(10)) { ph_conv(F); ph_s5(F); if (BOTH(10)) GRID_BAR(); }
#endif
    if (IN(11)) { GEMM_PLAIN(T1, ws + WS_WGLU, 1024, 512, Y, 1024); if (BOTH(11)) GRID_BAR(); }
    if (IN(12)) { ph_glu_gate(F); if (BOTH(12)) GRID_BAR(); }
    if (IN(13)) { GEMM_PLAIN(T2, ws + WS_WPW, 512, 512, Y, 512); if (BOTH(13)) GRID_BAR(); }
    if (IN(14)) { ph_conv_gate(F); if (BOTH(14)) GRID_BAR(); }
    if (IN(15)) { GEMM_PLAIN(MB, ws + WS_WOUT1, 1024, 1024, Y, 1024); if (BOTH(15)) GRID_BAR(); }
    if (IN(16)) { ph_norm_res(F, F.out, Y, F.in[2] + 1024, F.out, nullptr); }
#ifdef PROBE_ATTN
    GRID_BAR();
    if (blockIdx.x == 0 && F.tid == 0) { const float mxd = __builtin_bit_cast(float, __hip_atomic_load(ctl + 64, __ATOMIC_RELAXED, __HIP_MEMORY_SCOPE_AGENT)); F.out[0] = 100.f + 1.0e9f * mxd; }
#endif
#undef IN
#undef BOTH
}

extern "C" void kernel_launch(void* const* d_in, const int* in_sizes, int n_in, void* d_out, int out_size, void* d_ws, size_t ws_size, hipStream_t stream) {
    static int grid = 0;
    if (grid == 0) {
        if (n_in != 23 || in_sizes[0] != M * DM || out_size != M * DM || ws_size < WS_END) { fprintf(stderr, "kernel_launch: unexpected shapes n_in %d in0 %d out %d ws %zu\n", n_in, n_in > 0 ? in_sizes[0] : -1, out_size, ws_size); grid = -1; return; }
        int dev = 0, cus = 0, per_cu = 0;
        if (hipGetDevice(&dev) != hipSuccess || hipDeviceGetAttribute(&cus, hipDeviceAttributeMultiprocessorCount, dev) != hipSuccess) { grid = -1; return; }
        if (hipFuncSetAttribute((const void*)fwd_kernel, hipFuncAttributeMaxDynamicSharedMemorySize, LDS_BYTES) != hipSuccess) { fprintf(stderr, "kernel_launch: hipFuncSetAttribute failed\n"); grid = -1; return; }
        if (hipOccupancyMaxActiveBlocksPerMultiprocessor(&per_cu, (const void*)fwd_kernel, NWAVES * 64, LDS_BYTES) != hipSuccess || per_cu < 1) fprintf(stderr, "kernel_launch: occupancy query reports %d\n", per_cu);
        (void)hipGetLastError();
        grid = cus;
    }
    if (grid < 0) return;
    (void)hipMemsetAsync((char*)d_ws + WS_CTL, 0, CTL_ZERO_BYTES, stream);
    Args a{};
    for (int i = 0; i < 23; ++i) a.in[i] = (const float*)d_in[i];
    a.out = (float*)d_out; a.ws = (unsigned char*)d_ws;
    if (N_LAUNCHES == 1) { a.ph_lo = 0; a.ph_hi = N_PHASES; hipLaunchKernelGGL(fwd_kernel, dim3(grid), dim3(NWAVES * 64), LDS_BYTES, stream, a); }
    else for (int p = 0; p < N_PHASES; ++p) { a.ph_lo = p; a.ph_hi = p + 1; hipLaunchKernelGGL(fwd_kernel, dim3(grid), dim3(NWAVES * 64), LDS_BYTES, stream, a); }
}
```

```cpp
#include <hip/hip_runtime.h>
#include <cstdio>
#include <cstdint>
#include <cmath>
#define MK_N_LAUNCHES 1
namespace pg8 {
#define PG8_LAS __attribute__((address_space(3)))
typedef unsigned short bf16_t;
typedef short bf16x8 __attribute__((ext_vector_type(8)));
typedef float f32x4 __attribute__((ext_vector_type(4)));
typedef unsigned u32x4 __attribute__((ext_vector_type(4)));
constexpr int BM = 256, BK = 64, HALF = 128, HTB = HALF * BK * 2  , STAGE_BYTES = 8 * HTB, NXCD = 8, WGM = 8;

__host__ __device__ __forceinline__ int lds_byte(int r, int c) { const int st = (r >> 4) * 2 + (c >> 5), rr = r & 15, cc = c & 31, ob = rr * 64 + cc * 2; return st * 1024 + (ob ^ (((ob >> 9) & 1) << 5)); }
__host__ __device__ __forceinline__ void stage_rc(int b, int& R, int& C) { const int st = b / 1024, sb = b % 1024, swz = sb ^ (((sb >> 9) & 1) << 5); R = (st >> 1) * 16 + swz / 64; C = (st & 1) * 32 + (swz % 64) / 2; }
__host__ __device__ __forceinline__ int perm32(int rho) { const int n = rho >> 4, i = rho & 15; return 8 * (i >> 2) + 4 * n + (i & 3); }

struct Unit { int pm, pn; };
struct Gemm { const bf16_t* A; const bf16_t* Bt; int M, N, K; int lda, ldb, kpn; };

struct StaticOrder {
    int nM, nN, nwg, G, c;
    __host__ __device__ void init(int M, int N, int G_, int c_) { nM = M / BM; nN = N / BM; nwg = nM * nN; G = G_; c = c_; }
    __host__ __device__ bool next(int i, Unit& u) const {
        const long L = (long)i * G + c; if (L >= nwg) return false;
        int wgid = (int)L; { const int q = nwg / NXCD, r = nwg % NXCD, xcd = wgid % NXCD, off = wgid / NXCD; wgid = (xcd < r ? xcd * (q + 1) : r * (q + 1) + (xcd - r) * q) + off; }
        const int nig = WGM * nN, gid = wgid / nig, fm = gid * WGM, gsz = (nM - fm) < WGM ? (nM - fm) : WGM;
        u.pm = fm + ((wgid % nig) % gsz); u.pn = (wgid % nig) / gsz; return true;
    }
    __device__ __forceinline__ void a_ready(const Unit&) const {}
    __device__ __forceinline__ void done(const Unit&) const {}
};

__device__ __forceinline__ unsigned cvt_pk_bf16(float lo, float hi) { unsigned r; asm volatile("v_cvt_pk_bf16_f32 %0, %1, %2" : "=v"(r) : "v"(lo), "v"(hi)); return r; }
typedef float f32x2 __attribute__((ext_vector_type(2)));
__device__ __forceinline__ f32x2 gelu_pk(f32x2 v) {
    const f32x2 av = __builtin_elementwise_abs(v), d = av * 0.2316418882f + 1.0f;
    f32x2 t; t.x = __builtin_amdgcn_rcpf(d.x); t.y = __builtin_amdgcn_rcpf(d.y);
    f32x2 q = t * 0.5307027145f + (-0.7265760135f); q = q * t + 0.7107068705f; q = q * t + (-0.142248368f); q = q * t + 0.127414796f; q = q * t;
    const f32x2 s = (v * v) * (-0.72134752044f);
    f32x2 e; e.x = __builtin_amdgcn_exp2f(s.x); e.y = __builtin_amdgcn_exp2f(s.y);
    const f32x2 m = v * (q * e), r = v - m;
    f32x2 o; o.x = v.x < 0.f ? m.x : r.x; o.y = v.y < 0.f ? m.y : r.y; return o;
}

template <int ACT  > struct EpiBf16 {
    static constexpr bool PERM = true, AFTER_DRAIN = false; static_assert(ACT == 0 || ACT == 1, "EpiBf16: ACT is 0 (none) or 1 (gelu_pk)");
    bf16_t* O; int ldc; const float* bias; int split_cols; size_t split_stride; float scale0;
    __device__ __forceinline__ void operator()(const f32x4 (&acc)[2][2][4][2], const Unit& u, int wr, int wc, int fr, int fq) const {
        const int row0 = u.pm * BM + wr * 64 + fr; int colt = u.pn * BM; bf16_t* base = O;
        float sc = 1.f; if (split_cols) { const int t = colt / split_cols; base += (size_t)t * split_stride; colt -= t * split_cols; if (t == 0) sc = scale0; }
        const int col0 = colt + wc * 32 + 8 * fq, bcol0 = u.pn * BM + wc * 32 + 8 * fq;
        f32x4 bv[2][2];
#pragma unroll
        for (int bj = 0; bj < 2; ++bj)
#pragma unroll
            for (int n = 0; n < 2; ++n) bv[bj][n] = bias ? *(const f32x4*)(bias + bcol0 + bj * HALF + 4 * n) : (f32x4){0.f, 0.f, 0.f, 0.f};
#pragma unroll
        for (int ai = 0; ai < 2; ++ai)
#pragma unroll
            for (int m = 0; m < 4; ++m) { bf16_t* rowp = base + (size_t)(row0 + ai * HALF + m * 16) * ldc + col0;
#pragma unroll
                for (int bj = 0; bj < 2; ++bj) { f32x4 v0 = acc[ai][bj][m][0] + bv[bj][0], v1 = acc[ai][bj][m][1] + bv[bj][1];
                    if (ACT == 1) { f32x2 a = gelu_pk((f32x2){v0[0], v0[1]}), b = gelu_pk((f32x2){v0[2], v0[3]}), c = gelu_pk((f32x2){v1[0], v1[1]}), d = gelu_pk((f32x2){v1[2], v1[3]});
                        v0 = (f32x4){a.x, a.y, b.x, b.y}; v1 = (f32x4){c.x, c.y, d.x, d.y}; }
                    v0 = v0 * sc; v1 = v1 * sc; u32x4 w; w.x = cvt_pk_bf16(v0[0], v0[1]); w.y = cvt_pk_bf16(v0[2], v0[3]); w.z = cvt_pk_bf16(v1[0], v1[1]); w.w = cvt_pk_bf16(v1[2], v1[3]);
                    *(u32x4*)(rowp + bj * HALF) = w; } }
    }
};

struct PanelStats {
    unsigned* xbuf;
    unsigned* cnt;
    unsigned* tmo;
    int ntn; float eps;
    unsigned code;
    __device__ __forceinline__ bool run(const f32x4 (&v)[2][2][4][2], const Unit& u, int wr, int wc, int fr, int fq, PG8_LAS unsigned char* lds, int wid, int lane) const {
        typedef float f32x2v __attribute__((ext_vector_type(2)));
        PG8_LAS f32x2v* P = (PG8_LAS f32x2v*)lds;
        PG8_LAS f32x2v* S = (PG8_LAS f32x2v*)(lds + 8192);
        PG8_LAS unsigned* flag = (PG8_LAS unsigned*)(lds + 8192 + 2048);
#pragma unroll
        for (int ai = 0; ai < 2; ++ai)
#pragma unroll
            for (int m = 0; m < 4; ++m) {
                float s = 0.f;
#pragma unroll
                for (int bj = 0; bj < 2; ++bj)
#pragma unroll
                    for (int n = 0; n < 2; ++n) { const f32x4 x = v[ai][bj][m][n]; s += (x[0] + x[1]) + (x[2] + x[3]); }
                s += __shfl_xor(s, 16); s += __shfl_xor(s, 32);
                const float mw = s * (1.0f / 64.0f); float q = 0.f;
#pragma unroll
                for (int bj = 0; bj < 2; ++bj)
#pragma unroll
                    for (int n = 0; n < 2; ++n) { const f32x4 d = v[ai][bj][m][n] - mw; q += (d[0] * d[0] + d[1] * d[1]) + (d[2] * d[2] + d[3] * d[3]); }
                q += __shfl_xor(q, 16); q += __shfl_xor(q, 32);
                if (fq == 0) P[(ai * HALF + wr * 64 + m * 16 + fr) * 4 + wc] = (f32x2v){mw, q};
            }
        asm volatile("s_waitcnt lgkmcnt(0)" ::: "memory"); __builtin_amdgcn_s_barrier(); asm volatile("" ::: "memory");
#if defined(BROKEN_EXCHANGE_NO_WAIT)
#warning BROKEN CONTROL BUILD: the row-statistics exchange does not wait; results are wrong by design
        if (blockIdx.x >= 64) { const long long t0_ = clock64(); while (clock64() - t0_ < 60000) __builtin_amdgcn_s_sleep(8); }
#endif
        const int row = wid * 32 + (lane & 31);
        if (lane < 32) {
            const f32x2v a = P[row * 4 + 0], b = P[row * 4 + 1], c = P[row * 4 + 2], d = P[row * 4 + 3];
            const float mt = (a.x + b.x + c.x + d.x) * 0.25f;
            const float da = a.x - mt, db = b.x - mt, dc = c.x - mt, dd = d.x - mt;
            const float m2 = (a.y + b.y) + (c.y + d.y) + 64.0f * ((da * da + db * db) + (dc * dc + dd * dd));
            unsigned long long* slot = (unsigned long long*)xbuf + ((size_t)(u.pm * BM + row) * 4 + u.pn);
            __hip_atomic_store(slot, ((unsigned long long)__float_as_uint(m2) << 32) | __float_as_uint(mt), __ATOMIC_RELAXED, __HIP_MEMORY_SCOPE_AGENT);
        }
        asm volatile("s_waitcnt vmcnt(0)" ::: "memory");
        if (lane == 0) __hip_atomic_fetch_add(cnt + 64 * u.pm, 1u, __ATOMIC_RELAXED, __HIP_MEMORY_SCOPE_AGENT);
        if (wid == 0) {
            bool dead = false; const unsigned long long t0 = __builtin_amdgcn_s_memrealtime(); const unsigned want = 8u * (unsigned)ntn;
            for (;;) {
#if defined(BROKEN_EXCHANGE_NO_WAIT)
                break;
#endif
                if ((unsigned)__builtin_amdgcn_readfirstlane(__hip_atomic_load(cnt + 64 * u.pm, __ATOMIC_RELAXED, __HIP_MEMORY_SCOPE_AGENT)) >= want) break;
                if (__builtin_amdgcn_s_memrealtime() - t0 > 2000000ull) {
                    if (lane == 0) { unsigned expect = 0u; __hip_atomic_compare_exchange_strong(tmo + 1, &expect, code | (unsigned)(u.pm & 0xff), __ATOMIC_RELAXED, __ATOMIC_RELAXED, __HIP_MEMORY_SCOPE_AGENT);
                                     __hip_atomic_store(tmo, 1u, __ATOMIC_RELAXED, __HIP_MEMORY_SCOPE_AGENT); }
                    dead = true; break; }
                __builtin_amdgcn_s_sleep(2);
            }
            __builtin_amdgcn_fence(__ATOMIC_ACQUIRE, "agent");
            if (lane == 0) flag[0] = dead ? 1u : 0u;
        }
        asm volatile("s_waitcnt vmcnt(0) lgkmcnt(0)" ::: "memory"); __builtin_amdgcn_s_barrier(); asm volatile("" ::: "memory");
        const bool bad = flag[0] != 0u;
        if (lane < 32) {
            const unsigned long long* slot = (const unsigned long long*)xbuf + (size_t)(u.pm * BM + row) * 4; float mt[4], m2[4]; float ms = 0.f;
#pragma unroll
            for (int t = 0; t < 4; ++t) { if (t < ntn) { const unsigned long long w = __hip_atomic_load(slot + t, __ATOMIC_RELAXED, __HIP_MEMORY_SCOPE_AGENT); mt[t] = __uint_as_float((unsigned)w); m2[t] = __uint_as_float((unsigned)(w >> 32)); } else { mt[t] = 0.f; m2[t] = 0.f; } ms += mt[t]; }
            const float mean = ms / (float)ntn; float q = 0.f;
#pragma unroll
            for (int t = 0; t < 4; ++t) if (t < ntn) { const float dm = mt[t] - mean; q += m2[t] + 256.0f * dm * dm; }
            S[row] = (f32x2v){mean, 1.0f / sqrtf(q / (256.0f * (float)ntn) + eps)};
        }
        asm volatile("s_waitcnt lgkmcnt(0)" ::: "memory"); __builtin_amdgcn_s_barrier(); asm volatile("" ::: "memory");
        return bad;
    }
};
struct EpiLnRes {
    static constexpr bool PERM = false, AFTER_DRAIN = true;
    const float* base; float* out; int ldc; const float* bias; PanelStats st; unsigned poison;
    __device__ __forceinline__ void fused(f32x4 (&acc)[2][2][4][2], const Unit& u, int wr, int wc, int fr, int fq, PG8_LAS unsigned char* lds, int wid, int lane) const {
        typedef float f32x2v __attribute__((ext_vector_type(2)));
        const PG8_LAS f32x2v* S = (const PG8_LAS f32x2v*)(lds + 8192);
        const int col0 = u.pn * BM + wc * 32 + 4 * fq;
#pragma unroll
        for (int bj = 0; bj < 2; ++bj)
#pragma unroll
            for (int n = 0; n < 2; ++n) { const f32x4 bv = bias ? *(const f32x4*)(bias + col0 + bj * HALF + n * 16) : (f32x4){0.f, 0.f, 0.f, 0.f};
#pragma unroll
                for (int ai = 0; ai < 2; ++ai)
#pragma unroll
                    for (int m = 0; m < 4; ++m) acc[ai][bj][m][n] += bv; }
        f32x4 pre[4][2][2];
#pragma unroll
        for (int m = 0; m < 4; ++m) { const size_t off = (size_t)(u.pm * BM + wr * 64 + m * 16 + fr) * ldc + col0;
#pragma unroll
            for (int bj = 0; bj < 2; ++bj)
#pragma unroll
                for (int n = 0; n < 2; ++n) pre[m][bj][n] = *(const f32x4*)(base + off + bj * HALF + n * 16); }
        const bool bad = st.run(acc, u, wr, wc, fr, fq, lds, wid, lane) || poison != 0u;
        const float qnan = __builtin_nanf("");
#pragma unroll
        for (int ai = 0; ai < 2; ++ai)
#pragma unroll
            for (int m = 0; m < 4; ++m) { const int r = ai * HALF + wr * 64 + m * 16 + fr; const f32x2v sr = S[r]; const size_t off = (size_t)(u.pm * BM + r) * ldc + col0;
#pragma unroll
                for (int bj = 0; bj < 2; ++bj)
#pragma unroll
                    for (int n = 0; n < 2; ++n) { const f32x4 bs = ai == 0 ? pre[m][bj][n] : *(const f32x4*)(base + off + bj * HALF + n * 16); f32x4 o = bs + (acc[ai][bj][m][n] - sr.x) * sr.y;
                        if (bad) o = (f32x4){qnan, qnan, qnan, qnan}; *(f32x4*)(out + off + bj * HALF + n * 16) = o; }
                if (m & 1) asm volatile("" ::: "memory"); }
    }
};
struct EpiLnResLn {
    static constexpr bool PERM = false, AFTER_DRAIN = true;
    const float* base; float* out; bf16_t* xn; int ldc; const float* bias; PanelStats st1, st2; unsigned poison;
    __device__ __forceinline__ void fused(f32x4 (&acc)[2][2][4][2], const Unit& u, int wr, int wc, int fr, int fq, PG8_LAS unsigned char* lds, int wid, int lane) const {
        typedef float f32x2v __attribute__((ext_vector_type(2))); typedef unsigned u32x2v __attribute__((ext_vector_type(2)));
        const PG8_LAS f32x2v* S = (const PG8_LAS f32x2v*)(lds + 8192);
        const int col0 = u.pn * BM + wc * 32 + 4 * fq;
#pragma unroll
        for (int bj = 0; bj < 2; ++bj)
#pragma unroll
            for (int n = 0; n < 2; ++n) { const f32x4 bv = bias ? *(const f32x4*)(bias + col0 + bj * HALF + n * 16) : (f32x4){0.f, 0.f, 0.f, 0.f};
#pragma unroll
                for (int ai = 0; ai < 2; ++ai)
#pragma unroll
                    for (int m = 0; m < 4; ++m) acc[ai][bj][m][n] += bv; }
        bool bad = st1.run(acc, u, wr, wc, fr, fq, lds, wid, lane) || poison != 0u;
        const float qnan = __builtin_nanf("");
#pragma unroll
        for (int ai = 0; ai < 2; ++ai)
#pragma unroll
            for (int m = 0; m < 4; ++m) { const int r = ai * HALF + wr * 64 + m * 16 + fr; const f32x2v sr = S[r]; const size_t off = (size_t)(u.pm * BM + r) * ldc + col0;
#pragma unroll
                for (int bj = 0; bj < 2; ++bj)
#pragma unroll
                    for (int n = 0; n < 2; ++n) { const f32x4 bs = *(const f32x4*)(base + off + bj * HALF + n * 16); acc[ai][bj][m][n] = bs + (acc[ai][bj][m][n] - sr.x) * sr.y; }
                asm volatile("" : "+v"(acc[ai][0][m][0]), "+v"(acc[ai][0][m][1]), "+v"(acc[ai][1][m][0]), "+v"(acc[ai][1][m][1]));
                if (m & 1) asm volatile("" ::: "memory"); }
        const bool bad1 = bad;
        bad = st2.run(acc, u, wr, wc, fr, fq, lds, wid, lane) || bad;
#pragma unroll
        for (int ai = 0; ai < 2; ++ai)
#pragma unroll
            for (int m = 0; m < 4; ++m) { const int r = ai * HALF + wr * 64 + m * 16 + fr; const f32x2v sr = S[r]; const size_t off = (size_t)(u.pm * BM + r) * ldc + col0;
#pragma unroll
                for (int bj = 0; bj < 2; ++bj)
#pragma unroll
                    for (int n = 0; n < 2; ++n) { const f32x4 x1 = acc[ai][bj][m][n]; *(f32x4*)(out + off + bj * HALF + n * 16) = bad1 ? (f32x4){qnan, qnan, qnan, qnan} : x1;
                        const f32x4 o = (x1 - sr.x) * sr.y; u32x2v w; w.x = cvt_pk_bf16(o[0], o[1]); w.y = cvt_pk_bf16(o[2], o[3]);
                        if (bad) { w.x = 0x7fc07fc0u; w.y = 0x7fc07fc0u; } *(u32x2v*)(xn + off + bj * HALF + n * 16) = w; }
                asm volatile("" ::: "memory"); }
    }
};

template <class Epi, class Sched, bool ALIGN_EPI = false, bool SP2 = false>
__device__ __forceinline__ void gemm_phase(PG8_LAS unsigned char* lds, const Gemm g, const Sched& S, const Epi& E) {
    const int tid = threadIdx.x, wid = __builtin_amdgcn_readfirstlane(tid >> 6), lane = tid & 63, wr = wid >> 2, wc = wid & 3, fr = lane & 15, fq = lane >> 4;
    const int K = g.K, nt = K / BK;
    unsigned voffA[2], voffB[2];
#pragma unroll
    for (int i = 0; i < 2; ++i) { int R, C; stage_rc(tid * 16 + i * 8192, R, C); const int Rb = Epi::PERM ? ((R & ~31) + perm32(R & 31)) : R;
        voffA[i] = (unsigned)(R * g.lda + C) * 2u; voffB[i] = (unsigned)(Rb * g.ldb + C) * 2u; }
    const size_t kstep = (size_t)(BK * 2);
    const size_t hstepA = (size_t)HALF * g.lda * 2, hstepB = (size_t)HALF * g.ldb * 2;
    const size_t tstepA = 2 * hstepA, tstepB = 2 * hstepB, kpnb = (size_t)g.kpn * 2;
    const unsigned ldsw = (unsigned)wid * 1024u;
    const int aoff = lds_byte(wr * 64 + fr, fq * 8), boff = lds_byte(wc * 32 + fr, fq * 8);
#define PG8_SA(b, h) (((b) * 2 + (h)) * HTB)
#define PG8_SB(b, h) ((4 + (b) * 2 + (h)) * HTB)
#define PG8_STAGE(bufoff, gbase, voff) do { _Pragma("unroll") for (int _i = 0; _i < 2; ++_i) \
        __builtin_amdgcn_global_load_lds((const unsigned*)((const char*)(gbase) + (voff)[_i]), (PG8_LAS unsigned*)(lds + (bufoff) + ldsw + _i * 8192), 16, 0, 0); } while (0)
#define PG8_LDA(dst, b, h) do { _Pragma("unroll") for (int m = 0; m < 4; ++m) _Pragma("unroll") for (int k = 0; k < 2; ++k) dst[m][k] = *(const PG8_LAS bf16x8*)(lds + PG8_SA(b, h) + aoff + m * 2048 + k * 1024); } while (0)
#define PG8_LDB(dst, b, h) do { _Pragma("unroll") for (int n = 0; n < 2; ++n) _Pragma("unroll") for (int k = 0; k < 2; ++k) dst[n][k] = *(const PG8_LAS bf16x8*)(lds + PG8_SB(b, h) + boff + n * 2048 + k * 1024); } while (0)
#define PG8_MMA(ai, bj, At, Bt) do { __builtin_amdgcn_s_setprio(1); _Pragma("unroll") for (int m = 0; m < 4; ++m) _Pragma("unroll") for (int n = 0; n < 2; ++n) _Pragma("unroll") for (int k = 0; k < 2; ++k) \
        acc[ai][bj][m][n] = __builtin_amdgcn_mfma_f32_16x16x32_bf16(Bt[n][k], At[m][k], acc[ai][bj][m][n], 0, 0, 0); __builtin_amdgcn_s_setprio(0); } while (0)
#define PG8_WAIT_V(n) asm volatile("s_waitcnt vmcnt(" #n ")" ::: "memory")
#define PG8_WAIT_L(n) asm volatile("s_waitcnt lgkmcnt(" #n ")" ::: "memory")
#define PG8_BAR __builtin_amdgcn_s_barrier()
#define PG8_SCHED __builtin_amdgcn_sched_barrier(0)
    Unit cur, nxt; int ui = 0;
    if (!S.next(0, cur)) return;
    f32x4 acc[2][2][4][2];
#pragma unroll
    for (int a = 0; a < 2; ++a)
#pragma unroll
        for (int b = 0; b < 2; ++b)
#pragma unroll
            for (int m = 0; m < 4; ++m)
#pragma unroll
                for (int n = 0; n < 2; ++n) acc[a][b][m][n] = (f32x4){0.f, 0.f, 0.f, 0.f};
    bf16x8 At[4][2], B0[2][2], B1[2][2];
    const char* cA = (const char*)g.A + (size_t)cur.pm * tstepA + (size_t)cur.pn * kpnb; const char* cB = (const char*)g.Bt + (size_t)cur.pn * (tstepB + kpnb);
    S.a_ready(cur);
    if constexpr (SP2) {
        PG8_STAGE(PG8_SB(0, 0), cB, voffB); PG8_STAGE(PG8_SB(0, 1), cB + hstepB, voffB); PG8_STAGE(PG8_SA(0, 0), cA, voffA); PG8_STAGE(PG8_SA(0, 1), cA + hstepA, voffA);
        if (wr == 1) PG8_BAR;
        PG8_WAIT_V(2); PG8_BAR;
        PG8_STAGE(PG8_SB(1, 0), cB + kstep, voffB); PG8_STAGE(PG8_SA(1, 0), cA + kstep, voffA); PG8_STAGE(PG8_SB(1, 1), cB + hstepB + kstep, voffB);
        PG8_WAIT_V(6); PG8_BAR;
    } else {
        PG8_STAGE(PG8_SB(0, 0), cB, voffB); PG8_STAGE(PG8_SA(0, 0), cA, voffA); PG8_STAGE(PG8_SB(0, 1), cB + hstepB, voffB); PG8_STAGE(PG8_SA(0, 1), cA + hstepA, voffA);
        if (wr == 1) PG8_BAR;
        PG8_WAIT_V(4); PG8_BAR;
        PG8_STAGE(PG8_SB(1, 0), cB + kstep, voffB); PG8_STAGE(PG8_SA(1, 0), cA + kstep, voffA); PG8_STAGE(PG8_SB(1, 1), cB + hstepB + kstep, voffB);
        PG8_WAIT_V(6); PG8_BAR;
    }
    for (;;) {
        const bool has_next = S.next(ui + 1, nxt);
        const char* nA = has_next ? (const char*)g.A + (size_t)nxt.pm * tstepA + (size_t)nxt.pn * kpnb : cA; const char* nB = has_next ? (const char*)g.Bt + (size_t)nxt.pn * (tstepB + kpnb) : cB;
        for (int t = 0; t < nt; t += 2) {
            const bool last = (t == nt - 2);
            const char* a1 = cA + (size_t)(t + 1) * kstep;
            const char* a2 = last ? nA : cA + (size_t)(t + 2) * kstep; const char* b2 = last ? nB : cB + (size_t)(t + 2) * kstep;
            const char* a3 = a2 + kstep; const char* b3 = b2 + kstep;
            if (last && has_next) S.a_ready(nxt);
            if constexpr (SP2) {
            PG8_LDB(B0, 0, 0); PG8_LDB(B1, 0, 1); PG8_SCHED; PG8_LDA(At, 0, 0); PG8_STAGE(PG8_SA(1, 1), a1 + hstepA, voffA);
            PG8_WAIT_V(8); PG8_WAIT_L(0); PG8_BAR; PG8_MMA(0, 0, At, B0); PG8_MMA(0, 1, At, B1); PG8_BAR; PG8_SCHED;
            PG8_LDA(At, 0, 1); PG8_STAGE(PG8_SB(0, 0), b2, voffB); PG8_STAGE(PG8_SB(0, 1), b2 + hstepB, voffB); PG8_STAGE(PG8_SA(0, 0), a2, voffA);
            PG8_WAIT_V(8); PG8_WAIT_L(0); PG8_BAR; PG8_MMA(1, 0, At, B0); PG8_MMA(1, 1, At, B1); PG8_BAR; PG8_SCHED;
            PG8_LDB(B0, 1, 0); PG8_LDB(B1, 1, 1); PG8_SCHED; PG8_LDA(At, 1, 0); PG8_STAGE(PG8_SA(0, 1), a2 + hstepA, voffA);
            PG8_WAIT_V(8); PG8_WAIT_L(0); PG8_BAR; PG8_MMA(0, 0, At, B0); PG8_MMA(0, 1, At, B1); PG8_BAR; PG8_SCHED;
            PG8_LDA(At, 1, 1); PG8_STAGE(PG8_SB(1, 0), b3, voffB); PG8_STAGE(PG8_SB(1, 1), b3 + hstepB, voffB); PG8_STAGE(PG8_SA(1, 0), a3, voffA);
            PG8_WAIT_V(8); PG8_WAIT_L(0); PG8_BAR; PG8_MMA(1, 0, At, B0); PG8_MMA(1, 1, At, B1); PG8_BAR; PG8_SCHED;
            } else {
            PG8_LDB(B0, 0, 0); PG8_SCHED; PG8_LDA(At, 0, 0); PG8_STAGE(PG8_SA(1, 1), a1 + hstepA, voffA);
            PG8_WAIT_L(8); PG8_BAR; PG8_WAIT_L(0); PG8_MMA(0, 0, At, B0); PG8_BAR; PG8_SCHED;
            PG8_LDB(B1, 0, 1); PG8_STAGE(PG8_SB(0, 0), b2, voffB);
            PG8_BAR; PG8_WAIT_L(0); PG8_MMA(0, 1, At, B1); PG8_BAR;
            PG8_LDA(At, 0, 1); PG8_STAGE(PG8_SA(0, 0), a2, voffA);
            PG8_BAR; PG8_WAIT_L(0); PG8_MMA(1, 0, At, B0); PG8_BAR; PG8_SCHED;
            PG8_STAGE(PG8_SB(0, 1), b2 + hstepB, voffB);
            PG8_WAIT_V(6); PG8_BAR; PG8_MMA(1, 1, At, B1); PG8_BAR;
            PG8_LDB(B0, 1, 0); PG8_SCHED; PG8_LDA(At, 1, 0); PG8_STAGE(PG8_SA(0, 1), a2 + hstepA, voffA);
            PG8_WAIT_L(8); PG8_BAR; PG8_WAIT_L(0); PG8_MMA(0, 0, At, B0); PG8_BAR; PG8_SCHED;
            PG8_LDB(B1, 1, 1); PG8_STAGE(PG8_SB(1, 0), b3, voffB);
            PG8_BAR; PG8_WAIT_L(0); PG8_MMA(0, 1, At, B1); PG8_BAR;
            PG8_LDA(At, 1, 1); PG8_STAGE(PG8_SA(1, 0), a3, voffA);
            PG8_BAR; PG8_WAIT_L(0); PG8_MMA(1, 0, At, B0); PG8_BAR; PG8_SCHED;
            PG8_STAGE(PG8_SB(1, 1), b3 + hstepB, voffB);
            PG8_WAIT_V(6); PG8_BAR; PG8_MMA(1, 1, At, B1); PG8_BAR;
            }
        }
        if constexpr (ALIGN_EPI) { if (wr == 0) PG8_BAR; }
        if constexpr (!Epi::AFTER_DRAIN) { E(acc, cur, wr, wc, fr, fq); S.done(cur); }
        if (!has_next) break;
#pragma unroll
        for (int a = 0; a < 2; ++a)
#pragma unroll
            for (int b = 0; b < 2; ++b)
#pragma unroll
                for (int m = 0; m < 4; ++m)
#pragma unroll
                    for (int n = 0; n < 2; ++n) acc[a][b][m][n] = (f32x4){0.f, 0.f, 0.f, 0.f};
        cur = nxt; cA = nA; cB = nB; ++ui;
        if constexpr (ALIGN_EPI) { if (wr == 1) PG8_BAR; }
    }
    PG8_WAIT_V(0);
    if constexpr (!ALIGN_EPI) { if (wr == 0) PG8_BAR; }
    PG8_BAR;
    if constexpr (Epi::AFTER_DRAIN) { E.fused(acc, cur, wr, wc, fr, fq, lds, wid, lane); S.done(cur); }
#undef PG8_SA
#undef PG8_SB
#undef PG8_STAGE
#undef PG8_LDA
#undef PG8_LDB
#undef PG8_MMA
#undef PG8_WAIT_V
#undef PG8_WAIT_L
#undef PG8_BAR
#undef PG8_SCHED
}
}

namespace pg8 {
__device__ __forceinline__ float e_lo(unsigned w) { return __builtin_bit_cast(float, w << 16); }
__device__ __forceinline__ float e_hi(unsigned w) { return __builtin_bit_cast(float, w & 0xffff0000u); }
__device__ __forceinline__ float e_silu(float x) { return x / (1.0f + __expf(-x)); }
__device__ __forceinline__ float e_sigm(float x) { return 1.0f / (1.0f + __expf(-x)); }
struct EpiIn0 {
    static constexpr bool PERM = true, AFTER_DRAIN = false;
    bf16_t* O; const float* rope; float* kpart;
    __device__ __forceinline__ void operator()(const f32x4 (&acc)[2][2][4][2], const Unit& u, int wr, int wc, int fr, int fq) const {
        const int row0 = u.pm * BM + wr * 64 + fr, col0 = u.pn * BM + wc * 32 + 8 * fq;
        const bool do_rope = (u.pn < 4) && (wc == 0), do_kbar = (u.pn == 2 || u.pn == 3);
        float ksum[2][8];
#pragma unroll
        for (int bj = 0; bj < 2; ++bj)
#pragma unroll
            for (int e = 0; e < 8; ++e) ksum[bj][e] = 0.f;
#pragma unroll
        for (int ai = 0; ai < 2; ++ai)
#pragma unroll
            for (int m = 0; m < 4; ++m) { const int row = row0 + ai * HALF + m * 16; bf16_t* rowp = O + (size_t)row * 3072 + col0;
                f32x4 cs[4] = {};
                if (do_rope) { const f32x4* cp = (const f32x4*)(rope + ((size_t)(row & 2047) * 16 + 8 * (fq & 1)) * 2); cs[0] = cp[0]; cs[1] = cp[1]; cs[2] = cp[2]; cs[3] = cp[3]; }
#pragma unroll
                for (int bj = 0; bj < 2; ++bj) { float v[8];
#pragma unroll
                    for (int e = 0; e < 4; ++e) { v[e] = acc[ai][bj][m][0][e]; v[4 + e] = acc[ai][bj][m][1][e]; }
                    if (do_rope) {
#pragma unroll
                        for (int e = 0; e < 8; ++e) { const float o = __shfl_xor(v[e], 32); const float c = cs[e >> 1][2 * (e & 1)], s = cs[e >> 1][2 * (e & 1) + 1];
                            v[e] = (fq < 2) ? v[e] * c - o * s : v[e] * c + o * s; } }
                    if (do_kbar) {
#pragma unroll
                        for (int e = 0; e < 8; ++e) ksum[bj][e] += v[e]; }
                    u32x4 w; w.x = cvt_pk_bf16(v[0], v[1]); w.y = cvt_pk_bf16(v[2], v[3]); w.z = cvt_pk_bf16(v[4], v[5]); w.w = cvt_pk_bf16(v[6], v[7]);
                    *(u32x4*)(rowp + bj * HALF) = w; } }
        if (do_kbar) {
#pragma unroll
            for (int bj = 0; bj < 2; ++bj)
#pragma unroll
                for (int e = 0; e < 8; ++e) { float s = ksum[bj][e]; s += __shfl_xor(s, 1); s += __shfl_xor(s, 2); s += __shfl_xor(s, 4); s += __shfl_xor(s, 8); ksum[bj][e] = s; }
            if (fr == 0) { float* kp = kpart + (size_t)(u.pm * 2 + wr) * 512 + (u.pn - 2) * BM + wc * 32 + 8 * fq;
#pragma unroll
                for (int bj = 0; bj < 2; ++bj) { *(f32x4*)(kp + bj * HALF) = (f32x4){ksum[bj][0], ksum[bj][1], ksum[bj][2], ksum[bj][3]}; *(f32x4*)(kp + bj * HALF + 4) = (f32x4){ksum[bj][4], ksum[bj][5], ksum[bj][6], ksum[bj][7]}; } } }
    }
};
struct EpiGate {
    static constexpr bool PERM = true, AFTER_DRAIN = false;
    bf16_t* O; int ldo, ooff; const bf16_t* G; int ldg, goff;
    __device__ __forceinline__ void operator()(const f32x4 (&acc)[2][2][4][2], const Unit& u, int wr, int wc, int fr, int fq) const {
        const int row0 = u.pm * BM + wr * 64 + fr, col0 = u.pn * BM + wc * 32 + 8 * fq;
#pragma unroll
        for (int ai = 0; ai < 2; ++ai)
#pragma unroll
            for (int m = 0; m < 4; ++m) { const int row = row0 + ai * HALF + m * 16;
#pragma unroll
                for (int bj = 0; bj < 2; ++bj) { const int col = col0 + bj * HALF; const u32x4 gw = *(const u32x4*)(G + (size_t)row * ldg + goff + col);
                    const f32x4 v0 = acc[ai][bj][m][0], v1 = acc[ai][bj][m][1]; u32x4 w;
                    w.x = cvt_pk_bf16(v0[0] * e_silu(e_lo(gw.x)), v0[1] * e_silu(e_hi(gw.x))); w.y = cvt_pk_bf16(v0[2] * e_silu(e_lo(gw.y)), v0[3] * e_silu(e_hi(gw.y)));
                    w.z = cvt_pk_bf16(v1[0] * e_silu(e_lo(gw.z)), v1[1] * e_silu(e_hi(gw.z))); w.w = cvt_pk_bf16(v1[2] * e_silu(e_lo(gw.w)), v1[3] * e_silu(e_hi(gw.w)));
                    *(u32x4*)(O + (size_t)row * ldo + ooff + col) = w; } }
    }
};
struct EpiGlu {
    static constexpr bool PERM = true, AFTER_DRAIN = false;
    bf16_t* O; int ldo; const bf16_t* Zg; int ldg; const float* bias;
    __device__ __forceinline__ void operator()(const f32x4 (&acc)[2][2][4][2], const Unit& u, int wr, int wc, int fr, int fq) const {
        const int row0 = u.pm * BM + wr * 64 + fr, ocol = u.pn * HALF + wc * 32 + 8 * fq;
        const f32x4 ba0 = *(const f32x4*)(bias + ocol), ba1 = *(const f32x4*)(bias + ocol + 4), bb0 = *(const f32x4*)(bias + 512 + ocol), bb1 = *(const f32x4*)(bias + 512 + ocol + 4);
#pragma unroll
        for (int ai = 0; ai < 2; ++ai)
#pragma unroll
            for (int m = 0; m < 4; ++m) { const int row = row0 + ai * HALF + m * 16; const u32x4 gw = *(const u32x4*)(Zg + (size_t)row * ldg + 512 + ocol);
                const f32x4 a0 = acc[ai][0][m][0] + ba0, a1 = acc[ai][0][m][1] + ba1, b0 = acc[ai][1][m][0] + bb0, b1 = acc[ai][1][m][1] + bb1; u32x4 w;
                w.x = cvt_pk_bf16(a0[0] * e_sigm(b0[0]) * e_silu(e_lo(gw.x)), a0[1] * e_sigm(b0[1]) * e_silu(e_hi(gw.x))); w.y = cvt_pk_bf16(a0[2] * e_sigm(b0[2]) * e_silu(e_lo(gw.y)), a0[3] * e_sigm(b0[3]) * e_silu(e_hi(gw.y)));
                w.z = cvt_pk_bf16(a1[0] * e_sigm(b1[0]) * e_silu(e_lo(gw.z)), a1[1] * e_sigm(b1[1]) * e_silu(e_hi(gw.z))); w.w = cvt_pk_bf16(a1[2] * e_sigm(b1[2]) * e_silu(e_lo(gw.w)), a1[3] * e_sigm(b1[3]) * e_silu(e_hi(gw.w)));
                *(u32x4*)(O + (size_t)row * ldo + ocol) = w; }
    }
};
struct OneUnit { int pm, pn;
    __device__ bool next(int i, Unit& u) const { if (i != 0) return false; u.pm = pm; u.pn = pn; return true; }
    __device__ __forceinline__ void a_ready(const Unit&) const {}
    __device__ __forceinline__ void done(const Unit&) const {}
};
}

constexpr int NWAVES = 8;
#ifndef MK_N_LAUNCHES
#define MK_N_LAUNCHES 1
#endif
constexpr int N_LAUNCHES = MK_N_LAUNCHES;
constexpr int N_PHASES = 10;

constexpr int BATCH = 16, SEQ = 2048, DM = 1024, M = BATCH * SEQ;
constexpr int EVEN_IN = 3072, ODD_IN = 2560;
constexpr float EPS = 1e-6f;

constexpr size_t MiB = 1u << 20;
constexpr size_t WS_CTL = 0, CTL_ZERO_BYTES = 1 * MiB;
constexpr size_t WS_WIN0 = 2 * MiB;
constexpr size_t WS_WOUT0 = 8 * MiB;
constexpr size_t WS_WIN1 = 10 * MiB;
constexpr size_t WS_WGLU = 15 * MiB;
constexpr size_t WS_WPW = 16 * MiB;
constexpr size_t WS_WPOOL = 17 * MiB;
constexpr size_t WS_WOUT1 = 18 * MiB;
constexpr size_t WS_ROPE = 20 * MiB;
constexpr size_t WS_S5C = 21 * MiB;
constexpr size_t WS_KBAR = 22 * MiB;
constexpr size_t WS_S5PW = 23 * MiB;
constexpr size_t WS_S5A16 = 24 * MiB;
constexpr size_t WS_S5F = 25 * MiB;
constexpr size_t WS_S5G = 26 * MiB;
constexpr size_t WS_S5H = 28 * MiB;
constexpr size_t WS_XN = 32 * MiB;
constexpr size_t WS_Z = 96 * MiB;
constexpr size_t WS_MB = 288 * MiB;
constexpr size_t WS_Y = 352 * MiB;
constexpr size_t WS_T1 = 416 * MiB;
constexpr size_t WS_T2 = 448 * MiB;
constexpr size_t WS_END = 480 * MiB;
constexpr int CW_BAR = 4096;

constexpr int RING_OFF = 0, RING_BYTES = 131072;
constexpr int LDSCTL_OFF = RING_BYTES, MISC_OFF = LDSCTL_OFF + 320;
constexpr int LDS_BYTES = 147456;

#define GAS __attribute__((address_space(1)))
#define LAS __attribute__((address_space(3)))
typedef unsigned short bf16;
typedef unsigned v4u __attribute__((ext_vector_type(4)));
typedef unsigned v2u __attribute__((ext_vector_type(2)));
typedef float f32x4 __attribute__((ext_vector_type(4)));
#define LDS_WAIT() asm volatile("s_waitcnt lgkmcnt(0)" ::: "memory")
#define VM_WAIT() asm volatile("s_waitcnt vmcnt(0)" ::: "memory")
__device__ __forceinline__ unsigned f2bf(float f) { unsigned u = __builtin_bit_cast(unsigned, f); return (u + 0x7fffu + ((u >> 16) & 1u)) >> 16; }
__device__ __forceinline__ unsigned pk2(float lo, float hi) { return f2bf(lo) | (f2bf(hi) << 16); }
__device__ __forceinline__ float bf2f(unsigned short v) { return __builtin_bit_cast(float, (unsigned)v << 16); }
__device__ __forceinline__ float bflo(unsigned w) { return __builtin_bit_cast(float, w << 16); }
__device__ __forceinline__ float bfhi(unsigned w) { return __builtin_bit_cast(float, w & 0xffff0000u); }
__device__ __forceinline__ float sigmoidf_(float x) { return 1.0f / (1.0f + __expf(-x)); }
__device__ __forceinline__ float siluf_(float x) { return x / (1.0f + __expf(-x)); }

#define XB_TMO      128
#define XB_XCNT(j)  (256  + 64 * (j))
#define XB_XSUB(j)  (1280 + 64 * (j))
#define XB_XGEN(j)  (2304 + 64 * (j))
#define XB_TOP      3328
#define XB_TOPGEN   3392
#define XCD_BAR_WORDS 3456
#define XB_SPIN_CAP (1u << 18)
__device__ __forceinline__ unsigned xb_ld(unsigned* p)              { return __hip_atomic_load(p, __ATOMIC_RELAXED, __HIP_MEMORY_SCOPE_AGENT); }
__device__ __forceinline__ unsigned xb_add(unsigned* p, unsigned v) { return __hip_atomic_fetch_add(p, v, __ATOMIC_RELAXED, __HIP_MEMORY_SCOPE_AGENT); }
__device__ __forceinline__ unsigned xb_xcc_id() { return (unsigned)__builtin_amdgcn_s_getreg((3 << 11) | 20) & 0xFu; }
#define XB_SPIN(cond, bar) do { unsigned _sp = 0; while (cond) { __builtin_amdgcn_s_sleep(1); \
    if ((++_sp & 255u) == 0u) { if (xb_ld(&(bar)[XB_TMO])) break; if (_sp > XB_SPIN_CAP) { atomicAdd(&(bar)[XB_TMO], 1u); break; } } } } while (0)
struct XcdBarrier { unsigned* bar; unsigned x; volatile LAS unsigned* st; };
__device__ __forceinline__ XcdBarrier xcd_barrier_post(unsigned* bar, volatile LAS unsigned* st) {
    XcdBarrier b; b.bar = bar; b.x = xb_xcc_id(); b.st = st;
    if (threadIdx.x == 0) (void)xb_add(&bar[XB_XCNT(b.x)], 1u);
    return b;
}
__device__ __forceinline__ void xcd_barrier_complete(unsigned* bar, unsigned x, unsigned& nloc, unsigned& nx) {
    const unsigned G = gridDim.x * gridDim.y * gridDim.z;
    unsigned sum, cnt, mine, sp = 0u;
    for (;;) {
        sum = 0u; cnt = 0u; mine = 0u;
#pragma unroll
        for (unsigned j = 0; j < 16; ++j) { const unsigned c = xb_ld(&bar[XB_XCNT(j)]); sum += c; cnt += (c > 0u) ? 1u : 0u; mine = (j == x) ? c : mine; }
        if (sum == G) break;
        __builtin_amdgcn_s_sleep(1);
        if ((++sp & 255u) == 0u) { if (xb_ld(&bar[XB_TMO])) break; if (sp > XB_SPIN_CAP) { atomicAdd(&bar[XB_TMO], 1u); break; } }
    }
    nloc = mine > 0u ? mine : 1u; nx = cnt > 0u ? cnt : 1u;
}
__device__ __forceinline__ void xcd_barrier(const XcdBarrier& b) {
    asm volatile("s_waitcnt vmcnt(0)" ::: "memory");
    __syncthreads();
    if (threadIdx.x == 0) {
        unsigned* bar = b.bar;
        __builtin_amdgcn_s_waitcnt(0);
        unsigned nloc = b.st[0], nx = b.st[1];
        if (nloc == 0u) { xcd_barrier_complete(bar, b.x, nloc, nx); b.st[0] = nloc; b.st[1] = nx; }
        const unsigned old = xb_add(&bar[XB_XSUB(b.x)], 1u);
        const unsigned gen = old / nloc;
        if (old + 1u == (gen + 1u) * nloc) {
            __builtin_amdgcn_fence(__ATOMIC_RELEASE, "agent");
            asm volatile("s_waitcnt vmcnt(0)" ::: "memory");
            const unsigned og = xb_add(&bar[XB_TOP], 1u);
            const unsigned tg = og / nx;
            if (og + 1u == (tg + 1u) * nx) xb_add(&bar[XB_TOPGEN], 1u);
            else XB_SPIN(xb_ld(&bar[XB_TOPGEN]) == tg, bar);
            __builtin_amdgcn_fence(__ATOMIC_ACQUIRE, "agent");
            xb_add(&bar[XB_XGEN(b.x)], 1u);
            asm volatile("s_waitcnt vmcnt(0)" ::: "memory");
        } else {
            XB_SPIN(xb_ld(&bar[XB_XGEN(b.x)]) == gen, bar);
            __builtin_amdgcn_fence(__ATOMIC_ACQUIRE, "agent");
            asm volatile("s_waitcnt vmcnt(0)" ::: "memory");
        }
    }
    __syncthreads();
}

struct Frame {
    LAS unsigned char* lds;
    int tid, lane, wave;
    int vcu, G, gw, NGW;
    const float* in[23]; float* out; unsigned char* ws;
};
__device__ __forceinline__ float wave_sum(float v) {
#pragma unroll
    for (int o = 1; o < 64; o <<= 1) v += __shfl_xor(v, o);
    return v;
}
__device__ __forceinline__ float wave_max(float v) {
#pragma unroll
    for (int o = 1; o < 64; o <<= 1) v = fmaxf(v, __shfl_xor(v, o));
    return v;
}

__device__ __forceinline__ void p0_transpose_item(const float* W, int K, int N, bf16* WT, const float* gk, LAS float* scr, int item, int lane, bool glu_perm = false) {
    const int nblk = N / 32, kb = item / nblk, nb = item % nblk, k0 = 64 * kb, n0 = 32 * nb;
#pragma unroll 8
    for (int i = 0; i < 32; ++i) { const int kk = 2 * i + (lane >> 5); float v = W[(size_t)(k0 + kk) * N + n0 + (lane & 31)]; if (gk) v *= gk[k0 + kk]; scr[kk * 33 + (lane & 31)] = v; }
    LDS_WAIT(); asm volatile("" ::: "memory");
    const int c = lane & 7;
#pragma unroll
    for (int j = 0; j < 4; ++j) { const int n = (lane >> 3) + 8 * j; const LAS float* s = scr + (8 * c) * 33 + n;
        v4u o; o.x = pk2(s[0 * 33], s[1 * 33]); o.y = pk2(s[2 * 33], s[3 * 33]); o.z = pk2(s[4 * 33], s[5 * 33]); o.w = pk2(s[6 * 33], s[7 * 33]);
        int nn = n0 + n; if (glu_perm) nn = 256 * ((nn & 511) >> 7) + 128 * (nn >> 9) + (nn & 127);
        *(GAS v4u*)(WT + (size_t)nn * K + k0 + 8 * c) = o; }
    LDS_WAIT(); asm volatile("" ::: "memory");
}

__device__ __forceinline__ void ph_prologue(Frame& F) {
    LAS float* scr = (LAS float*)(F.lds + RING_OFF + F.wave * 16384);
    unsigned char* ws = F.ws;
    const int I_IN0 = (1024 / 64) * (EVEN_IN / 32), I_SQ = (1024 / 64) * (1024 / 32), I_IN1 = (1024 / 64) * (ODD_IN / 32), I_GLU = (512 / 64) * (1024 / 32), I_PW = (512 / 64) * (512 / 32);
    const int NITEMS = I_IN0 + I_SQ + I_IN1 + I_GLU + I_PW + I_SQ;
    for (int it = F.gw; it < NITEMS; it += F.NGW) {
        int r = it;
        if (r < I_IN0) { p0_transpose_item(F.in[3], 1024, EVEN_IN, (bf16*)(ws + WS_WIN0), F.in[1], scr, r, F.lane); continue; } r -= I_IN0;
        if (r < I_SQ) { p0_transpose_item(F.in[6], 1024, 1024, (bf16*)(ws + WS_WOUT0), nullptr, scr, r, F.lane); continue; } r -= I_SQ;
        if (r < I_IN1) { p0_transpose_item(F.in[7], 1024, ODD_IN, (bf16*)(ws + WS_WIN1), F.in[1] + 1024, scr, r, F.lane); continue; } r -= I_IN1;
        if (r < I_GLU) { p0_transpose_item(F.in[16], 512, 1024, (bf16*)(ws + WS_WGLU), nullptr, scr, r, F.lane, true); continue; } r -= I_GLU;
        if (r < I_PW) { p0_transpose_item(F.in[21], 512, 512, (bf16*)(ws + WS_WPW), nullptr, scr, r, F.lane); continue; } r -= I_PW;
        p0_transpose_item(F.in[22], 1024, 1024, (bf16*)(ws + WS_WOUT1), nullptr, scr, r, F.lane);
    }
    const int gt = F.gw * 64 + F.lane, NGT = F.NGW * 64;
    { bf16* wp = (bf16*)(ws + WS_WPOOL); const float* pw = F.in[4]; const float* ps = F.in[5];
      for (int i = gt; i < 512 * 512; i += NGT) { const int n = i >> 9, k = i & 511; float v = 0.f;
          if ((n >> 7) == (k >> 7)) v = pw[(size_t)(n >> 7) * 16384 + (k & 127) * 128 + (n & 127)] * ps[n];
          wp[i] = (bf16)f2bf(v); } }
    { float* rt = (float*)(ws + WS_ROPE);
      for (int i = gt; i < SEQ * 16; i += NGT) { const int t = i >> 4, j = i & 15;
          const float inv = (float)pow(500000.0, -(double)(2 * j) / 32.0); const float ang = (float)t * inv;
          rt[2 * i] = (float)cos((double)ang); rt[2 * i + 1] = (float)sin((double)ang); } }
    { float* sc = (float*)(ws + WS_S5C); float* Lre = sc, *Lim = sc + 2048, *BBre = sc + 4096, *BBim = sc + 4096 + 32768;
      const float* lam_re = F.in[8]; const float* lam_im = F.in[9]; const float* log_dt = F.in[10]; const float* b_re = F.in[11]; const float* b_im = F.in[12];
      for (int i = gt; i < 2048; i += NGT) { const int g = i >> 6;
          const double lr = lam_re[i], li = lam_im[i], dt = exp((double)log_dt[g]);
          const double mag = exp(lr * dt), are = mag * cos(li * dt), aim = mag * sin(li * dt);
          const double den = lr * lr + li * li, nre = are - 1.0;
          const double fre = (nre * lr + aim * li) / den, fim = (aim * lr - nre * li) / den;
          Lre[i] = (float)are; Lim[i] = (float)aim;
          { double* pw = (double*)(ws + WS_S5PW); double pr = 1.0, pi = 0.0; const int p = i & 63;
            for (int e = 0; e <= 16; ++e) { pw[((size_t)(g * 17 + e) * 64 + p) * 2] = pr; pw[((size_t)(g * 17 + e) * 64 + p) * 2 + 1] = pi; const double nr = pr * are - pi * aim, ni = pr * aim + pi * are; pr = nr; pi = ni;
                if (e == 15) { float* a16 = (float*)(ws + WS_S5A16); a16[2 * i] = (float)pr; a16[2 * i + 1] = (float)pi; } } }
          for (int k = 0; k < 16; ++k) { const double br = b_re[(size_t)i * 16 + k], bi = b_im[(size_t)i * 16 + k];
              BBre[(size_t)i * 16 + k] = (float)(fre * br - fim * bi); BBim[(size_t)i * 16 + k] = (float)(fre * bi + fim * br); } } }
    { const float* x = F.in[0]; bf16* xn = (bf16*)(ws + WS_XN);
      for (int m = F.gw; m < M; m += F.NGW) {
          const GAS f32x4* xr = (const GAS f32x4*)(x + (size_t)m * DM) + F.lane;
          f32x4 v[4]; float s = 0.f;
#pragma unroll
          for (int j = 0; j < 4; ++j) { v[j] = xr[64 * j]; s += (v[j].x * v[j].x + v[j].y * v[j].y) + (v[j].z * v[j].z + v[j].w * v[j].w); }
          const float rstd = 1.0f / sqrtf(wave_sum(s) * (1.f / DM) + EPS);
          GAS v2u* o8 = (GAS v2u*)(xn + (size_t)m * DM) + F.lane;
#pragma unroll
          for (int j = 0; j < 4; ++j) { v2u w; w.x = pk2(v[j].x * rstd, v[j].y * rstd); w.y = pk2(v[j].z * rstd, v[j].w * rstd); o8[64 * j] = w; } } }
}

__device__ __forceinline__ void ph_rope(Frame& F, bf16* Z) {
    const float* rt = (const float*)(F.ws + WS_ROPE);
    const int gt = F.gw * 64 + F.lane, NGT = F.NGW * 64;
    for (int i = gt; i < M * 128; i += NGT) {
        const int row = i >> 7, r = i & 127, which = r >> 6, h = (r >> 4) & 3, j = r & 15, t = row & (SEQ - 1);
        bf16* p = Z + (size_t)row * EVEN_IN + which * 512 + h * 128 + j;
        const float x1 = bf2f(p[0]), x2 = bf2f(p[16]), c = rt[(t * 16 + j) * 2], s = rt[(t * 16 + j) * 2 + 1];
        p[0] = (bf16)f2bf(x1 * c - x2 * s); p[16] = (bf16)f2bf(x2 * c + x1 * s);
    }
}
__device__ __forceinline__ void ph_kbar(Frame& F, const bf16* Z) {
    float* kb = (float*)(F.ws + WS_S5PW);
    const int gt = F.gw * 64 + F.lane, NGT = F.NGW * 64;
    for (int i = gt; i < BATCH * 8 * 512; i += NGT) { const int bn = i >> 9, c = i & 511; float s = 0.f;
        const bf16* p = Z + (size_t)bn * 256 * EVEN_IN + 512 + c;
        for (int k = 0; k < 256; ++k) s += bf2f(p[(size_t)k * EVEN_IN]);
        kb[i] = s * (1.f / 256.f); }
}
__device__ __forceinline__ void ph_attn_naive(Frame& F) {
    const bf16* Z = (const bf16*)(F.ws + WS_Z); const float* kbar = (const float*)(F.ws + WS_KBAR); bf16* MB = (bf16*)(F.ws + WS_MB);
    LAS float* qs = (LAS float*)(F.lds + RING_OFF + F.wave * 8192); LAS float* ps = qs + 128;
    const int lane = F.lane; const float scale = 0.08838834764831845f;
    for (int item = F.gw; item < M * 4; item += F.NGW) {
        const int row = item >> 2, h = item & 3, b = row >> 11, t = row & (SEQ - 1), qblk = t >> 8;
        const bf16* zrow = Z + (size_t)row * EVEN_IN;
        qs[lane] = bf2f(zrow[h * 128 + lane]); qs[lane + 64] = bf2f(zrow[h * 128 + 64 + lane]);
        LDS_WAIT(); asm volatile("" ::: "memory");
        float gate = -INFINITY;
        if (lane < 8 && lane < qblk) { const float* kb = kbar + (size_t)(b * 8 + lane) * 512 + h * 128; float a = 0.f; for (int d = 0; d < 128; ++d) a += qs[d] * bf2f((unsigned short)f2bf(kb[d])); gate = a; }
        float gv[8];
#pragma unroll
        for (int n = 0; n < 8; ++n) gv[n] = __shfl(gate, n);
        int blk[4];
#pragma unroll
        for (int r = 0; r < 3; ++r) { int best = -1; float bv = -INFINITY;
#pragma unroll
            for (int n = 0; n < 8; ++n) if (gv[n] > bv) { bv = gv[n]; best = n; }
#pragma unroll
            for (int n = 0; n < 8; ++n) if (n == best) gv[n] = -INFINITY;
            blk[r] = best; }
        blk[3] = qblk;
        float s[4][4];
#pragma unroll
        for (int j = 0; j < 4; ++j) {
#pragma unroll
            for (int i = 0; i < 4; ++i) s[j][i] = -INFINITY;
            if (blk[j] >= 0) {
#pragma unroll
                for (int i = 0; i < 4; ++i) { const int key = blk[j] * 256 + lane + 64 * i;
                    const GAS v4u* kr = (const GAS v4u*)(Z + (size_t)(b * SEQ + key) * EVEN_IN + 512 + h * 128); float a = 0.f;
                    for (int c = 0; c < 16; ++c) { const v4u w = kr[c]; const LAS float* q8 = qs + c * 8;
                        a += q8[0] * bflo(w.x) + q8[1] * bfhi(w.x) + q8[2] * bflo(w.y) + q8[3] * bfhi(w.y) + q8[4] * bflo(w.z) + q8[5] * bfhi(w.z) + q8[6] * bflo(w.w) + q8[7] * bfhi(w.w); }
                    a *= scale; if (j == 3 && key > t) a = -INFINITY; s[j][i] = a; } } }
        float mx = -INFINITY;
#pragma unroll
        for (int j = 0; j < 4; ++j)
#pragma unroll
            for (int i = 0; i < 4; ++i) mx = fmaxf(mx, s[j][i]);
        mx = wave_max(mx);
        float sum = 0.f;
#pragma unroll
        for (int j = 0; j < 4; ++j)
#pragma unroll
            for (int i = 0; i < 4; ++i) { const float p = __expf(s[j][i] - mx); sum += p; ps[j * 256 + lane + 64 * i] = p; }
        sum = wave_sum(sum);
        LDS_WAIT(); asm volatile("" ::: "memory");
        float a0 = 0.f, a1 = 0.f;
#pragma unroll
        for (int j = 0; j < 4; ++j) if (blk[j] >= 0) { const int nk = (j == 3) ? (t & 255) + 1 : 256;
            const bf16* vb = Z + (size_t)(b * SEQ + blk[j] * 256) * EVEN_IN + 1024 + h * 128 + 2 * lane;
            for (int k = 0; k < nk; ++k) { const unsigned w = *(const GAS unsigned*)(vb + (size_t)k * EVEN_IN); const float p = ps[j * 256 + k]; a0 += p * bflo(w); a1 += p * bfhi(w); } }
        const float inv = 1.0f / sum;
        const unsigned gw2 = *(const GAS unsigned*)(zrow + 1536 + h * 128 + 2 * lane);
        const float o0 = a0 * inv * siluf_(bflo(gw2)), o1 = a1 * inv * siluf_(bfhi(gw2));
        *(GAS unsigned*)(MB + (size_t)row * DM + h * 128 + 2 * lane) = pk2(o0, o1);
        LDS_WAIT(); asm volatile("" ::: "memory");
    }
}
__device__ __forceinline__ void ph_pool_naive(Frame& F) {
    const bf16* Z = (const bf16*)(F.ws + WS_Z); bf16* T1 = (bf16*)(F.ws + WS_T1);
    const int gt = F.gw * 64 + F.lane, NGT = F.NGW * 64;
    for (int i = gt; i < M * 512; i += NGT) { const int row = i >> 9, c = i & 511, g = c >> 7, w = 2 << g, t = row & (SEQ - 1);
        const int n = (t + 1 < w) ? t + 1 : w; const bf16* p = Z + (size_t)row * EVEN_IN + 2048 + c; float s = 0.f;
        for (int k = 0; k < n; ++k) s += bf2f(*(p - (size_t)k * EVEN_IN));
        T1[i] = (bf16)f2bf(s / (float)n - bf2f(p[0])); }
}
__device__ __forceinline__ void ph_pool_gate(Frame& F) {
    const bf16* Z = (const bf16*)(F.ws + WS_Z); const bf16* T2 = (const bf16*)(F.ws + WS_T2); bf16* MB = (bf16*)(F.ws + WS_MB);
    const int gt = F.gw * 64 + F.lane, NGT = F.NGW * 64;
    for (int i = gt; i < M * 512; i += NGT) { const int row = i >> 9, c = i & 511;
        MB[(size_t)row * DM + 512 + c] = (bf16)f2bf(bf2f(T2[i]) * siluf_(bf2f(Z[(size_t)row * EVEN_IN + 2560 + c]))); }
}
__device__ __forceinline__ void ph_norm_res(Frame& F, const float* base, const bf16* Y, const float* g, float* outp, bf16* xn) {
    for (int m = F.gw; m < M; m += F.NGW) {
        const GAS v2u* yr = (const GAS v2u*)(Y + (size_t)m * DM) + F.lane;
        float y[4][4]; float s = 0.f;
#pragma unroll
        for (int j = 0; j < 4; ++j) { const v2u w = yr[64 * j]; y[j][0] = bflo(w.x); y[j][1] = bfhi(w.x); y[j][2] = bflo(w.y); y[j][3] = bfhi(w.y);
            s += (y[j][0] * y[j][0] + y[j][1] * y[j][1]) + (y[j][2] * y[j][2] + y[j][3] * y[j][3]); }
        const float rstd = 1.0f / sqrtf(wave_sum(s) * (1.f / DM) + EPS);
        const GAS f32x4* br = (const GAS f32x4*)(base + (size_t)m * DM) + F.lane; const GAS f32x4* gr = (const GAS f32x4*)g + F.lane;
        GAS f32x4* orow = (GAS f32x4*)(outp + (size_t)m * DM) + F.lane;
        f32x4 x1[4]; float s1 = 0.f;
#pragma unroll
        for (int j = 0; j < 4; ++j) { const f32x4 bv = br[64 * j], gv = gr[64 * j];
            x1[j].x = bv.x + y[j][0] * rstd * gv.x; x1[j].y = bv.y + y[j][1] * rstd * gv.y; x1[j].z = bv.z + y[j][2] * rstd * gv.z; x1[j].w = bv.w + y[j][3] * rstd * gv.w;
            orow[64 * j] = x1[j]; s1 += (x1[j].x * x1[j].x + x1[j].y * x1[j].y) + (x1[j].z * x1[j].z + x1[j].w * x1[j].w); }
        if (xn) { const float r1 = 1.0f / sqrtf(wave_sum(s1) * (1.f / DM) + EPS);
            GAS v2u* o8 = (GAS v2u*)(xn + (size_t)m * DM) + F.lane;
#pragma unroll
            for (int j = 0; j < 4; ++j) { v2u w; w.x = pk2(x1[j].x * r1, x1[j].y * r1); w.y = pk2(x1[j].z * r1, x1[j].w * r1); o8[64 * j] = w; } }
    }
}
__device__ __forceinline__ void ph_s5_naive(Frame& F) {
    const bf16* Z = (const bf16*)(F.ws + WS_Z); bf16* T1 = (bf16*)(F.ws + WS_T1);
    const float* sc = (const float*)(F.ws + WS_S5C); const float* Lre = sc, *Lim = sc + 2048, *BBre = sc + 4096, *BBim = sc + 4096 + 32768;
    const float* c_re = F.in[13]; const float* c_im = F.in[14]; const float* dvec = F.in[15];
    const int lane = F.lane;
    for (int item = F.gw; item < BATCH * 32; item += F.NGW) {
        const int b = item >> 5, g = item & 31, gp = g * 64 + lane;
        const float are = Lre[gp], aim = Lim[gp];
        float bbr[16], bbi[16], cr[16], ci[16];
#pragma unroll
        for (int i = 0; i < 16; ++i) { bbr[i] = BBre[(size_t)gp * 16 + i]; bbi[i] = BBim[(size_t)gp * 16 + i]; cr[i] = c_re[(size_t)(g * 16 + i) * 64 + lane]; ci[i] = c_im[(size_t)(g * 16 + i) * 64 + lane]; }
        const float dmine = dvec[g * 16 + (lane & 15)];
        float xr = 0.f, xi = 0.f;
        for (int t = 0; t < SEQ; ++t) {
            const size_t row = (size_t)b * SEQ + t;
            const GAS v4u* up = (const GAS v4u*)(Z + row * ODD_IN + g * 16);
            const v4u w0 = up[0], w1 = up[1];
            float u[16];
            u[0] = bflo(w0.x); u[1] = bfhi(w0.x); u[2] = bflo(w0.y); u[3] = bfhi(w0.y); u[4] = bflo(w0.z); u[5] = bfhi(w0.z); u[6] = bflo(w0.w); u[7] = bfhi(w0.w);
            u[8] = bflo(w1.x); u[9] = bfhi(w1.x); u[10] = bflo(w1.y); u[11] = bfhi(w1.y); u[12] = bflo(w1.z); u[13] = bfhi(w1.z); u[14] = bflo(w1.w); u[15] = bfhi(w1.w);
            float bur = 0.f, bui = 0.f;
#pragma unroll
            for (int i = 0; i < 16; ++i) { bur += bbr[i] * u[i]; bui += bbi[i] * u[i]; }
            const float nr = are * xr - aim * xi + bur, ni = are * xi + aim * xr + bui; xr = nr; xi = ni;
            float mine = 0.f;
#pragma unroll
            for (int i = 0; i < 16; ++i) { const float v = wave_sum(xr * cr[i] - xi * ci[i]); if ((lane & 15) == i) mine = v; }
            if (lane < 16) { const float ui = bf2f(Z[row * ODD_IN + g * 16 + lane]); T1[row * 512 + g * 16 + lane] = (bf16)f2bf(mine + dmine * ui); }
        }
    }
}
__device__ __forceinline__ void ph_conv_naive(Frame& F) {
    const bf16* Z = (const bf16*)(F.ws + WS_Z); bf16* T2 = (bf16*)(F.ws + WS_T2);
    const float* dw = F.in[18]; const float* ln_g = F.in[19]; const float* ln_b = F.in[20];
    LAS float* red = (LAS float*)(F.lds + RING_OFF);
    const int c = F.tid;
    float wt[31];
#pragma unroll
    for (int j = 0; j < 31; ++j) wt[j] = dw[j * 512 + c];
    const float lg = ln_g[c], lb = ln_b[c];
    for (int row = blockIdx.x; row < M; row += F.G) {
        const int t = row & (SEQ - 1); float acc = 0.f;
#pragma unroll
        for (int j = 0; j < 31; ++j) { const int tt = t - 30 + j;
            if (tt >= 0) { const bf16* zr = Z + (size_t)(row - 30 + j) * ODD_IN; acc += bf2f(zr[1024 + c]) * sigmoidf_(bf2f(zr[1536 + c])) * wt[j]; } }
        float s = wave_sum(acc);
        __syncthreads();
        if (F.lane == 0) red[F.wave] = s;
        __syncthreads();
        float tot = 0.f;
#pragma unroll
        for (int w = 0; w < 8; ++w) tot += red[w];
        const float mu = tot * (1.f / 512.f), dlt = acc - mu;
        float q = wave_sum(dlt * dlt);
        __syncthreads();
        if (F.lane == 0) red[F.wave] = q;
        __syncthreads();
        float qt = 0.f;
#pragma unroll
        for (int w = 0; w < 8; ++w) qt += red[w];
        const float nrm = dlt * (1.0f / sqrtf(qt * (1.f / 512.f) + EPS)) * lg + lb;
        T2[(size_t)row * 512 + c] = (bf16)f2bf(siluf_(nrm));
    }
    __syncthreads();
}
__device__ __forceinline__ void ph_glu_gate(Frame& F) {
    const bf16* Z = (const bf16*)(F.ws + WS_Z); const bf16* Y = (const bf16*)(F.ws + WS_Y); bf16* MB = (bf16*)(F.ws + WS_MB); const float* gb = F.in[17];
    const int gt = F.gw * 64 + F.lane, NGT = F.NGW * 64;
    for (int i = gt; i < M * 512; i += NGT) { const int row = i >> 9, c = i & 511;
        const float ya = bf2f(Y[(size_t)row * 1024 + c]) + gb[c], yb = bf2f(Y[(size_t)row * 1024 + 512 + c]) + gb[512 + c];
        MB[(size_t)row * DM + c] = (bf16)f2bf(ya * sigmoidf_(yb) * siluf_(bf2f(Z[(size_t)row * ODD_IN + 512 + c]))); }
}
__device__ __forceinline__ void ph_conv_gate(Frame& F) {
    const bf16* Z = (const bf16*)(F.ws + WS_Z); const bf16* Y = (const bf16*)(F.ws + WS_Y); bf16* MB = (bf16*)(F.ws + WS_MB);
    const int gt = F.gw * 64 + F.lane, NGT = F.NGW * 64;
    for (int i = gt; i < M * 512; i += NGT) { const int row = i >> 9, c = i & 511;
        MB[(size_t)row * DM + 512 + c] = (bf16)f2bf(bf2f(Y[i]) * siluf_(bf2f(Z[(size_t)row * ODD_IN + 2048 + c]))); }
}


namespace swa {
constexpr int D = 128, ZP = 3072, OP = 1024;
constexpr float SCALE = 0.08838834764831845f;
constexpr float THR = 8.f;
constexpr int NW = 8, QBLK = 32, KVBLK = 64, QB = NW * QBLK;
constexpr int SHM_V = KVBLK * D * 2, SHM_K = KVBLK * D * 2;
constexpr int LDS_BYTES = 2 * SHM_V + 2 * SHM_K + NW * 64 * 4;
using bf16 = unsigned short;
typedef short bf16x8 __attribute__((ext_vector_type(8)));
typedef short s16x4 __attribute__((ext_vector_type(4)));
typedef float f32x16 __attribute__((ext_vector_type(16)));
typedef float f32x4 __attribute__((ext_vector_type(4)));
typedef unsigned u32x4 __attribute__((ext_vector_type(4)));
#define KSWZ(row, colB) ((row) * 256 + ((colB) ^ (((row) & 7) << 4)))
#define SBAR() __builtin_amdgcn_sched_barrier(0)
__device__ __forceinline__ int v_st(int k, int c) { const int kk = (k & ~0xC) | ((k & 4) << 1) | ((k & 8) >> 1); return ((kk >> 3) * 4 + (c >> 5)) * 512 + ((kk & 7) * 32 + (c & 31)) * 2; }
__device__ __forceinline__ int v_rd_base(int lane) { return ((lane & 3) << 3) | (((lane >> 2) & 3) << 6) | (((lane >> 4) & 1) << 5) | (((lane >> 5) & 1) << 8); }
constexpr int v_rd_off(int d0, int ks, int half) { return d0 * 512 + ks * 4096 + half * 2048; }
__device__ __forceinline__ int crow(int r, int hi) { return (r & 3) + 8 * (r >> 2) + 4 * hi; }
__device__ __forceinline__ unsigned cvtpk(float lo, float hi) { unsigned r; asm volatile("v_cvt_pk_bf16_f32 %0, %1, %2" : "=v"(r) : "v"(lo), "v"(hi)); return r; }
__device__ __forceinline__ bf16x8 load8(const bf16* p) { return *reinterpret_cast<const bf16x8*>(p); }
__device__ __forceinline__ void mask_tile(f32x16& p0, f32x16& p1, int dq) {
    const float NEG = -__builtin_inff();
#pragma unroll
    for (int r = 0; r < 16; ++r) {
        const int c = (r & 3) + 8 * (r >> 2);
        if (dq - c < 0) p0[r] = NEG;
        if (dq - c - 32 < 0) p1[r] = NEG;
    }
}
__device__ __forceinline__ void partialSM(f32x16& p0, f32x16& p1, float& m_reg, float& mn, float& alpha, bool sel) {
    float pmax = p0[0]; for (int r = 1; r < 16; ++r) pmax = fmaxf(pmax, p0[r]); for (int r = 0; r < 16; ++r) pmax = fmaxf(pmax, p1[r]);
    { auto rr = __builtin_amdgcn_permlane32_swap(__float_as_uint(pmax), __float_as_uint(pmax), false, false);
      pmax = fmaxf(__uint_as_float(rr[0]), __uint_as_float(rr[1])); }
    if (!sel) pmax = -__builtin_inff();
    constexpr float C2 = 1.4426950408889634f * SCALE;
    if (__builtin_expect(__all((pmax - m_reg) * SCALE <= THR), 1)) { mn = m_reg; alpha = 1.f; }
    else { mn = fmaxf(m_reg, pmax); alpha = __builtin_amdgcn_exp2f((m_reg - mn) * C2); m_reg = mn; }
    const float mnL = sel ? -mn * C2 : -__builtin_inff();
    for (int r = 0; r < 16; ++r) p0[r] = fmaf(p0[r], C2, mnL); for (int r = 0; r < 16; ++r) p1[r] = fmaf(p1[r], C2, mnL);
    for (int r = 0; r < 16; ++r) p0[r] = __builtin_amdgcn_exp2f(p0[r]);
}
__device__ __forceinline__ void finishSM(f32x16& p0, f32x16& p1, float alpha, float& l_reg, bf16x8& pa0, bf16x8& pa1, bf16x8& pa2, bf16x8& pa3) {
    for (int r = 0; r < 16; ++r) p1[r] = __builtin_amdgcn_exp2f(p1[r]);
    float ps = 0; for (int r = 0; r < 16; ++r) ps += p0[r]; for (int r = 0; r < 16; ++r) ps += p1[r];
    { auto rr = __builtin_amdgcn_permlane32_swap(__float_as_uint(ps), __float_as_uint(ps), false, false);
      ps = __uint_as_float(rr[0]) + __uint_as_float(rr[1]); }
    l_reg = l_reg * alpha + ps;
#define PK4(P, B_, OUT) do { unsigned a0 = cvtpk(P[B_+0], P[B_+1]), a1 = cvtpk(P[B_+2], P[B_+3]);                          \
        unsigned b0 = cvtpk(P[B_+4], P[B_+5]), b1 = cvtpk(P[B_+6], P[B_+7]);                                             \
        auto r0 = __builtin_amdgcn_permlane32_swap(a0, b0, false, false); auto r1 = __builtin_amdgcn_permlane32_swap(a1, b1, false, false); \
        u32x4 w = {r0[0], r1[0], r0[1], r1[1]}; OUT = *reinterpret_cast<bf16x8*>(&w); } while (0)
    PK4(p0, 0, pa0); PK4(p0, 8, pa1); PK4(p1, 0, pa2); PK4(p1, 8, pa3);
#undef PK4
}
template <int KB>
__device__ __forceinline__ void qkt(f32x16& p0, f32x16& p1, const char* K_lds, int r32, int hi, const bf16x8* qr) {
    p0 = f32x16{}; p1 = f32x16{};
    const char* kb[4];
#pragma unroll
    for (int dd = 0; dd < 4; ++dd) kb[dd] = K_lds + KB * SHM_K + KSWZ(r32, (dd * 16 + hi * 8) * 2);
#pragma unroll
    for (int d0 = 0; d0 < 8; ++d0) { const char* a = kb[d0 & 3] + (d0 >> 2) * 128;
        bf16x8 b0 = *reinterpret_cast<const bf16x8*>(a);
        bf16x8 b1 = *reinterpret_cast<const bf16x8*>(a + 32 * 256);
        p0 = __builtin_amdgcn_mfma_f32_32x32x16_bf16(b0, qr[d0], p0, 0, 0, 0);
        p1 = __builtin_amdgcn_mfma_f32_32x32x16_bf16(b1, qr[d0], p1, 0, 0, 0); }
}
template <int VB>
__device__ __forceinline__ void pv_tile(f32x16* o, int vb0, bf16x8 pa0, bf16x8 pa1, bf16x8 pa2, bf16x8 pa3) {
#define TRRD(dst, off) asm volatile("ds_read_b64_tr_b16 %0, %1 offset:%2" : "=&v"(dst) : "v"(vb0), "i"(off) : "memory")
#define PV_D0(d0) do { s16x4 l0, l1, l2, l3, h0, h1, h2, h3; constexpr int b_ = VB * SHM_V + v_rd_off(d0, 0, 0); \
        TRRD(l0, b_); TRRD(h0, b_ + 2048); TRRD(l1, b_ + 4096); TRRD(h1, b_ + 6144); TRRD(l2, b_ + 8192); TRRD(h2, b_ + 10240); TRRD(l3, b_ + 12288); TRRD(h3, b_ + 14336); \
        asm volatile("s_waitcnt lgkmcnt(0)" ::: "memory"); SBAR();   \
        o[d0] = __builtin_amdgcn_mfma_f32_32x32x16_bf16(pa0, (bf16x8){l0[0], l0[1], l0[2], l0[3], h0[0], h0[1], h0[2], h0[3]}, o[d0], 0, 0, 0);   \
        o[d0] = __builtin_amdgcn_mfma_f32_32x32x16_bf16(pa1, (bf16x8){l1[0], l1[1], l1[2], l1[3], h1[0], h1[1], h1[2], h1[3]}, o[d0], 0, 0, 0);   \
        o[d0] = __builtin_amdgcn_mfma_f32_32x32x16_bf16(pa2, (bf16x8){l2[0], l2[1], l2[2], l2[3], h2[0], h2[1], h2[2], h2[3]}, o[d0], 0, 0, 0);   \
        o[d0] = __builtin_amdgcn_mfma_f32_32x32x16_bf16(pa3, (bf16x8){l3[0], l3[1], l3[2], l3[3], h3[0], h3[1], h3[2], h3[3]}, o[d0], 0, 0, 0); } while (0)
    PV_D0(0); PV_D0(1); PV_D0(2); PV_D0(3);
#undef PV_D0
#undef TRRD
}
struct BlockRef { const bf16* Q; const bf16* K; const bf16* V; bf16* O; const bf16* GA; const float* KBAR; int qblk; };
struct Seam { bf16x8 qr[8]; bf16x8 st_v0, st_v1, st_k0, st_k1; };
#define ROW(p, k0, rr) ((p) + (size_t)((k0) + (rr)) * ZP + sc)
#define VMW() asm volatile("s_waitcnt vmcnt(0)" ::: "memory")
#define VMWN(n) asm volatile("s_waitcnt vmcnt(%0)" :: "i"(n) : "memory")
#define SLOAD_H(Kp, Vp, k0) do { S.st_v0 = load8(ROW(Vp, k0, sr)); S.st_v1 = load8(ROW(Vp, k0, 32 + sr));              \
                         S.st_k0 = load8(ROW(Kp, k0, sr)); S.st_k1 = load8(ROW(Kp, k0, 32 + sr)); } while (0)
#define SWRITE_HK(bf) do { *(bf16x8*)(K_lds + (bf) * SHM_K + kws) = S.st_k0; *(bf16x8*)(K_lds + (bf) * SHM_K + kws + 32 * 256) = S.st_k1; } while (0)
#define SWRITE_HV(bf) do { *(bf16x8*)(V_lds + (bf) * SHM_V + vst0) = S.st_v0; *(bf16x8*)(V_lds + (bf) * SHM_V + vst1) = S.st_v1; } while (0)
#define SWRITE_H(bf) do { SWRITE_HV(bf); SWRITE_HK(bf); } while (0)
__device__ __forceinline__ void prime(const BlockRef& cur, char* lds, Seam& S) {
    const int tid = threadIdx.x, wid = __builtin_amdgcn_readfirstlane(tid >> 6), lane = tid & 63, r32 = lane & 31, hi = lane >> 5;
    const int sr = tid >> 4, sc = (tid & 15) * 8, kws = KSWZ(sr, sc * 2); char* K_lds = lds + 2 * SHM_V;
    for (int d0 = 0; d0 < 8; ++d0) S.qr[d0] = load8(cur.Q + (size_t)(wid * QBLK + r32) * ZP + d0 * 16 + hi * 8);
    SLOAD_H(cur.K, cur.V, 0); VMW(); SWRITE_HK(0);
    __syncthreads();
}
__device__ __forceinline__ unsigned select_blocks(const BlockRef& cur, const bf16x8* qr, int r32, int hi) {
    const int qblk = cur.qblk;
    f32x16 g = {};
#pragma unroll
    for (int d0 = 0; d0 < 8; ++d0) {
        bf16x8 a = {0, 0, 0, 0, 0, 0, 0, 0};
        if (r32 < 8) { const float* kp = cur.KBAR + (size_t)r32 * 1024 + d0 * 16 + hi * 8; const f32x4 x = (*(const f32x4*)kp + *(const f32x4*)(kp + 512)) * (1.f / 256.f), y = (*(const f32x4*)(kp + 4) + *(const f32x4*)(kp + 516)) * (1.f / 256.f);
            u32x4 w = {cvtpk(x[0], x[1]), cvtpk(x[2], x[3]), cvtpk(y[0], y[1]), cvtpk(y[2], y[3])}; a = *reinterpret_cast<bf16x8*>(&w); }
        g = __builtin_amdgcn_mfma_f32_32x32x16_bf16(a, qr[d0], g, 0, 0, 0);
    }
    float gv[8];
#pragma unroll
    for (int r = 0; r < 4; ++r) { auto rr = __builtin_amdgcn_permlane32_swap(__float_as_uint(g[r]), __float_as_uint(g[r]), false, false);
        gv[r] = __uint_as_float(rr[0]); gv[4 + r] = __uint_as_float(rr[1]); }
    const float NEG = -__builtin_inff();
#pragma unroll
    for (int n = 0; n < 8; ++n) if (n >= qblk) gv[n] = NEG;
    unsigned bits = 1u << qblk;
#pragma unroll
    for (int k = 0; k < 3; ++k) { int best = -1; float bv = NEG;
#pragma unroll
        for (int n = 0; n < 8; ++n) if (gv[n] > bv) { bv = gv[n]; best = n; }
#pragma unroll
        for (int n = 0; n < 8; ++n) if (n == best) gv[n] = NEG;
        if (best >= 0) bits |= 1u << best; }
    return bits;
}
__device__ __forceinline__ void block(const BlockRef& cur, const BlockRef& nxt, char* lds, Seam& S) {
    const int tid = threadIdx.x, wid = __builtin_amdgcn_readfirstlane(tid >> 6), lane = tid & 63, r32 = lane & 31, hi = lane >> 5;
    const int P0 = cur.qblk * QB;
    const int NT = 4 * cur.qblk + 4;
    const int qlo = P0 + wid * QBLK, qm = qlo + r32 - 4 * hi;
    char* V_lds = lds; char* K_lds = lds + 2 * SHM_V;
    float* ws = (float*)(lds + 2 * SHM_V + 2 * SHM_K) + wid * 64; float* li_l = ws, * al_l = ws + 32;
    float m_reg = -1e30f, l_reg = 0; f32x16 o[4] = {};
    const int sr = tid >> 4, sc = (tid & 15) * 8, vst0 = v_st(sr, sc), vst1 = v_st(32 + sr, sc), kws = KSWZ(sr, sc * 2);
    const int vb0 = (int)(uintptr_t)V_lds + v_rd_base(lane);
    const bf16* Kh = cur.K; const bf16* Vh = cur.V;
    const unsigned selbits = select_blocks(cur, S.qr, r32, hi);
#define RESC(a) do { if (__any((a) < 1.f)) { if (hi == 0) al_l[r32] = (a); asm volatile("s_waitcnt lgkmcnt(0)" ::: "memory");              \
                     for (int d_ = 0; d_ < 4; ++d_) for (int r = 0; r < 16; ++r) o[d_][r] *= al_l[crow(r, hi)]; } } while (0)
#define KBASE(t) ((t) * KVBLK)
#define SEL(t) (((selbits >> ((t) >> 2)) & 1u) != 0u)
#define MASKT(P0_, P1_, t) do { const int kb_ = KBASE(t); if (kb_ + KVBLK - 1 > qlo) mask_tile(P0_, P1_, qm - kb_); } while (0)
    constexpr int NQL = 8;
#define SEAM_K0() do { VMWN(NQL); SWRITE_HK(0); SBAR(); } while (0)
    f32x16 pA0, pA1, pB0, pB1; float mnA, mnB, alA, alB; bf16x8 pa0, pa1, pa2, pa3;
    SWRITE_HV(0); SBAR();
    if (NT > 1) { SLOAD_H(Kh, Vh, KBASE(1)); }
    SBAR(); qkt<0>(pA0, pA1, K_lds, r32, hi, S.qr);
    MASKT(pA0, pA1, 0); partialSM(pA0, pA1, m_reg, mnA, alA, SEL(0));
    if (NT > 1) { VMW(); SWRITE_H(1); }
    __syncthreads();
#define HALF_STEP(PX0, PX1, mnX, alX, PY0, PY1, alY, t, KB, VB, SB) do {                                                      \
        SBAR(); qkt<KB>(PX0, PX1, K_lds, r32, hi, S.qr);                                             \
        finishSM(PY0, PY1, alY, l_reg, pa0, pa1, pa2, pa3); SBAR();                                                           \
        if ((t) + 1 < NT) { SLOAD_H(Kh, Vh, KBASE((t) + 1)); SBAR(); }                                               \
        pv_tile<VB>(o, vb0, pa0, pa1, pa2, pa3); MASKT(PX0, PX1, (t)); partialSM(PX0, PX1, m_reg, mnX, alX, SEL(t));                                        \
        __syncthreads();                                                                                                      \
        if ((t) + 1 < NT) { VMW(); SWRITE_H(SB); }                                                                          \
        RESC(alX); __syncthreads(); } while (0)
    for (int t = 1; t + 1 < NT; t += 2) {
        HALF_STEP(pB0, pB1, mnB, alB, pA0, pA1, alA, t, 1, 0, 0);
        HALF_STEP(pA0, pA1, mnA, alA, pB0, pB1, alB, t + 1, 0, 1, 1);
    }
    { SBAR(); qkt<1>(pB0, pB1, K_lds, r32, hi, S.qr); SBAR(); }
    SLOAD_H(nxt.K, nxt.V, 0); SBAR();
#pragma unroll
    for (int d0 = 0; d0 < 8; ++d0) S.qr[d0] = load8(nxt.Q + (size_t)(wid * QBLK + r32) * ZP + d0 * 16 + hi * 8);
    SBAR();
    finishSM(pA0, pA1, alA, l_reg, pa0, pa1, pa2, pa3); SBAR();
    pv_tile<0>(o, vb0, pa0, pa1, pa2, pa3);
    { MASKT(pB0, pB1, NT - 1); partialSM(pB0, pB1, m_reg, mnB, alB, SEL(NT - 1)); __syncthreads(); RESC(alB);
      finishSM(pB0, pB1, alB, l_reg, pa0, pa1, pa2, pa3); SBAR(); pv_tile<1>(o, vb0, pa0, pa1, pa2, pa3); }
    SBAR(); SEAM_K0();
    if (hi == 0) li_l[r32] = l_reg; asm volatile("s_waitcnt lgkmcnt(0)" ::: "memory");
    float rli[16];
#pragma unroll
    for (int r = 0; r < 16; ++r) rli[r] = __builtin_amdgcn_rcpf(li_l[crow(r, hi)]);
    int hi2 = hi, r2 = r32; asm volatile("" : "+v"(hi2), "+v"(r2));
    bf16* Ow = cur.O + (size_t)(wid * QBLK + 4 * hi2) * OP + r2; const bf16* Gw = cur.GA + (size_t)(wid * QBLK + 4 * hi2) * ZP + r2;
#pragma unroll
    for (int r = 0; r < 16; ++r) { const int orow = (r & 3) + 8 * (r >> 2);
#pragma unroll
        for (int d0 = 0; d0 < 4; ++d0) { const float gat = __builtin_bit_cast(float, (unsigned)Gw[(size_t)orow * ZP + d0 * 32] << 16);
            const float v = o[d0][r] * rli[r] * (gat / (1.0f + __expf(-gat)));
            const float vn = __shfl_xor(v, 1);
            if ((r2 & 1) == 0) *(unsigned*)(Ow + (size_t)orow * OP + d0 * 32) = cvtpk(v, vn); } }
    __syncthreads();
#undef RESC
#undef KBASE
#undef SEL
#undef MASKT
#undef SEAM_K0
#undef HALF_STEP
}
#undef ROW
#undef VMW
#undef VMWN
#undef SLOAD_H
#undef SWRITE_HK
#undef SWRITE_HV
#undef SWRITE_H
#undef KSWZ
#undef SBAR
}

__device__ __forceinline__ swa::BlockRef attn_ref(unsigned char* ws, bf16* Obase, int bh, int qblk) {
    const int b = bh >> 2, h = bh & 3; const bf16* Z = (const bf16*)(ws + WS_Z);
    swa::BlockRef r; const size_t row0 = (size_t)b * SEQ + (size_t)qblk * 256;
    r.Q = Z + row0 * EVEN_IN + h * 128; r.K = Z + (size_t)b * SEQ * EVEN_IN + 512 + h * 128; r.V = Z + (size_t)b * SEQ * EVEN_IN + 1024 + h * 128;
    r.GA = Z + row0 * EVEN_IN + 1536 + h * 128; r.O = Obase + row0 * DM + h * 128;
    r.KBAR = (const float*)(ws + WS_KBAR) + (size_t)b * 8 * 1024 + h * 128; r.qblk = qblk; return r;
}
__device__ __forceinline__ void ph_attn(Frame& F, bf16* Obase) {
    char* lds = (char*)F.lds + RING_OFF;
    const int total = BATCH * 4 * 4;
    int L = F.vcu; if (L >= total) return;
    int pass = 0;
    swa::BlockRef cur = attn_ref(F.ws, Obase, L >> 2, L & 3);
    swa::Seam S;
    swa::prime(cur, lds, S);
    for (;;) {
        const bool more_pass = pass == 0, more_item = L + F.G < total, last = !more_pass && !more_item;
        int passn = pass + 1, Ln = L;
        if (!more_pass) { passn = 0; Ln = more_item ? L + F.G : L; }
        const int sn = Ln & 3;
        const swa::BlockRef nxt = last ? cur : attn_ref(F.ws, Obase, Ln >> 2, passn ? 7 - sn : sn);
        swa::block(cur, nxt, lds, S);
        if (last) break;
        cur = nxt; pass = passn; L = Ln;
    }
}
#ifdef PROBE_ATTN
__device__ __forceinline__ void ph_probe_cmp(Frame& F, const bf16* A, const bf16* B, unsigned* word) {
    const int gt = F.gw * 64 + F.lane, NGT = F.NGW * 64; float sm = 0.f;
    for (int i = gt; i < M * 512; i += NGT) { const int row = i >> 9, c = i & 511; float d = fabsf(bf2f(A[(size_t)row * DM + c]) - bf2f(B[(size_t)row * DM + c])); if (!(d == d)) d = 1000.f; sm += d; }
    sm = wave_sum(sm);
    if (F.lane == 0) atomicAdd((float*)word, sm * (1.0f / (float)(M * 512)));
}
#endif

__device__ __forceinline__ void ph_s5_frags(Frame& F) {
    const unsigned char* ws = F.ws; const double* pw = (const double*)(ws + WS_S5PW);
    const float* sc = (const float*)(ws + WS_S5C); const float* BBre = sc + 4096, *BBim = sc + 4096 + 32768;
    const float* c_re = F.in[13]; const float* c_im = F.in[14];
    bf16* Ff = (bf16*)(F.ws + WS_S5F); bf16* Gf = (bf16*)(F.ws + WS_S5G); bf16* Hf = (bf16*)(F.ws + WS_S5H);
    const int gt = F.gw * 64 + F.lane, NGT = F.NGW * 64;
    for (int i = gt; i < 32 * 32768; i += NGT) { const int g = i >> 15, r = i & 32767, ks = r >> 12, nt = (r >> 9) & 7, lane = (r >> 3) & 63, jj = r & 7, q = lane >> 4;
        const int s = 2 * ks + (q >> 1), j = 8 * (q & 1) + jj, n = 16 * nt + (lane & 15), p = n & 63;
        const double ar = pw[((size_t)(g * 17 + 15 - s) * 64 + p) * 2], ai = pw[((size_t)(g * 17 + 15 - s) * 64 + p) * 2 + 1];
        const double br = BBre[(size_t)(g * 64 + p) * 16 + j], bi = BBim[(size_t)(g * 64 + p) * 16 + j];
        Gf[i] = (bf16)f2bf((float)(n < 64 ? ar * br - ai * bi : ar * bi + ai * br)); }
    for (int i = gt; i < 32 * 32768; i += NGT) { const int g = i >> 15, r = i & 32767, k4 = r >> 13, tau = (r >> 9) & 15, lane = (r >> 3) & 63, jj = r & 7, q = lane >> 4;
        const int ci = lane & 15, k = 32 * k4 + 8 * q + jj, p = k & 63;
        const double ar = pw[((size_t)(g * 17 + tau + 1) * 64 + p) * 2], ai = pw[((size_t)(g * 17 + tau + 1) * 64 + p) * 2 + 1];
        const double cr = c_re[(size_t)(g * 16 + ci) * 64 + p], cim = c_im[(size_t)(g * 16 + ci) * 64 + p];
        Hf[i] = (bf16)f2bf((float)(k < 64 ? cr * ar - cim * ai : -(cr * ai + cim * ar))); }
    for (int i = gt; i < 32 * 8192; i += NGT) { const int g = i >> 13, r = i & 8191, d = r >> 9, lane = (r >> 3) & 63, jj = r & 7, q = lane >> 4;
        const int ci = lane & 15, lag = d - (q >> 1), j = 8 * (q & 1) + jj; double acc = 0.0;
        if (lag >= 0) for (int p = 0; p < 64; ++p) {
            const double ar = pw[((size_t)(g * 17 + lag) * 64 + p) * 2], ai = pw[((size_t)(g * 17 + lag) * 64 + p) * 2 + 1];
            const double br = BBre[(size_t)(g * 64 + p) * 16 + j], bi = BBim[(size_t)(g * 64 + p) * 16 + j];
            const double zr = ar * br - ai * bi, zi = ar * bi + ai * br;
            acc += (double)c_re[(size_t)(g * 16 + ci) * 64 + p] * zr - (double)c_im[(size_t)(g * 16 + ci) * 64 + p] * zi; }
        Ff[i] = (bf16)f2bf((float)acc); }
}
__device__ __forceinline__ void ph_conv(Frame& F) {
    const bf16* Z = (const bf16*)(F.ws + WS_Z); bf16* T2 = (bf16*)(F.ws + WS_T2);
    const float* dw = F.in[18]; const float* ln_g = F.in[19]; const float* ln_b = F.in[20];
    LAS unsigned short* cbuf = (LAS unsigned short*)(F.lds + RING_OFF);
    const int ch = F.tid;
    float dwt[31];
#pragma unroll
    for (int j = 0; j < 31; ++j) dwt[j] = dw[j * 512 + ch];
    for (int run = blockIdx.x; run < M / 128; run += F.G) {
        const int row0 = run * 128, t0 = row0 & (SEQ - 1);
        float win[31];
#pragma unroll
        for (int j = 0; j < 31; ++j) win[j] = 0.f;
        for (int base = 0; base < 186; base += 31) {
            unsigned short ra[31], rb[31];
#pragma unroll
            for (int k = 0; k < 31; ++k) { const int n = base + k, s = n - 30; ra[k] = 0; rb[k] = 0;
                if (n < 158 && t0 + s >= 0) { const bf16* zr = Z + (size_t)(row0 + s) * ODD_IN; ra[k] = zr[1024 + ch]; rb[k] = zr[1536 + ch]; } }
#pragma unroll
            for (int k = 0; k < 31; ++k) { const int n = base + k, s = n - 30;
                if (n < 158) {
                    win[k] = bf2f(ra[k]) * sigmoidf_(bf2f(rb[k]));
                    if (s >= 0) { float acc = 0.f;
#pragma unroll
                        for (int j = 0; j < 31; ++j) acc += dwt[j] * win[(k + 1 + j) % 31];
                        cbuf[s * 512 + ch] = (unsigned short)f2bf(acc); } } }
        }
        __syncthreads();
        { const int lane = F.lane; float lg[8], lb[8];
#pragma unroll
          for (int e = 0; e < 8; ++e) { lg[e] = ln_g[8 * lane + e]; lb[e] = ln_b[8 * lane + e]; }
          for (int tk = F.wave; tk < 128; tk += 8) {
              const v4u w = *(const LAS v4u*)(cbuf + tk * 512 + 8 * lane);
              float v[8]; v[0] = bflo(w.x); v[1] = bfhi(w.x); v[2] = bflo(w.y); v[3] = bfhi(w.y); v[4] = bflo(w.z); v[5] = bfhi(w.z); v[6] = bflo(w.w); v[7] = bfhi(w.w);
              float s = 0.f;
#pragma unroll
              for (int e = 0; e < 8; ++e) s += v[e];
              const float mu = wave_sum(s) * (1.f / 512.f); float qq = 0.f;
#pragma unroll
              for (int e = 0; e < 8; ++e) { v[e] -= mu; qq += v[e] * v[e]; }
              const float rstd = 1.0f / sqrtf(wave_sum(qq) * (1.f / 512.f) + EPS);
              float o[8];
#pragma unroll
              for (int e = 0; e < 8; ++e) o[e] = siluf_(v[e] * rstd * lg[e] + lb[e]);
              v4u ow; ow.x = pk2(o[0], o[1]); ow.y = pk2(o[2], o[3]); ow.z = pk2(o[4], o[5]); ow.w = pk2(o[6], o[7]);
              *(GAS v4u*)(T2 + (size_t)(row0 + tk) * 512 + 8 * lane) = ow; } }
        __syncthreads();
    }
}
typedef short s5_bf16x8 __attribute__((ext_vector_type(8)));
__device__ __forceinline__ void s5_item(Frame& F, int b, int g) {
    const bf16* Z = (const bf16*)(F.ws + WS_Z); bf16* T1 = (bf16*)(F.ws + WS_T1);
    LAS unsigned char* CST = F.lds + RING_OFF;
    LAS unsigned char* SX = F.lds + RING_OFF + 65536;
    int tid = F.tid; asm volatile("" : "+v"(tid));
    const int w = F.wave, lane = tid & 63, q = lane >> 4, cl = lane & 15, chunk = 16 * w + cl;
    { const GAS v4u* src = (const GAS v4u*)(F.ws + WS_S5G + (size_t)g * 65536);
#pragma unroll
      for (int i = 0; i < 8; ++i) *(LAS v4u*)(CST + (size_t)(i * 512 + tid) * 16) = src[i * 512 + tid]; }
    s5_bf16x8 U[8];
    { const bf16* up = Z + ((size_t)b * SEQ + (size_t)chunk * 16 + (q >> 1)) * ODD_IN + g * 16 + 8 * (q & 1);
#pragma unroll
      for (int ks = 0; ks < 8; ++ks) U[ks] = *(const s5_bf16x8*)(up + (size_t)(2 * ks) * ODD_IN); }
    __syncthreads();
#pragma unroll
    for (int nt = 0; nt < 8; ++nt) { f32x4 acc = {0.f, 0.f, 0.f, 0.f};
#pragma unroll
        for (int ks = 0; ks < 8; ++ks) { const s5_bf16x8 gf = *(const LAS s5_bf16x8*)(CST + (size_t)((ks * 8 + nt) * 64 + lane) * 16);
            acc = __builtin_amdgcn_mfma_f32_16x16x32_bf16(gf, U[ks], acc, 0, 0, 0); }
        *(LAS f32x4*)(SX + (size_t)chunk * 512 + (16 * nt + 4 * q) * 4) = acc; }
    __syncthreads();
    { const GAS v4u* src = (const GAS v4u*)(F.ws + WS_S5H + (size_t)g * 65536);
#pragma unroll
      for (int i = 0; i < 8; ++i) *(LAS v4u*)(CST + (size_t)(i * 512 + tid) * 16) = src[i * 512 + tid]; }
    if (w == 0) { const float* a16 = (const float*)(F.ws + WS_S5A16) + 2 * (g * 64 + lane); const float ar = a16[0], ai = a16[1]; float xr = 0.f, xi = 0.f;
        for (int c0 = 0; c0 < 128; c0 += 8) { float sr[8], si[8];
#pragma unroll
            for (int e = 0; e < 8; ++e) { sr[e] = *(const LAS float*)(SX + (size_t)(c0 + e) * 512 + lane * 4); si[e] = *(const LAS float*)(SX + (size_t)(c0 + e) * 512 + 256 + lane * 4); }
            LDS_WAIT(); asm volatile("" ::: "memory");
#pragma unroll
            for (int e = 0; e < 8; ++e) { *(LAS unsigned short*)(SX + (size_t)(c0 + e) * 272 + lane * 2) = (unsigned short)f2bf(xr); *(LAS unsigned short*)(SX + (size_t)(c0 + e) * 272 + 128 + lane * 2) = (unsigned short)f2bf(xi);
                const float nr = ar * xr - ai * xi + sr[e], ni = ar * xi + ai * xr + si[e]; xr = nr; xi = ni; }
            LDS_WAIT(); asm volatile("" ::: "memory"); } }
    s5_bf16x8 Fq[16];
    { const s5_bf16x8* fp = (const s5_bf16x8*)(F.ws + WS_S5F + (size_t)g * 16384) + lane;
#pragma unroll
      for (int d = 0; d < 16; ++d) Fq[d] = fp[d * 64]; }
    const f32x4 dv = *(const f32x4*)(F.in[15] + g * 16 + 4 * q);
    __syncthreads();
    s5_bf16x8 XA[4];
#pragma unroll
    for (int k4 = 0; k4 < 4; ++k4) XA[k4] = *(const LAS s5_bf16x8*)(SX + (size_t)chunk * 272 + 64 * k4 + 16 * q);
    const size_t rowc = (size_t)b * SEQ + (size_t)chunk * 16;
#pragma unroll
    for (int tau = 0; tau < 16; ++tau) { f32x4 acc = {0.f, 0.f, 0.f, 0.f};
#pragma unroll
        for (int ks = 0; ks <= tau / 2; ++ks) acc = __builtin_amdgcn_mfma_f32_16x16x32_bf16(Fq[tau - 2 * ks], U[ks], acc, 0, 0, 0);
#pragma unroll
        for (int k4 = 0; k4 < 4; ++k4) { const s5_bf16x8 hf = *(const LAS s5_bf16x8*)(CST + (size_t)((k4 * 16 + tau) * 64 + lane) * 16);
            acc = __builtin_amdgcn_mfma_f32_16x16x32_bf16(hf, XA[k4], acc, 0, 0, 0); }
        const v2u uw = *(const GAS v2u*)(Z + (rowc + tau) * ODD_IN + g * 16 + 4 * q);
        v2u ow; ow.x = pk2(acc[0] + dv[0] * bflo(uw.x), acc[1] + dv[1] * bfhi(uw.x)); ow.y = pk2(acc[2] + dv[2] * bflo(uw.y), acc[3] + dv[3] * bfhi(uw.y));
        *(GAS v2u*)(T1 + (rowc + tau) * 512 + g * 16 + 4 * q) = ow; }
    __syncthreads();
}
__device__ __forceinline__ void ph_s5(Frame& F) {
    for (int item = 2 * F.vcu; item < BATCH * 32; item += 2 * F.G) { s5_item(F, item >> 5, item & 31); s5_item(F, (item + 1) >> 5, (item + 1) & 31); }
}

__device__ __forceinline__ void pool_features(Frame& F, int pm, int pn) {
    const bf16* Z = (const bf16*)(F.ws + WS_Z); bf16* T1 = (bf16*)(F.ws + WS_T1);
    int ptid = F.tid; asm volatile("" : "+v"(ptid));
    const int col = ptid & 255, half = ptid >> 8, c = 256 * pn + col, w = 2 << (c >> 7);
    const int r0 = 256 * pm + 128 * half, t0 = r0 & (SEQ - 1);
    const bf16* p = Z + (size_t)r0 * EVEN_IN + 2048 + c; bf16* o = T1 + (size_t)r0 * 512 + c;
    float acc = 0.f;
    for (int k = 1; k < w; ++k) if (t0 - k >= 0) acc += bf2f(*(p - (size_t)k * EVEN_IN));
#pragma unroll 8
    for (int i = 0; i < 128; ++i) { const int t = t0 + i; const float x = bf2f(p[(size_t)i * EVEN_IN]); acc += x;
        const int n = (t + 1 < w) ? t + 1 : w;
        o[(size_t)i * 512] = (bf16)f2bf(acc / (float)n - x);
        if (t - w + 1 >= 0) acc -= bf2f(*(p + (ptrdiff_t)(i - w + 1) * EVEN_IN)); }
}

#ifdef PROBE_ROPE
__device__ __forceinline__ void ph_probe_rope(Frame& F, unsigned* word) {
    const bf16* Z = (const bf16*)(F.ws + WS_Z); const bf16* Z2 = (const bf16*)(F.ws + WS_MB); const float* kb2 = (const float*)(F.ws + WS_S5PW); const float* kp = (const float*)(F.ws + WS_KBAR);
    const int gt = F.gw * 64 + F.lane, NGT = F.NGW * 64; float sm = 0.f;
    for (size_t i = gt; i < (size_t)M * EVEN_IN; i += NGT) { float d = fabsf(bf2f(Z[i]) - bf2f(Z2[i])); if (!(d == d)) d = 1000.f; sm += d; }
    sm = wave_sum(sm) * (1.0f / ((float)M * (float)EVEN_IN));
    float s2 = 0.f;
    for (int i = gt; i < BATCH * 8 * 512; i += NGT) { const int bn = i >> 9, c = i & 511; float d = fabsf(kb2[i] - (kp[(size_t)bn * 1024 + c] + kp[(size_t)bn * 1024 + 512 + c]) * (1.f / 256.f)); if (!(d == d)) d = 1000.f; s2 += d; }
    s2 = wave_sum(s2) * (1.0f / (float)(BATCH * 8 * 512));
    if (F.lane == 0) atomicAdd((float*)word, sm + s2);
}
#endif
struct Args { const float* in[23]; float* out; unsigned char* ws; int ph_lo, ph_hi; };
__global__ void __launch_bounds__(NWAVES * 64, 2) fwd_kernel(Args args) {
    extern __shared__ __attribute__((aligned(16))) unsigned char lds[];
    Frame F;
    F.lds = (LAS unsigned char*)lds;
    volatile LAS unsigned* MISC = (volatile LAS unsigned*)(F.lds + MISC_OFF);
    F.tid = threadIdx.x; F.lane = F.tid & 63; F.wave = __builtin_amdgcn_readfirstlane(F.tid >> 6);
    F.G = gridDim.x; { const int bx = blockIdx.x; F.vcu = (F.G % 8 == 0) ? (bx % 8) * (F.G / 8) + bx / 8 : bx; }
    F.gw = blockIdx.x * NWAVES + F.wave; F.NGW = F.G * NWAVES;
#pragma unroll
    for (int i = 0; i < 23; ++i) F.in[i] = args.in[i];
    F.out = args.out; F.ws = args.ws;
    unsigned* ctl = (unsigned*)(args.ws + WS_CTL);
    { int zt = F.tid; asm volatile("" : "+v"(zt)); for (int u = zt; u < (LDS_BYTES - LDSCTL_OFF) / 4; u += NWAVES * 64) ((LAS unsigned*)(F.lds + LDSCTL_OFF))[u] = 0u; }
    __syncthreads();
    XcdBarrier bar; bar.bar = ctl + CW_BAR; bar.x = 0; bar.st = nullptr;
    if (N_LAUNCHES == 1) bar = xcd_barrier_post(ctl + CW_BAR, MISC + 8);
#define GRID_BAR() do { if (N_LAUNCHES == 1) xcd_barrier(bar); } while (0)
#define REFRESH() do { int t_ = threadIdx.x; asm volatile("" : "+v"(t_)); F.tid = t_; F.lane = t_ & 63; } while (0)
    const int lo = args.ph_lo, hi = args.ph_hi;
#define IN(k) (lo <= (k) && (k) < hi)
#define BOTH(k) (IN(k) && IN((k) + 1))
    unsigned char* ws = args.ws;
    bf16* XN = (bf16*)(ws + WS_XN); bf16* Z = (bf16*)(ws + WS_Z); bf16* MB = (bf16*)(ws + WS_MB); bf16* Y = (bf16*)(ws + WS_Y); bf16* T1 = (bf16*)(ws + WS_T1); bf16* T2 = (bf16*)(ws + WS_T2);
    typedef pg8::EpiBf16<0> EpiP;
#define GEMM_PLAIN(Aptr, Wptr, Nn, Kk, Optr, ldc_) do { pg8::Gemm g{(const pg8::bf16_t*)(Aptr), (const pg8::bf16_t*)(Wptr), M, (Nn), (Kk), (Kk), (Kk), 0}; pg8::StaticOrder S; S.init(M, (Nn), F.G, (int)blockIdx.x); \
        EpiP E{(pg8::bf16_t*)(Optr), (ldc_), nullptr, 0, 0, 1.f}; pg8::gemm_phase<EpiP, pg8::StaticOrder, true, true>(F.lds + RING_OFF, g, S, E); } while (0)

    if (IN(0)) { REFRESH(); ph_prologue(F); if (BOTH(0)) GRID_BAR(); }
    if (IN(1)) { REFRESH(); ph_s5_frags(F); __syncthreads();
        { pg8::Gemm g{(const pg8::bf16_t*)XN, (const pg8::bf16_t*)(ws + WS_WIN0), M, EVEN_IN, 1024, 1024, 1024, 0}; pg8::StaticOrder S; S.init(M, EVEN_IN, F.G, (int)blockIdx.x);
          pg8::EpiIn0 E{(pg8::bf16_t*)Z, (const float*)(ws + WS_ROPE), (float*)(ws + WS_KBAR)}; pg8::gemm_phase<pg8::EpiIn0, pg8::StaticOrder, true, true>(F.lds + RING_OFF, g, S, E); }
#ifdef PROBE_ROPE
        GRID_BAR(); GEMM_PLAIN(XN, ws + WS_WIN0, EVEN_IN, 1024, MB, EVEN_IN); GRID_BAR(); ph_rope(F, MB); GRID_BAR(); ph_kbar(F, MB); GRID_BAR(); ph_probe_rope(F, ctl + 64);
#endif
        if (BOTH(1)) GRID_BAR(); }
    if (IN(2)) { REFRESH();
        for (int v0 = F.vcu; v0 < 256; v0 += F.G) { int v = v0; asm volatile("" : "+s"(v)); pool_features(F, v >> 1, v & 1); VM_WAIT(); __syncthreads();
            pg8::Gemm g{(const pg8::bf16_t*)T1, (const pg8::bf16_t*)(ws + WS_WPOOL), M, 512, 256, 512, 512, 256}; pg8::OneUnit S{v >> 1, v & 1};
            pg8::EpiGate E{(pg8::bf16_t*)MB, 1024, 512, (const pg8::bf16_t*)Z, EVEN_IN, 2560}; pg8::gemm_phase<pg8::EpiGate, pg8::OneUnit, true, true>(F.lds + RING_OFF, g, S, E); }
        ph_attn(F, MB); if (BOTH(2)) GRID_BAR(); }
    if (IN(3)) { REFRESH(); GEMM_PLAIN(MB, ws + WS_WOUT0, 1024, 1024, Y, 1024); if (BOTH(3)) GRID_BAR(); }
    if (IN(4)) { REFRESH(); ph_norm_res(F, F.in[0], Y, F.in[2], F.out, XN); if (BOTH(4)) GRID_BAR(); }
    if (IN(5)) { REFRESH(); GEMM_PLAIN(XN, ws + WS_WIN1, ODD_IN, 1024, Z, ODD_IN); if (BOTH(5)) GRID_BAR(); }
    if (IN(6)) { REFRESH(); ph_conv(F); ph_s5(F); if (BOTH(6)) GRID_BAR(); }
    if (IN(7)) { REFRESH();
        { pg8::Gemm g{(const pg8::bf16_t*)T1, (const pg8::bf16_t*)(ws + WS_WGLU), M, 1024, 512, 512, 512, 0}; pg8::StaticOrder S; S.init(M, 1024, F.G, (int)blockIdx.x);
          pg8::EpiGlu E{(pg8::bf16_t*)MB, 1024, (const pg8::bf16_t*)Z, ODD_IN, F.in[17]}; pg8::gemm_phase<pg8::EpiGlu, pg8::StaticOrder, true, true>(F.lds + RING_OFF, g, S, E); }
        { pg8::Gemm g{(const pg8::bf16_t*)T2, (const pg8::bf16_t*)(ws + WS_WPW), M, 512, 512, 512, 512, 0}; pg8::StaticOrder S; S.init(M, 512, F.G, (int)blockIdx.x);
          pg8::EpiGate E{(pg8::bf16_t*)MB, 1024, 512, (const pg8::bf16_t*)Z, ODD_IN, 2048}; pg8::gemm_phase<pg8::EpiGate, pg8::StaticOrder, true, true>(F.lds + RING_OFF, g, S, E); }
        if (BOTH(7)) GRID_BAR(); }
    if (IN(8)) { REFRESH(); GEMM_PLAIN(MB, ws + WS_WOUT1, 1024, 1024, Y, 1024); if (BOTH(8)) GRID_BAR(); }
    if (IN(9)) { REFRESH(); ph_norm_res(F, F.out, Y, F.in[2] + 1024, F.out, nullptr); }
#ifdef PROBE_ROPE
    GRID_BAR();
    if (blockIdx.x == 0 && F.tid == 0) { const float mxd = __builtin_bit_cast(float, __hip_atomic_load(ctl + 64, __ATOMIC_RELAXED, __HIP_MEMORY_SCOPE_AGENT)); F.out[0] = 100.f + 1.0e9f * mxd; }
#endif
#undef IN
#undef BOTH
}

extern "C" void kernel_launch(void* const* d_in, const int* in_sizes, int n_in, void* d_out, int out_size, void* d_ws, size_t ws_size, hipStream_t stream) {
    static int grid = 0;
    if (grid == 0) {
        if (n_in != 23 || in_sizes[0] != M * DM || out_size != M * DM || ws_size < WS_END) { fprintf(stderr, "kernel_launch: unexpected shapes n_in %d in0 %d out %d ws %zu\n", n_in, n_in > 0 ? in_sizes[0] : -1, out_size, ws_size); grid = -1; return; }
        int dev = 0, cus = 0, per_cu = 0;
        if (hipGetDevice(&dev) != hipSuccess || hipDeviceGetAttribute(&cus, hipDeviceAttributeMultiprocessorCount, dev) != hipSuccess) { grid = -1; return; }
        if (hipFuncSetAttribute((const void*)fwd_kernel, hipFuncAttributeMaxDynamicSharedMemorySize, LDS_BYTES) != hipSuccess) { fprintf(stderr, "kernel_launch: hipFuncSetAttribute failed\n"); grid = -1; return; }
        if (hipOccupancyMaxActiveBlocksPerMultiprocessor(&per_cu, (const void*)fwd_kernel, NWAVES * 64, LDS_BYTES) != hipSuccess || per_cu < 1) fprintf(stderr, "kernel_launch: occupancy query reports %d\n", per_cu);
        (void)hipGetLastError();
        grid = cus;
    }
    if (grid < 0) return;
    (void)hipMemsetAsync((char*)d_ws + WS_CTL, 0, CTL_ZERO_BYTES, stream);
    Args a{};
    for (int i = 0; i < 23; ++i) a.in[i] = (const float*)d_in[i];
    a.out = (float*)d_out; a.ws = (unsigned char*)d_ws;
    if (N_LAUNCHES == 1) { a.ph_lo = 0; a.ph_hi = N_PHASES; hipLaunchKernelGGL(fwd_kernel, dim3(grid), dim3(NWAVES * 64), LDS_BYTES, stream, a); }
    else for (int p = 0; p < N_PHASES; ++p) { a.ph_lo = p; a.ph_hi = p + 1; hipLaunchKernelGGL(fwd_kernel, dim3(grid), dim3(NWAVES * 64), LDS_BYTES, stream, a); }
}
```
